# Optimizing an MI355X kernel written in HIP

```python
import math
import numpy as np
import jax
import jax.numpy as jnp
from jax import lax

D_MODEL = 1024
BATCH = 16
SEQ = 256
DEPTH = 2
DEC_BATCH = 4
DEC_SEQ = 1024
PAST_LEN = 256

GRID_W = 64
D_MIX = D_MODEL // 2
D_FF = ((8 * D_MODEL // 3) + 127) // 128 * 128
N_MOD = 9
SSD_P = 64
SSD_H = D_MIX // SSD_P
SSD_N = 64
SSD_G = 2
SSD_CONV = 3
SSD_CHUNK = 64
SSD_XBC = D_MIX + 2 * SSD_G * SSD_N
SSD_COLS = D_MIX + SSD_XBC + 2 * SSD_H
GLA_H = 4
GLA_DK = D_MIX // 2 // GLA_H
GLA_DV = D_MIX // GLA_H
GLA_LR = 16
GLA_GATE_NORM = 16.0
GLA_CHUNK = 64
GLA_COLS = 2 * GLA_H * GLA_DK + 2 * D_MIX + 2 * GLA_LR
RW_N = 64
RW_H = D_MIX // RW_N
RW_LW = 64
RW_LA = 64
RW_LG = 128
RW_COLS = 3 * D_MIX + 2 * RW_LW + RW_LA + RW_LG
GATE_COLS = 3 * D_MODEL
N_IN = SSD_COLS + GLA_COLS + RW_COLS + GATE_COLS
RMS_EPS = 1e-6
RW_GN_EPS = 64e-5

kernel_name = 'hybrid_ssd_gla_rwkv7_diffusion_step'


def _split(x, sizes):
    return jnp.split(x, np.cumsum(sizes)[:-1].tolist(), axis=-1)


def _rev(t):
    return jnp.flip(t, axis=1)


def rmsnorm(x, g):
    xf = x.astype(jnp.float32)
    y = xf * lax.rsqrt(jnp.mean(xf * xf, axis=-1, keepdims=True) + RMS_EPS)
    return (y * g.astype(jnp.float32)).astype(x.dtype)


def modulate(h, shift, scale):
    return h * (1 + scale) + shift


def swiglu(h, wg, wu, wd):
    return (jax.nn.silu(h @ wg) * (h @ wu)) @ wd


def grid_pos_embed(rows, cols, dim):
    quarter = dim // 4
    omega = 1.0 / (10000.0 ** (jnp.arange(quarter, dtype=jnp.float32) / quarter))
    er = jnp.arange(rows, dtype=jnp.float32)[:, None] * omega
    ec = jnp.arange(cols, dtype=jnp.float32)[:, None] * omega
    er = jnp.concatenate([jnp.sin(er), jnp.cos(er)], axis=-1)
    ec = jnp.concatenate([jnp.sin(ec), jnp.cos(ec)], axis=-1)
    emb = jnp.concatenate([jnp.broadcast_to(er[:, None], (rows, cols, dim // 2)),
                           jnp.broadcast_to(ec[None], (rows, cols, dim // 2))], axis=-1)
    return emb.reshape(rows * cols, dim)


def segsum(x):
    T = x.shape[-1]
    xr = jnp.broadcast_to(x[..., None], x.shape + (T,))
    xr = jnp.where(jnp.tril(jnp.ones((T, T), bool), -1), xr, 0.0)
    ss = jnp.cumsum(xr, axis=-2)
    return jnp.where(jnp.tril(jnp.ones((T, T), bool)), ss, -jnp.inf)


def centred_conv(x, w, b):
    K = w.shape[0]
    half = K // 2
    L = x.shape[1]
    xp = jnp.pad(x, ((0, 0), (half, half), (0, 0)))
    out = b + xp[:, 0:L] * w[0]
    for i in range(1, K):
        out = out + xp[:, i:i + L] * w[i]
    return out


def centred_shift_mix(p, mu):
    zero = jnp.zeros_like(p[:, :1])
    prev = jnp.concatenate([zero, p[:, :-1]], axis=1)
    nxt = jnp.concatenate([p[:, 1:], zero], axis=1)
    return p + (0.5 * (prev + nxt) - p) * mu


def ssd_chunked(X, Adt, Bm, Cm, S0):
    b, l, H, P = X.shape
    dt = X.dtype
    G = Bm.shape[2]
    J = H // G
    N = Bm.shape[3]
    nc = l // SSD_CHUNK
    Xc = X.reshape(b, nc, SSD_CHUNK, G, J, P)
    Bc = Bm.reshape(b, nc, SSD_CHUNK, G, N)
    Cc = Cm.reshape(b, nc, SSD_CHUNK, G, N)
    A = Adt.astype(jnp.float32).reshape(b, nc, SSD_CHUNK, G, J).transpose(0, 3, 4, 1, 2)
    A_cs = jnp.cumsum(A, axis=-1)
    Lmat = jnp.exp(segsum(A))
    Y_diag = jnp.einsum('bclgn,bcsgn,bgjcls,bcsgjp->bclgjp', Cc, Bc, Lmat, Xc)
    decay_states = jnp.exp(A_cs[..., -1:] - A_cs)
    states = jnp.einsum('bcsgn,bgjcs,bcsgjp->bcgjpn', Bc, decay_states, Xc)
    S0r = S0.reshape(b, G, J, P, N).astype(states.dtype)
    states = jnp.concatenate([S0r[:, None], states], axis=1)
    chunk_end = jnp.pad(A_cs[..., -1], ((0, 0), (0, 0), (0, 0), (1, 0)))
    decay_chunk = jnp.exp(segsum(chunk_end))
    new_states = jnp.einsum('bgjzc,bcgjpn->bzgjpn', decay_chunk, states)
    S_in, S_fin = new_states[:, :-1], new_states[:, -1]
    Y_off = jnp.einsum('bclgn,bcgjpn,bgjcl->bclgjp', Cc, S_in, jnp.exp(A_cs))
    Y = (Y_diag + Y_off).reshape(b, l, H, P)
    return Y.astype(dt), S_fin.reshape(b, H, P, N).astype(dt)


def gla_chunked(q, k, v, lg, S0):
    b, l, h, dk = q.shape
    dv = v.shape[-1]
    dt = q.dtype
    C = GLA_CHUNK
    nc = l // C
    f32 = jnp.float32
    qc = q.astype(f32).reshape(b, nc, C, h, dk)
    kc = k.astype(f32).reshape(b, nc, C, h, dk)
    vc = v.astype(f32).reshape(b, nc, C, h, dv)
    bc = jnp.cumsum(lg.astype(f32).reshape(b, nc, C, h, dk), axis=2)
    causal = jnp.tril(jnp.ones((C, C), bool))[None, None, :, :, None, None]
    diff = bc[:, :, :, None] - bc[:, :, None, :]
    decay = jnp.exp(jnp.where(causal, diff, -jnp.inf))
    A = jnp.einsum('bnthk,bnshk,bntshk->bnhts', qc, kc, decay)
    o_intra = jnp.einsum('bnhts,bnshv->bnthv', A, vc)
    last = bc[:, :, -1]
    q_dec = qc * jnp.exp(bc)
    k_dec = kc * jnp.exp(last[:, :, None] - bc)
    kv = jnp.einsum('bnshk,bnshv->bnhkv', k_dec, vc)

    def step(S, inp):
        dec, kv_n = inp
        return dec[..., None] * S + kv_n, S

    S_fin, S_in = lax.scan(step, S0.astype(f32), (jnp.moveaxis(jnp.exp(last), 1, 0), jnp.moveaxis(kv, 1, 0)))
    S_in = jnp.moveaxis(S_in, 0, 1)
    o_inter = jnp.einsum('bnthk,bnhkv->bnthv', q_dec, S_in)
    o = (o_intra + o_inter).reshape(b, l, h, dv)
    return o.astype(dt), S_fin.astype(dt)


def rwkv_scan(r, w, k, v, kk, a, S0, reverse):
    def step(S, inp):
        r_t, w_t, k_t, v_t, kk_t, a_t = inp
        Skk = jnp.einsum('bhvk,bhk->bhv', S, kk_t)
        S = S * w_t[:, :, None, :] - Skk[..., None] * (kk_t * a_t)[:, :, None, :] + v_t[..., None] * k_t[:, :, None, :]
        return S, jnp.einsum('bhvk,bhk->bhv', S, r_t)

    xs = tuple(jnp.moveaxis(t, 1, 0) for t in (r, w, k, v, kk, a))
    S_fin, o = lax.scan(step, S0.astype(jnp.float32), xs, reverse=reverse)
    return jnp.moveaxis(o, 0, 1), S_fin


def ssd_branch(p, st, lp):
    b, L, _ = p.shape
    z, xbc, dt_raw = _split(p, [D_MIX, SSD_XBC, 2 * SSD_H])
    xbc = jax.nn.silu(centred_conv(xbc, lp['ssd_conv_w'], lp['ssd_conv_b']))
    xs, bm, cm = _split(xbc, [D_MIX, SSD_G * SSD_N, SSD_G * SSD_N])
    xs = xs.reshape(b, L, SSD_H, SSD_P)
    bm = bm.reshape(b, L, SSD_G, SSD_N)
    cm = cm.reshape(b, L, SSD_G, SSD_N)
    dt = jax.nn.softplus((dt_raw.reshape(b, L, 2, SSD_H) + lp['ssd_dt_bias']).astype(jnp.float32))
    a = -jnp.exp(lp['ssd_A_log'].astype(jnp.float32))
    y = xs * (lp['ssd_D'][0] + lp['ssd_D'][1])[:, None]
    finals = []
    for d in range(2):
        xd = (xs * dt[:, :, d, :, None]).astype(xs.dtype)
        ad = dt[:, :, d] * a[d]
        if d == 0:
            yd, sd = ssd_chunked(xd, ad, bm, cm, st[:, 0])
        else:
            yd, sd = ssd_chunked(_rev(xd), _rev(ad), _rev(bm), _rev(cm), st[:, 1])
            yd = _rev(yd)
        y = y + yd
        finals.append(sd)
    y = rmsnorm(y.reshape(b, L, D_MIX) * jax.nn.silu(z), lp['ssd_norm'])
    return y @ lp['w_ssd_o'], jnp.stack(finals, axis=1)


def gla_branch(p, st, lp):
    b, L, _ = p.shape
    q, k, v, g, lr = _split(p, [GLA_H * GLA_DK, GLA_H * GLA_DK, D_MIX, D_MIX, 2 * GLA_LR])
    q = q.reshape(b, L, GLA_H, GLA_DK) * (GLA_DK ** -0.5)
    k = k.reshape(b, L, GLA_H, GLA_DK)
    v = v.reshape(b, L, GLA_H, GLA_DV)
    lr = lr.reshape(b, L, 2, GLA_LR)
    outs = []
    finals = []
    for d in range(2):
        lg = jax.nn.log_sigmoid((lr[:, :, d] @ lp['gla_gk_w'][d] + lp['gla_gk_b'][d]).astype(jnp.float32)) / GLA_GATE_NORM
        lg = lg.reshape(b, L, GLA_H, GLA_DK)
        if d == 0:
            od, sd = gla_chunked(q, k, v, lg, st[:, 0])
        else:
            od, sd = gla_chunked(_rev(q), _rev(k), _rev(v), _rev(lg), st[:, 1])
            od = _rev(od)
        outs.append(od)
        finals.append(sd)
    o = rmsnorm(outs[0] + outs[1], lp['gla_norm']).reshape(b, L, D_MIX) * jax.nn.silu(g)
    return o @ lp['w_gla_o'], jnp.stack(finals, axis=1)


def rwkv_branch(p, st, lp):
    b, L, _ = p.shape
    f32 = jnp.float32
    p = centred_shift_mix(p, lp['rw_mu'])
    r, k, v, wlr, alr, glr = _split(p, [D_MIX, D_MIX, D_MIX, 2 * RW_LW, RW_LA, RW_LG])
    a = jax.nn.sigmoid((lp['rw_a0'] + alr @ lp['rw_a2']).astype(f32))
    g = jax.nn.sigmoid(glr) @ lp['rw_g2']

    def hd(t):
        return t.reshape(b, L, RW_H, RW_N)

    r, k, v, a = hd(r.astype(f32)), hd(k.astype(f32)), hd(v.astype(f32)), hd(a)
    kk = k * lp['rw_kk'].astype(f32).reshape(RW_H, RW_N)
    kk = kk / jnp.maximum(jnp.sqrt(jnp.sum(kk * kk, axis=-1, keepdims=True)), 1e-12)
    k = k * (1 + (a - 1) * lp['rw_ka'].astype(f32).reshape(RW_H, RW_N))
    wlr = wlr.reshape(b, L, 2, RW_LW)
    o = jnp.zeros_like(r)
    finals = []
    for d in range(2):
        wl = -jax.nn.softplus(-(lp['rw_w0'][d] + jnp.tanh(wlr[:, :, d]) @ lp['rw_w2'][d]).astype(f32)) - 0.5
        w = hd(jnp.exp(-jnp.exp(wl)))
        od, sd = rwkv_scan(r, w, k, v, kk, a, st[:, d], reverse=(d == 1))
        o = o + od
        finals.append(sd.astype(p.dtype))
    mu = jnp.mean(o, axis=-1, keepdims=True)
    var = jnp.mean(jnp.square(o - mu), axis=-1, keepdims=True)
    o = ((o - mu) * lax.rsqrt(var + RW_GN_EPS)).reshape(b, L, D_MIX)
    o = o * lp['rw_ln_w'].astype(f32) + lp['rw_ln_b'].astype(f32)
    o = o + (jnp.sum(r * k * lp['rw_rk'].astype(f32), axis=-1, keepdims=True) * v).reshape(b, L, D_MIX)
    o = o.astype(p.dtype) * g
    return o @ lp['w_rw_o'], jnp.stack(finals, axis=1)


def token_mixer(u, st_ssd, st_gla, st_rw, lp):
    b, L, _ = u.shape
    proj = u @ lp['w_in']
    p_ssd, p_gla, p_rw, p_gate = _split(proj, [SSD_COLS, GLA_COLS, RW_COLS, GATE_COLS])
    o_ssd, s_ssd = ssd_branch(p_ssd, st_ssd, lp)
    o_gla, s_gla = gla_branch(p_gla, st_gla, lp)
    o_rw, s_rw = rwkv_branch(p_rw, st_rw, lp)
    gates = jax.nn.sigmoid(p_gate.astype(jnp.float32)).astype(u.dtype).reshape(b, L, 3, D_MODEL)
    merged = gates[:, :, 0] * o_ssd + gates[:, :, 1] * o_gla + gates[:, :, 2] * o_rw
    return merged @ lp['w_out'], s_ssd, s_gla, s_rw


def trunk_layer(x, cond, st_ssd, st_gla, st_rw, lp):
    nb = cond.shape[0]
    ada = (jax.nn.silu(cond) @ lp['w_ada'] + lp['b_ada']).reshape(nb, 1, N_MOD, D_MODEL)
    sh1, sc1, g1, sh2, sc2, g2, sh3, sc3, g3 = [ada[:, :, i] for i in range(N_MOD)]
    h = modulate(rmsnorm(x, lp['norm_g'][0]), sh1, sc1)
    x = x + 0.5 * g1 * swiglu(h, lp['ffn_gate'][0], lp['ffn_up'][0], lp['ffn_down'][0])
    h = modulate(rmsnorm(x, lp['norm_g'][1]), sh2, sc2)
    m, s_ssd, s_gla, s_rw = token_mixer(h, st_ssd, st_gla, st_rw, lp)
    x = x + g2 * m
    h = modulate(rmsnorm(x, lp['norm_g'][2]), sh3, sc3)
    x = x + 0.5 * g3 * swiglu(h, lp['ffn_gate'][1], lp['ffn_up'][1], lp['ffn_down'][1])
    return x, s_ssd, s_gla, s_rw


def setup_inputs(seed: int = 0) -> dict:
    key = jax.random.key(seed)
    ks = iter(jax.random.split(key, 64))
    f32 = jnp.float32

    def nrm(shape, scale):
        return jax.random.normal(next(ks), shape, f32) * scale

    def uni(shape, lo, hi):
        return jax.random.uniform(next(ks), shape, f32, lo, hi)

    x_prompt = nrm((BATCH, SEQ, D_MODEL), 1.0)
    x_sample = nrm((DEC_BATCH, DEC_SEQ, D_MODEL), 1.0)
    state_ssd = nrm((DEC_BATCH, DEPTH, 2, SSD_H, SSD_P, SSD_N), 0.5)
    state_gla = nrm((DEC_BATCH, DEPTH, 2, GLA_H, GLA_DK, GLA_DV), 1.0)
    state_rwkv = nrm((DEC_BATCH, DEPTH, 2, RW_H, RW_N, RW_N), 0.5)
    c = nrm((DEC_BATCH, D_MODEL), 1.0)
    c_ctx = nrm((D_MODEL,), 1.0)
    norm_g = 1.0 + nrm((DEPTH, 3, D_MODEL), 0.02)
    w_ada = nrm((DEPTH, D_MODEL, N_MOD * D_MODEL), 0.5 * D_MODEL ** -0.5)
    b_ada = nrm((DEPTH, N_MOD * D_MODEL), 0.02)
    ffn_gate = nrm((DEPTH, 2, D_MODEL, D_FF), D_MODEL ** -0.5)
    ffn_up = nrm((DEPTH, 2, D_MODEL, D_FF), D_MODEL ** -0.5)
    ffn_down = nrm((DEPTH, 2, D_FF, D_MODEL), D_FF ** -0.5)
    w_in = nrm((DEPTH, D_MODEL, N_IN), D_MODEL ** -0.5)
    ssd_conv_w = nrm((DEPTH, SSD_CONV, SSD_XBC), SSD_CONV ** -0.5)
    ssd_conv_b = nrm((DEPTH, SSD_XBC), 0.02)
    dt0 = jnp.exp(uni((DEPTH, 2, SSD_H), math.log(1e-3), math.log(1e-1)))
    ssd_dt_bias = dt0 + jnp.log(-jnp.expm1(-dt0))
    ssd_A_log = jnp.log(uni((DEPTH, 2, SSD_H), 1.0, 16.0))
    ssd_D = 1.0 + nrm((DEPTH, 2, SSD_H), 0.1)
    ssd_norm = 1.0 + nrm((DEPTH, D_MIX), 0.02)
    w_ssd_o = nrm((DEPTH, D_MIX, D_MODEL), D_MIX ** -0.5)
    gla_gk_w = nrm((DEPTH, 2, GLA_LR, GLA_H * GLA_DK), GLA_LR ** -0.5)
    gla_gk_b = nrm((DEPTH, 2, GLA_H * GLA_DK), 0.5)
    gla_norm = 1.0 + nrm((DEPTH, GLA_DV), 0.02)
    w_gla_o = nrm((DEPTH, D_MIX, D_MODEL), D_MIX ** -0.5)
    rw_mu = uni((DEPTH, RW_COLS), 0.0, 1.0)
    rw_w0 = uni((DEPTH, 2, D_MIX), -6.0, 1.0)
    rw_w2 = nrm((DEPTH, 2, RW_LW, D_MIX), 0.5 * RW_LW ** -0.5)
    rw_a0 = nrm((DEPTH, D_MIX), 0.5)
    rw_a2 = nrm((DEPTH, RW_LA, D_MIX), 0.5 * RW_LA ** -0.5)
    rw_g2 = nrm((DEPTH, RW_LG, D_MIX), RW_LG ** -0.5)
    rw_kk = 0.85 + nrm((DEPTH, D_MIX), 0.02)
    rw_ka = 1.0 + nrm((DEPTH, D_MIX), 0.02)
    rw_rk = nrm((DEPTH, RW_H, RW_N), 0.1)
    rw_ln_w = 1.0 + nrm((DEPTH, D_MIX), 0.02)
    rw_ln_b = nrm((DEPTH, D_MIX), 0.02)
    w_rw_o = nrm((DEPTH, D_MIX, D_MODEL), D_MIX ** -0.5)
    w_out = nrm((DEPTH, D_MODEL, D_MODEL), D_MODEL ** -0.5)
    final_norm = 1.0 + nrm((D_MODEL,), 0.02)
    return {'x_prompt': x_prompt, 'x_sample': x_sample, 'state_ssd': state_ssd, 'state_gla': state_gla,
            'state_rwkv': state_rwkv, 'c': c, 'c_ctx': c_ctx, 'norm_g': norm_g, 'w_ada': w_ada, 'b_ada': b_ada,
            'ffn_gate': ffn_gate, 'ffn_up': ffn_up, 'ffn_down': ffn_down, 'w_in': w_in,
            'ssd_conv_w': ssd_conv_w, 'ssd_conv_b': ssd_conv_b, 'ssd_dt_bias': ssd_dt_bias, 'ssd_A_log': ssd_A_log,
            'ssd_D': ssd_D, 'ssd_norm': ssd_norm, 'w_ssd_o': w_ssd_o, 'gla_gk_w': gla_gk_w, 'gla_gk_b': gla_gk_b,
            'gla_norm': gla_norm, 'w_gla_o': w_gla_o, 'rw_mu': rw_mu, 'rw_w0': rw_w0, 'rw_w2': rw_w2,
            'rw_a0': rw_a0, 'rw_a2': rw_a2, 'rw_g2': rw_g2, 'rw_kk': rw_kk, 'rw_ka': rw_ka, 'rw_rk': rw_rk,
            'rw_ln_w': rw_ln_w, 'rw_ln_b': rw_ln_b, 'w_rw_o': w_rw_o, 'w_out': w_out, 'final_norm': final_norm}


def reference(x_prompt, x_sample, state_ssd, state_gla, state_rwkv, c, c_ctx, norm_g, w_ada, b_ada,
              ffn_gate, ffn_up, ffn_down, w_in, ssd_conv_w, ssd_conv_b, ssd_dt_bias, ssd_A_log, ssd_D,
              ssd_norm, w_ssd_o, gla_gk_w, gla_gk_b, gla_norm, w_gla_o, rw_mu, rw_w0, rw_w2, rw_a0, rw_a2,
              rw_g2, rw_kk, rw_ka, rw_rk, rw_ln_w, rw_ln_b, w_rw_o, w_out, final_norm):
    rows = x_sample.shape[1] // GRID_W
    xs = x_sample + grid_pos_embed(rows, GRID_W, D_MODEL).astype(x_sample.dtype)[None]
    xp = x_prompt
    bp = xp.shape[0]
    cond_ctx = c_ctx[None]
    new_ssd, new_gla, new_rw = [], [], []
    for l in range(DEPTH):
        lp = {'norm_g': norm_g[l], 'w_ada': w_ada[l], 'b_ada': b_ada[l], 'ffn_gate': ffn_gate[l],
              'ffn_up': ffn_up[l], 'ffn_down': ffn_down[l], 'w_in': w_in[l], 'ssd_conv_w': ssd_conv_w[l],
              'ssd_conv_b': ssd_conv_b[l], 'ssd_dt_bias': ssd_dt_bias[l], 'ssd_A_log': ssd_A_log[l],
              'ssd_D': ssd_D[l], 'ssd_norm': ssd_norm[l], 'w_ssd_o': w_ssd_o[l], 'gla_gk_w': gla_gk_w[l],
              'gla_gk_b': gla_gk_b[l], 'gla_norm': gla_norm[l], 'w_gla_o': w_gla_o[l], 'rw_mu': rw_mu[l],
              'rw_w0': rw_w0[l], 'rw_w2': rw_w2[l], 'rw_a0': rw_a0[l], 'rw_a2': rw_a2[l], 'rw_g2': rw_g2[l],
              'rw_kk': rw_kk[l], 'rw_ka': rw_ka[l], 'rw_rk': rw_rk[l], 'rw_ln_w': rw_ln_w[l],
              'rw_ln_b': rw_ln_b[l], 'w_rw_o': w_rw_o[l], 'w_out': w_out[l]}
        z_ssd = jnp.zeros((bp, 2, SSD_H, SSD_P, SSD_N), xp.dtype)
        z_gla = jnp.zeros((bp, 2, GLA_H, GLA_DK, GLA_DV), xp.dtype)
        z_rw = jnp.zeros((bp, 2, RW_H, RW_N, RW_N), xp.dtype)
        xp, s_ssd, s_gla, s_rw = trunk_layer(xp, cond_ctx, z_ssd, z_gla, z_rw, lp)
        new_ssd.append(s_ssd)
        new_gla.append(s_gla)
        new_rw.append(s_rw)
        xs, _, _, _ = trunk_layer(xs, c, state_ssd[:, l], state_gla[:, l], state_rwkv[:, l], lp)
    y_prompt = rmsnorm(xp, final_norm)
    y_sample = rmsnorm(xs, final_norm)
    return (y_prompt, y_sample, jnp.stack(new_ssd, axis=1), jnp.stack(new_gla, axis=1), jnp.stack(new_rw, axis=1))
```

```cpp
#include <hip/hip_runtime.h>
#include <hip/hip_cooperative_groups.h>
#include <cstdio>
namespace cg = cooperative_groups;
namespace pg8 {
#define PG8_LAS __attribute__((address_space(3)))
typedef unsigned short bf16_t;
typedef short bf16x8 __attribute__((ext_vector_type(8)));
typedef float f32x4 __attribute__((ext_vector_type(4)));
typedef unsigned u32x4 __attribute__((ext_vector_type(4)));
constexpr int BM = 256, BK = 64, HALF = 128, HTB = HALF * BK * 2  , STAGE_BYTES = 8 * HTB, NXCD = 8, WGM = 8;

__host__ __device__ __forceinline__ int lds_byte(int r, int c) { const int st = (r >> 4) * 2 + (c >> 5), rr = r & 15, cc = c & 31, ob = rr * 64 + cc * 2; return st * 1024 + (ob ^ (((ob >> 9) & 1) << 5)); }
__host__ __device__ __forceinline__ void stage_rc(int b, int& R, int& C) { const int st = b / 1024, sb = b % 1024, swz = sb ^ (((sb >> 9) & 1) << 5); R = (st >> 1) * 16 + swz / 64; C = (st & 1) * 32 + (swz % 64) / 2; }
__host__ __device__ __forceinline__ int perm32(int rho) { const int n = rho >> 4, i = rho & 15; return 8 * (i >> 2) + 4 * n + (i & 3); }

struct Unit { int pm, pn; };
struct Gemm { const bf16_t* A; const bf16_t* Bt; int M, N, K, ld, nreal; size_t asl, bsl; };

struct StaticOrder {
    int nM, nN, nwg, G, c;
    __host__ __device__ void init(int M, int N, int G_, int c_) { nM = M / BM; nN = N / BM; nwg = nM * nN; G = G_; c = c_; }
    __host__ __device__ bool next(int i, Unit& u) const {
        const long L = (long)i * G + c; if (L >= nwg) return false;
        int wgid = (int)L; { const int q = nwg / NXCD, r = nwg % NXCD, xcd = wgid % NXCD, off = wgid / NXCD; wgid = (xcd < r ? xcd * (q + 1) : r * (q + 1) + (xcd - r) * q) + off; }
        const int nig = WGM * nN, gid = wgid / nig, fm = gid * WGM, gsz = (nM - fm) < WGM ? (nM - fm) : WGM;
        u.pm = fm + ((wgid % nig) % gsz); u.pn = (wgid % nig) / gsz; return true;
    }
    __device__ __forceinline__ void a_ready(const Unit&) const {}
    __device__ __forceinline__ void done(const Unit&) const {}
};
__device__ __forceinline__ unsigned cvt_pk_bf16(float lo, float hi) { unsigned r; asm volatile("v_cvt_pk_bf16_f32 %0, %1, %2" : "=v"(r) : "v"(lo), "v"(hi)); return r; }
template <class Epi, class Sched, bool ALIGN_EPI = false, bool SP2 = false>
__device__ __forceinline__ void gemm_phase(PG8_LAS unsigned char* lds, const Gemm g, const Sched& S, const Epi& E) {
    int tid_l = threadIdx.x; asm volatile("" : "+v"(tid_l));
    const int tid = tid_l, wid = __builtin_amdgcn_readfirstlane(tid >> 6), lane = tid & 63, wr = wid >> 2, wc = wid & 3, fr = lane & 15, fq = lane >> 4;
    const int K = g.K, LD = g.ld, nt = K / BK;
    unsigned voffA[2], voffB[2];
#pragma unroll
    for (int i = 0; i < 2; ++i) { int R, C; stage_rc(tid * 16 + i * 8192, R, C); const int Rb = Epi::PERM ? ((R & ~31) + perm32(R & 31)) : R;
        voffA[i] = (unsigned)(R * LD + C) * 2u; voffB[i] = (unsigned)(Rb * LD + C) * 2u; }
    const size_t kstep = (size_t)(BK * 2);
    const size_t hstep = (size_t)HALF * LD * 2;
    const size_t tstep = 2 * hstep;
    const unsigned ldsw = (unsigned)wid * 1024u;
    const int aoff = lds_byte(wr * 64 + fr, fq * 8), boff = lds_byte(wc * 32 + fr, fq * 8);
#define PG8_SA(b, h) (((b) * 2 + (h)) * HTB)
#define PG8_SB(b, h) ((4 + (b) * 2 + (h)) * HTB)
#define PG8_STAGE(bufoff, gbase, voff) do { _Pragma("unroll") for (int _i = 0; _i < 2; ++_i) \
        __builtin_amdgcn_global_load_lds((const unsigned*)((const char*)(gbase) + (voff)[_i]), (PG8_LAS unsigned*)(lds + (bufoff) + ldsw + _i * 8192), 16, 0, 0); } while (0)
#define PG8_LDA(dst, b, h) do { _Pragma("unroll") for (int m = 0; m < 4; ++m) _Pragma("unroll") for (int k = 0; k < 2; ++k) dst[m][k] = *(const PG8_LAS bf16x8*)(lds + PG8_SA(b, h) + aoff + m * 2048 + k * 1024); } while (0)
#define PG8_LDB(dst, b, h) do { _Pragma("unroll") for (int n = 0; n < 2; ++n) _Pragma("unroll") for (int k = 0; k < 2; ++k) dst[n][k] = *(const PG8_LAS bf16x8*)(lds + PG8_SB(b, h) + boff + n * 2048 + k * 1024); } while (0)
#define PG8_MMA(ai, bj, At, Bt) do { __builtin_amdgcn_s_setprio(1); _Pragma("unroll") for (int m = 0; m < 4; ++m) _Pragma("unroll") for (int n = 0; n < 2; ++n) _Pragma("unroll") for (int k = 0; k < 2; ++k) \
        acc[ai][bj][m][n] = __builtin_amdgcn_mfma_f32_16x16x32_bf16(Bt[n][k], At[m][k], acc[ai][bj][m][n], 0, 0, 0); __builtin_amdgcn_s_setprio(0); } while (0)
#define PG8_WAIT_V(n) asm volatile("s_waitcnt vmcnt(" #n ")" ::: "memory")
#define PG8_WAIT_L(n) asm volatile("s_waitcnt lgkmcnt(" #n ")" ::: "memory")
#define PG8_BAR __builtin_amdgcn_s_barrier()
#define PG8_SCHED __builtin_amdgcn_sched_barrier(0)
    Unit cur, nxt; int ui = 0;
    if (!S.next(0, cur)) return;
    f32x4 acc[2][2][4][2];
#pragma unroll
    for (int a = 0; a < 2; ++a)
#pragma unroll
        for (int b = 0; b < 2; ++b)
#pragma unroll
            for (int m = 0; m < 4; ++m)
#pragma unroll
                for (int n = 0; n < 2; ++n) acc[a][b][m][n] = (f32x4){0.f, 0.f, 0.f, 0.f};
    bf16x8 At[4][2], B0[2][2], B1[2][2];
    const char* cA = (const char*)g.A + (size_t)cur.pm * tstep + (size_t)(cur.pn / g.nreal) * g.asl; const char* cB = (const char*)g.Bt + (size_t)(cur.pn % g.nreal) * tstep + (size_t)(cur.pn / g.nreal) * g.bsl;
    S.a_ready(cur);
    if constexpr (SP2) {
        PG8_STAGE(PG8_SB(0, 0), cB, voffB); PG8_STAGE(PG8_SB(0, 1), cB + hstep, voffB); PG8_STAGE(PG8_SA(0, 0), cA, voffA); PG8_STAGE(PG8_SA(0, 1), cA + hstep, voffA);
        if (wr == 1) PG8_BAR;
        PG8_WAIT_V(2); PG8_BAR;
        PG8_STAGE(PG8_SB(1, 0), cB + kstep, voffB); PG8_STAGE(PG8_SA(1, 0), cA + kstep, voffA); PG8_STAGE(PG8_SB(1, 1), cB + hstep + kstep, voffB);
        PG8_WAIT_V(6); PG8_BAR;
    } else {
        PG8_STAGE(PG8_SB(0, 0), cB, voffB); PG8_STAGE(PG8_SA(0, 0), cA, voffA); PG8_STAGE(PG8_SB(0, 1), cB + hstep, voffB); PG8_STAGE(PG8_SA(0, 1), cA + hstep, voffA);
        if (wr == 1) PG8_BAR;
        PG8_WAIT_V(4); PG8_BAR;
        PG8_STAGE(PG8_SB(1, 0), cB + kstep, voffB); PG8_STAGE(PG8_SA(1, 0), cA + kstep, voffA); PG8_STAGE(PG8_SB(1, 1), cB + hstep + kstep, voffB);
        PG8_WAIT_V(6); PG8_BAR;
    }
    for (;;) {
        const bool has_next = S.next(ui + 1, nxt);
        const char* nA = has_next ? (const char*)g.A + (size_t)nxt.pm * tstep + (size_t)(nxt.pn / g.nreal) * g.asl : cA; const char* nB = has_next ? (const char*)g.Bt + (size_t)(nxt.pn % g.nreal) * tstep + (size_t)(nxt.pn / g.nreal) * g.bsl : cB;
        for (int t = 0; t < nt; t += 2) {
            const bool last = (t == nt - 2);
            const char* a1 = cA + (size_t)(t + 1) * kstep;
            const char* a2 = last ? nA : cA + (size_t)(t + 2) * kstep; const char* b2 = last ? nB : cB + (size_t)(t + 2) * kstep;
            const char* a3 = a2 + kstep; const char* b3 = b2 + kstep;
            if (last && has_next) S.a_ready(nxt);
            if constexpr (SP2) {
            PG8_LDB(B0, 0, 0); PG8_LDB(B1, 0, 1); PG8_SCHED; PG8_LDA(At, 0, 0); PG8_STAGE(PG8_SA(1, 1), a1 + hstep, voffA);
            PG8_WAIT_V(8); PG8_WAIT_L(0); PG8_BAR; PG8_MMA(0, 0, At, B0); PG8_MMA(0, 1, At, B1); PG8_BAR; PG8_SCHED;
            PG8_LDA(At, 0, 1); PG8_STAGE(PG8_SB(0, 0), b2, voffB); PG8_STAGE(PG8_SB(0, 1), b2 + hstep, voffB); PG8_STAGE(PG8_SA(0, 0), a2, voffA);
            PG8_WAIT_V(8); PG8_WAIT_L(0); PG8_BAR; PG8_MMA(1, 0, At, B0); PG8_MMA(1, 1, At, B1); PG8_BAR; PG8_SCHED;
            PG8_LDB(B0, 1, 0); PG8_LDB(B1, 1, 1); PG8_SCHED; PG8_LDA(At, 1, 0); PG8_STAGE(PG8_SA(0, 1), a2 + hstep, voffA);
            PG8_WAIT_V(8); PG8_WAIT_L(0); PG8_BAR; PG8_MMA(0, 0, At, B0); PG8_MMA(0, 1, At, B1); PG8_BAR; PG8_SCHED;
            PG8_LDA(At, 1, 1); PG8_STAGE(PG8_SB(1, 0), b3, voffB); PG8_STAGE(PG8_SB(1, 1), b3 + hstep, voffB); PG8_STAGE(PG8_SA(1, 0), a3, voffA);
            PG8_WAIT_V(8); PG8_WAIT_L(0); PG8_BAR; PG8_MMA(1, 0, At, B0); PG8_MMA(1, 1, At, B1); PG8_BAR; PG8_SCHED;
            } else {
            PG8_LDB(B0, 0, 0); PG8_SCHED; PG8_LDA(At, 0, 0); PG8_STAGE(PG8_SA(1, 1), a1 + hstep, voffA);
            PG8_WAIT_L(8); PG8_BAR; PG8_WAIT_L(0); PG8_MMA(0, 0, At, B0); PG8_BAR; PG8_SCHED;
            PG8_LDB(B1, 0, 1); PG8_STAGE(PG8_SB(0, 0), b2, voffB);
            PG8_BAR; PG8_WAIT_L(0); PG8_MMA(0, 1, At, B1); PG8_BAR;
            PG8_LDA(At, 0, 1); PG8_STAGE(PG8_SA(0, 0), a2, voffA);
            PG8_BAR; PG8_WAIT_L(0); PG8_MMA(1, 0, At, B0); PG8_BAR; PG8_SCHED;
            PG8_STAGE(PG8_SB(0, 1), b2 + hstep, voffB);
            PG8_WAIT_V(6); PG8_BAR; PG8_MMA(1, 1, At, B1); PG8_BAR;
            PG8_LDB(B0, 1, 0); PG8_SCHED; PG8_LDA(At, 1, 0); PG8_STAGE(PG8_SA(0, 1), a2 + hstep, voffA);
            PG8_WAIT_L(8); PG8_BAR; PG8_WAIT_L(0); PG8_MMA(0, 0, At, B0); PG8_BAR; PG8_SCHED;
            PG8_LDB(B1, 1, 1); PG8_STAGE(PG8_SB(1, 0), b3, voffB);
            PG8_BAR; PG8_WAIT_L(0); PG8_MMA(0, 1, At, B1); PG8_BAR;
            PG8_LDA(At, 1, 1); PG8_STAGE(PG8_SA(1, 0), a3, voffA);
            PG8_BAR; PG8_WAIT_L(0); PG8_MMA(1, 0, At, B0); PG8_BAR; PG8_SCHED;
            PG8_STAGE(PG8_SB(1, 1), b3 + hstep, voffB);
            PG8_WAIT_V(6); PG8_BAR; PG8_MMA(1, 1, At, B1); PG8_BAR;
            }
        }
        if constexpr (ALIGN_EPI) { if (wr == 0) PG8_BAR; }
        if constexpr (!Epi::AFTER_DRAIN) { E(acc, cur, wr, wc, fr, fq); S.done(cur); }
        if (!has_next) break;
#pragma unroll
        for (int a = 0; a < 2; ++a)
#pragma unroll
            for (int b = 0; b < 2; ++b)
#pragma unroll
                for (int m = 0; m < 4; ++m)
#pragma unroll
                    for (int n = 0; n < 2; ++n) acc[a][b][m][n] = (f32x4){0.f, 0.f, 0.f, 0.f};
        cur = nxt; cA = nA; cB = nB; ++ui;
        if constexpr (ALIGN_EPI) { if (wr == 1) PG8_BAR; }
    }
    PG8_WAIT_V(0);
    if constexpr (!ALIGN_EPI) { if (wr == 0) PG8_BAR; }
    PG8_BAR;
    if constexpr (Epi::AFTER_DRAIN) { E.fused(acc, cur, wr, wc, fr, fq, lds, wid, lane); S.done(cur); }
#undef PG8_SA
#undef PG8_SB
#undef PG8_STAGE
#undef PG8_LDA
#undef PG8_LDB
#undef PG8_MMA
#undef PG8_WAIT_V
#undef PG8_WAIT_L
#undef PG8_BAR
#undef PG8_SCHED
}
}
#define LAS __attribute__((address_space(3)))
#define XB_TMO      128
#define XB_XCNT(j)  (256  + 64 * (j))
#define XB_XSUB(j)  (1280 + 64 * (j))
#define XB_XGEN(j)  (2304 + 64 * (j))
#define XB_TOP      3328
#define XB_TOPGEN   3392
#define XCD_BAR_WORDS 3456
#define XB_SPIN_CAP (1u << 18)

__device__ __forceinline__ unsigned xb_ld(unsigned* p)              { return __hip_atomic_load(p, __ATOMIC_RELAXED, __HIP_MEMORY_SCOPE_AGENT); }
__device__ __forceinline__ unsigned xb_add(unsigned* p, unsigned v) { return __hip_atomic_fetch_add(p, v, __ATOMIC_RELAXED, __HIP_MEMORY_SCOPE_AGENT); }
__device__ __forceinline__ unsigned xb_xcc_id() { return (unsigned)__builtin_amdgcn_s_getreg((3 << 11) | 20) & 0xFu; }
#define XB_SPIN(cond, bar) do { unsigned _sp = 0; while (cond) { __builtin_amdgcn_s_sleep(1); \
    if ((++_sp & 255u) == 0u) { if (xb_ld(&(bar)[XB_TMO])) break; if (_sp > XB_SPIN_CAP) { atomicAdd(&(bar)[XB_TMO], 1u); break; } } } } while (0)

struct XcdBarrier {
    unsigned* bar; unsigned x;
    volatile LAS unsigned* st;
};

__device__ __forceinline__ XcdBarrier xcd_barrier_post(unsigned* bar, volatile LAS unsigned* st) {
    XcdBarrier b; b.bar = bar; b.x = xb_xcc_id(); b.st = st;
    if (threadIdx.x == 0) (void)xb_add(&bar[XB_XCNT(b.x)], 1u);
    return b;
}
__device__ __forceinline__ void xcd_barrier_complete(unsigned* bar, unsigned x, unsigned& nloc, unsigned& nx) {
    const unsigned G = gridDim.x * gridDim.y * gridDim.z;
    unsigned sum, cnt, mine, sp = 0u;
    for (;;) {
        sum = 0u; cnt = 0u; mine = 0u;
#pragma unroll
        for (unsigned j = 0; j < 16; ++j) { const unsigned c = xb_ld(&bar[XB_XCNT(j)]); sum += c; cnt += (c > 0u) ? 1u : 0u; mine = (j == x) ? c : mine; }
        if (sum == G) break;
        __builtin_amdgcn_s_sleep(1);
        if ((++sp & 255u) == 0u) { if (xb_ld(&bar[XB_TMO])) break; if (sp > XB_SPIN_CAP) { atomicAdd(&bar[XB_TMO], 1u); break; } }
    }
    nloc = mine > 0u ? mine : 1u; nx = cnt > 0u ? cnt : 1u;
}

__device__ __forceinline__ void xcd_barrier(const XcdBarrier& b) {
    asm volatile("s_waitcnt vmcnt(0)" ::: "memory");
    __syncthreads();
    if (threadIdx.x == 0) {
        unsigned* bar = b.bar;
        __builtin_amdgcn_s_waitcnt(0);
        unsigned nloc = b.st[0], nx = b.st[1];
        if (nloc == 0u) { xcd_barrier_complete(bar, b.x, nloc, nx); b.st[0] = nloc; b.st[1] = nx; }
        const unsigned old = xb_add(&bar[XB_XSUB(b.x)], 1u);
        const unsigned gen = old / nloc;
        if (old + 1u == (gen + 1u) * nloc) {
            __builtin_amdgcn_fence(__ATOMIC_RELEASE, "agent");
            asm volatile("s_waitcnt vmcnt(0)" ::: "memory");
            const unsigned og = xb_add(&bar[XB_TOP], 1u);
            const unsigned tg = og / nx;
            if (og + 1u == (tg + 1u) * nx) xb_add(&bar[XB_TOPGEN], 1u);
            else XB_SPIN(xb_ld(&bar[XB_TOPGEN]) == tg, bar);
            __builtin_amdgcn_fence(__ATOMIC_ACQUIRE, "agent");
            xb_add(&bar[XB_XGEN(b.x)], 1u);
            asm volatile("s_waitcnt vmcnt(0)" ::: "memory");
        } else {
            XB_SPIN(xb_ld(&bar[XB_XGEN(b.x)]) == gen, bar);
            __builtin_amdgcn_fence(__ATOMIC_ACQUIRE, "agent");
            asm volatile("s_waitcnt vmcnt(0)" ::: "memory");
        }
    }
    __syncthreads();
}

using pg8::bf16_t; using pg8::f32x4; using pg8::u32x4; using pg8::cvt_pk_bf16;
typedef unsigned u32x2 __attribute__((ext_vector_type(2)));

constexpr int T = 8192, D = 1024, DFF = 2816, DMIX = 512, NPROJ = 7936, NIN = 7792, NSM = 2560, KSM = 384, NT = 512, LDS_STAGE = 131072, LDS_BYTES = LDS_STAGE + 16;
constexpr int C_GLA = 1296, C_RW = 2864, C_GATE = 4720;
constexpr size_t WS_ADA = 0;
constexpr size_t WS_WGU = WS_ADA + 2ull * 5 * 9216 * 4;
constexpr size_t WS_WD = WS_WGU + 5632ull * 1024 * 2;
constexpr size_t WS_WIN = WS_WD + 1024ull * 2816 * 2;
constexpr size_t WS_WBO = WS_WIN + (size_t)NPROJ * 1024 * 2;
constexpr size_t WS_WOUT = WS_WBO + 3ull * 1024 * 512 * 2;
constexpr size_t WS_WSM = WS_WOUT + 1024ull * 1024 * 2;
constexpr size_t WS_H = WS_WSM + (size_t)NSM * KSM * 2;
constexpr size_t WS_PROJ = WS_H + (size_t)T * D * 2;
constexpr size_t WS_RW = WS_PROJ + (size_t)T * NPROJ * 2;
constexpr size_t WS_LOWA = WS_RW + 4ull * T * DMIX * 2;
constexpr size_t WS_SMALL = WS_LOWA + (size_t)T * KSM * 2;
constexpr size_t WS_OUT = WS_SMALL + (size_t)T * NSM * 2;
constexpr size_t WS_BAR = WS_OUT + 6ull * T * DMIX * 2;
constexpr size_t WS_END = WS_BAR + XCD_BAR_WORDS * 4;
constexpr size_t WS_XBC = WS_WGU;
constexpr size_t WS_DT = WS_XBC + (size_t)T * 768 * 2;
static_assert(WS_DT + (size_t)T * 16 * 4 <= WS_WIN, "xbc alias");
constexpr size_t OUT_SSD = 8388608, OUT_GLA = OUT_SSD + 2097152, OUT_RWK = OUT_GLA + 2097152;

struct Args { const float* in[39]; float* out; unsigned char* ws; int ph_lo, ph_hi; };

struct Ctx {
    const float* const* in; float* out; unsigned char* ws; LAS unsigned char* lds; int tid, lane, wid, G, bid, gw, NW;
    __device__ __forceinline__ float* X_() const { return out; }
    __device__ __forceinline__ float* ADA_() const { return (float*)(ws + WS_ADA); }
    __device__ __forceinline__ bf16_t* WGU_() const { return (bf16_t*)(ws + WS_WGU); }
    __device__ __forceinline__ bf16_t* WD_() const { return (bf16_t*)(ws + WS_WD); }
    __device__ __forceinline__ bf16_t* WIN_() const { return (bf16_t*)(ws + WS_WIN); }
    __device__ __forceinline__ bf16_t* WBO_() const { return (bf16_t*)(ws + WS_WBO); }
    __device__ __forceinline__ bf16_t* WOUT_() const { return (bf16_t*)(ws + WS_WOUT); }
    __device__ __forceinline__ bf16_t* WSM_() const { return (bf16_t*)(ws + WS_WSM); }
    __device__ __forceinline__ bf16_t* H_() const { return (bf16_t*)(ws + WS_H); }
    __device__ __forceinline__ bf16_t* PROJ_() const { return (bf16_t*)(ws + WS_PROJ); }
    __device__ __forceinline__ bf16_t* RWR_() const { return (bf16_t*)(ws + WS_RW); }
    __device__ __forceinline__ bf16_t* RWK_() const { return (bf16_t*)(ws + WS_RW) + (size_t)T * DMIX; }
    __device__ __forceinline__ bf16_t* RWV_() const { return (bf16_t*)(ws + WS_RW) + (size_t)2 * T * DMIX; }
    __device__ __forceinline__ bf16_t* RWKK_() const { return (bf16_t*)(ws + WS_RW) + (size_t)3 * T * DMIX; }
    __device__ __forceinline__ bf16_t* LOWA_() const { return (bf16_t*)(ws + WS_LOWA); }
    __device__ __forceinline__ bf16_t* SMALL_() const { return (bf16_t*)(ws + WS_SMALL); }
    __device__ __forceinline__ bf16_t* OUTS_() const { return (bf16_t*)(ws + WS_OUT); }
    __device__ __forceinline__ bf16_t* XBC_() const { return (bf16_t*)(ws + WS_XBC); }
    __device__ __forceinline__ float* DT_() const { return (float*)(ws + WS_DT); }
};

__device__ __forceinline__ float bf2f(bf16_t v) { return __uint_as_float((unsigned)v << 16); }
__device__ __forceinline__ float bflo(unsigned v) { return __uint_as_float(v << 16); }
__device__ __forceinline__ float bfhi(unsigned v) { return __uint_as_float(v & 0xffff0000u); }
__device__ __forceinline__ bf16_t f2bf(float f) { return (bf16_t)(cvt_pk_bf16(f, 0.f) & 0xffffu); }
__device__ __forceinline__ float sigmoidf_(float x) { return __builtin_amdgcn_rcpf(1.0f + __expf(-x)); }
__device__ __forceinline__ float siluf_(float x) { return x * __builtin_amdgcn_rcpf(1.0f + __expf(-x)); }
__device__ __forceinline__ float softplusf_(float x) { return fmaxf(x, 0.f) + __logf(1.0f + __expf(-fabsf(x))); }
__device__ __forceinline__ void unpack8(const u32x4 w, float* f) { f[0] = bflo(w.x); f[1] = bfhi(w.x); f[2] = bflo(w.y); f[3] = bfhi(w.y); f[4] = bflo(w.z); f[5] = bfhi(w.z); f[6] = bflo(w.w); f[7] = bfhi(w.w); }
__device__ __forceinline__ u32x4 pack8(const float* f) { u32x4 w; w.x = cvt_pk_bf16(f[0], f[1]); w.y = cvt_pk_bf16(f[2], f[3]); w.z = cvt_pk_bf16(f[4], f[5]); w.w = cvt_pk_bf16(f[6], f[7]); return w; }
__device__ __forceinline__ float shx(float x, int lane, int m) { return __int_as_float(__builtin_amdgcn_ds_bpermute((lane ^ m) << 2, __float_as_int(x))); }
__device__ __forceinline__ float wave_sum(float x, int lane) { x += shx(x, lane, 32); x += shx(x, lane, 16); x += shx(x, lane, 8); x += shx(x, lane, 4); x += shx(x, lane, 2); x += shx(x, lane, 1); return x; }
__device__ __forceinline__ float red8(float x, int lane) { x += shx(x, lane, 1); x += shx(x, lane, 2); x += shx(x, lane, 4); return x; }
template <int CTRL> __device__ __forceinline__ float dppf(float x) { return __int_as_float(__builtin_amdgcn_update_dpp(0, __float_as_int(x), CTRL, 0xF, 0xF, true)); }
__device__ __forceinline__ float dred8(float x) { x += dppf<0xB1>(x); x += dppf<0x4E>(x); x += dppf<0x141>(x); return x; }
__device__ __forceinline__ int cond_of_row(int r) { return r < 4096 ? 0 : 1 + ((r - 4096) >> 10); }

template <class F>
__device__ __forceinline__ int conv_tiles(const Ctx& c, F colptr, int ld, bf16_t* dst, int K, int N, int base) {
    LAS float* tile = (LAS float*)c.lds;
    const int nkt = K / 64, ntl = (N / 256) * nkt;
    int first = (c.bid - (base % c.G) + c.G) % c.G;
    for (int tl = first; tl < ntl; tl += c.G) {
        const int n0 = (tl / nkt) * 256, k0 = (tl % nkt) * 64;
        const int n4 = c.lane * 4;
        const float* p = colptr(n0 + n4);
        f32x4 v[8];
#pragma unroll
        for (int j = 0; j < 8; ++j) { const int k = c.wid + 8 * j; v[j] = p ? *(const f32x4*)(p + (size_t)(k0 + k) * ld) : (f32x4){0.f, 0.f, 0.f, 0.f}; }
#pragma unroll
        for (int j = 0; j < 8; ++j) { const int k = c.wid + 8 * j; LAS float* t = tile + k * 257 + n4; t[0] = v[j][0]; t[1] = v[j][1]; t[2] = v[j][2]; t[3] = v[j][3]; }
        __syncthreads();
        const int kc = c.tid & 7, nn0 = c.tid >> 3;
#pragma unroll
        for (int j = 0; j < 4; ++j) { const int n = nn0 + 64 * j; float f[8];
#pragma unroll
            for (int i = 0; i < 8; ++i) f[i] = tile[(kc * 8 + i) * 257 + n];
            *(u32x4*)(dst + (size_t)(n0 + n) * K + k0 + kc * 8) = pack8(f); }
        __syncthreads();
    }
    return base + ntl;
}
struct ColGU { const float* g; const float* u; __device__ const float* operator()(int n) const { const int pn = n >> 8, bj = (n >> 7) & 1, i = n & 127; return g + (u - g) * (long)bj + pn * 128 + i; } };
struct ColPlain { const float* w; int nvalid; __device__ const float* operator()(int n) const { return n < nvalid ? w + n : nullptr; } };

__device__ __forceinline__ int convert_ffn(const Ctx& c, int l, int f, int base) {
    const size_t o = ((size_t)l * 2 + f) * 1024 * 2816;
    base = conv_tiles(c, ColGU{c.in[10] + o, c.in[11] + o}, DFF, c.WGU_(), 1024, 5632, base);
    return conv_tiles(c, ColPlain{c.in[12] + o, 1024}, 1024, c.WD_(), DFF, 1024, base);
}
__device__ __forceinline__ void convert_mixer(const Ctx& c, int l, int base) {
    base = conv_tiles(c, ColPlain{c.in[13] + (size_t)l * 1024 * NIN, NIN}, NIN, c.WIN_(), 1024, NPROJ, base);
    base = conv_tiles(c, ColPlain{c.in[20] + (size_t)l * 512 * 1024, 1024}, 1024, c.WBO_(), 512, 1024, base);
    base = conv_tiles(c, ColPlain{c.in[24] + (size_t)l * 512 * 1024, 1024}, 1024, c.WBO_() + 1024 * 512, 512, 1024, base);
    base = conv_tiles(c, ColPlain{c.in[36] + (size_t)l * 512 * 1024, 1024}, 1024, c.WBO_() + 2 * 1024 * 512, 512, 1024, base);
    base = conv_tiles(c, ColPlain{c.in[37] + (size_t)l * 1024 * 1024, 1024}, 1024, c.WOUT_(), 1024, 1024, base);
    const float* w2 = c.in[27] + (size_t)l * 2 * 64 * 512; const float* a2 = c.in[29] + (size_t)l * 64 * 512; const float* g2 = c.in[30] + (size_t)l * 128 * 512; const float* gk = c.in[21] + (size_t)l * 2 * 16 * 256;
    for (int i = c.bid * NT + c.tid; i < NSM * KSM; i += c.G * NT) {
        const int n = i / KSM, k = i % KSM; float v = 0.f;
        if (n < 512) { if (k < 64) v = w2[k * 512 + n]; }
        else if (n < 1024) { if (k >= 64 && k < 128) v = w2[64 * 512 + (k - 64) * 512 + (n - 512)]; }
        else if (n < 1536) { if (k >= 128 && k < 192) v = a2[(k - 128) * 512 + (n - 1024)]; }
        else if (n < 2048) { if (k >= 192 && k < 320) v = g2[(k - 192) * 512 + (n - 1536)]; }
        else if (n < 2304) { if (k >= 320 && k < 336) v = gk[(k - 320) * 256 + (n - 2048)]; }
        else { if (k >= 336 && k < 352) v = gk[16 * 256 + (k - 336) * 256 + (n - 2304)]; }
        c.WSM_()[i] = f2bf(v);
    }
}

__device__ void phase_init(const Ctx& c) {
    const float* xp = c.in[0]; const float* xs = c.in[1];
    for (int i = c.bid * NT + c.tid; i < T * D / 4; i += c.G * NT) {
        const int r = i >> 8, c4 = (i & 255) * 4;
        f32x4 v;
        if (r < 4096) v = *(const f32x4*)(xp + (size_t)r * D + c4);
        else {
            v = *(const f32x4*)(xs + (size_t)(r - 4096) * D + c4);
            const int t = (r - 4096) & 1023, gr = t >> 6, gc = t & 63;
#pragma unroll
            for (int j = 0; j < 4; ++j) { const int cc = c4 + j, seg = cc >> 8, ii = cc & 255;
                const float omega = __expf(-(float)ii * (9.210340371976184f / 256.0f)); const float ang = (float)(seg < 2 ? gr : gc) * omega;
                v[j] += (seg & 1) ? __cosf(ang) : __sinf(ang); }
        }
        *(f32x4*)(c.X_() + (size_t)r * D + c4) = v;
    }
    LAS float* sc = (LAS float*)c.lds;
    LAS float* red = sc + 5 * 1024;
    for (int i = c.tid; i < 5 * 1024; i += NT) { const int cd = i >> 10, k = i & 1023; const float x = cd == 0 ? c.in[6][k] : c.in[5][(cd - 1) * 1024 + k]; sc[i] = siluf_(x); }
    __syncthreads();
    for (int it = c.bid; it < 288; it += c.G) {
        const int l = it / 144, n0 = (it % 144) * 64, c4 = (c.tid & 15) * 4, kg = c.tid >> 4;
        const float* w = c.in[8] + (size_t)l * 1024 * 9216 + n0 + c4;
        f32x4 a0 = (f32x4){0.f, 0.f, 0.f, 0.f}, a1 = a0, a2 = a0, a3 = a0, a4 = a0;
#pragma unroll 8
        for (int k = kg * 32; k < kg * 32 + 32; ++k) { const f32x4 wv = *(const f32x4*)(w + (size_t)k * 9216); a0 += wv * sc[k]; a1 += wv * sc[1024 + k]; a2 += wv * sc[2048 + k]; a3 += wv * sc[3072 + k]; a4 += wv * sc[4096 + k]; }
        *(LAS f32x4*)(red + (kg * 5 + 0) * 64 + c4) = a0; *(LAS f32x4*)(red + (kg * 5 + 1) * 64 + c4) = a1; *(LAS f32x4*)(red + (kg * 5 + 2) * 64 + c4) = a2; *(LAS f32x4*)(red + (kg * 5 + 3) * 64 + c4) = a3; *(LAS f32x4*)(red + (kg * 5 + 4) * 64 + c4) = a4;
        __syncthreads();
        if (c.tid < 320) { const int cd = c.tid >> 6, cl = c.tid & 63; float s = c.in[9][l * 9216 + n0 + cl];
#pragma unroll
            for (int g = 0; g < 32; ++g) s += red[(g * 5 + cd) * 64 + cl];
            c.ADA_()[(l * 5 + cd) * 9216 + n0 + cl] = s; }
        __syncthreads();
    }
}

__device__ void phase_norm(const Ctx& c, int l, int which, bool addP) {
    const bf16_t* P = c.OUTS_();
    const float* g = c.in[7] + (l * 3 + which) * 1024;
    for (int r = c.gw; r < T; r += c.NW) {
        float* xr = c.X_() + (size_t)r * D; f32x4 v[4]; float ss = 0.f;
#pragma unroll
        for (int j = 0; j < 4; ++j) { v[j] = *(const f32x4*)(xr + (c.lane + 64 * j) * 4); if (addP) { const u32x2 pw = *(const u32x2*)(P + (size_t)r * D + (c.lane + 64 * j) * 4), pv = *(const u32x2*)(P + (size_t)T * D + (size_t)r * D + (c.lane + 64 * j) * 4); v[j] = v[j] + ((f32x4){bflo(pw.x), bfhi(pw.x), bflo(pw.y), bfhi(pw.y)} + (f32x4){bflo(pv.x), bfhi(pv.x), bflo(pv.y), bfhi(pv.y)}); *(f32x4*)(xr + (c.lane + 64 * j) * 4) = v[j]; } ss += v[j][0] * v[j][0] + v[j][1] * v[j][1] + v[j][2] * v[j][2] + v[j][3] * v[j][3]; }
        ss = wave_sum(ss, c.lane); const float rs = rsqrtf(ss * (1.0f / 1024.0f) + 1e-6f);
        const float* sh = c.ADA_() + (l * 5 + cond_of_row(r)) * 9216 + (which * 3) * 1024; const float* scl = sh + 1024;
#pragma unroll
        for (int j = 0; j < 4; ++j) { const int cc = (c.lane + 64 * j) * 4; const f32x4 gg = *(const f32x4*)(g + cc), s1 = *(const f32x4*)(scl + cc), s0 = *(const f32x4*)(sh + cc);
            const f32x4 o = v[j] * rs * gg * (s1 + 1.0f) + s0; u32x2 w; w.x = cvt_pk_bf16(o[0], o[1]); w.y = cvt_pk_bf16(o[2], o[3]); *(u32x2*)(c.H_() + (size_t)r * D + cc) = w; }
    }
}
__device__ void phase_final_norm(const Ctx& c) {
    const float* g = c.in[38]; const bf16_t* P = c.OUTS_();
    for (int r = c.gw; r < T; r += c.NW) {
        float* xr = c.X_() + (size_t)r * D; f32x4 v[4]; float ss = 0.f;
#pragma unroll
        for (int j = 0; j < 4; ++j) { const u32x2 pw = *(const u32x2*)(P + (size_t)r * D + (c.lane + 64 * j) * 4), pv = *(const u32x2*)(P + (size_t)T * D + (size_t)r * D + (c.lane + 64 * j) * 4); v[j] = *(const f32x4*)(xr + (c.lane + 64 * j) * 4) + ((f32x4){bflo(pw.x), bfhi(pw.x), bflo(pw.y), bfhi(pw.y)} + (f32x4){bflo(pv.x), bfhi(pv.x), bflo(pv.y), bfhi(pv.y)}); ss += v[j][0] * v[j][0] + v[j][1] * v[j][1] + v[j][2] * v[j][2] + v[j][3] * v[j][3]; }
        ss = wave_sum(ss, c.lane); const float rs = rsqrtf(ss * (1.0f / 1024.0f) + 1e-6f);
#pragma unroll
        for (int j = 0; j < 4; ++j) { const int cc = (c.lane + 64 * j) * 4; *(f32x4*)(xr + cc) = v[j] * rs * *(const f32x4*)(g + cc); }
    }
}

struct EpiGU { static constexpr bool PERM = true, AFTER_DRAIN = false; bf16_t* O;
    __device__ __forceinline__ void operator()(const f32x4 (&acc)[2][2][4][2], const pg8::Unit& u, int wr, int wc, int fr, int fq) const {
        const int row0 = u.pm * 256 + wr * 64 + fr, col0 = u.pn * 128 + wc * 32 + 8 * fq;
#pragma unroll
        for (int ai = 0; ai < 2; ++ai)
#pragma unroll
            for (int m = 0; m < 4; ++m) { float o[8];
#pragma unroll
                for (int n = 0; n < 2; ++n)
#pragma unroll
                    for (int j = 0; j < 4; ++j) o[n * 4 + j] = siluf_(acc[ai][0][m][n][j]) * acc[ai][1][m][n][j];
                *(u32x4*)(O + (size_t)(row0 + ai * 128 + m * 16) * DFF + col0) = pack8(o); }
    } };
struct EpiResid { static constexpr bool PERM = false, AFTER_DRAIN = false; bf16_t* P; const float* gate; float s;
    __device__ __forceinline__ void operator()(const f32x4 (&acc)[2][2][4][2], const pg8::Unit& u, int wr, int wc, int fr, int fq) const {
        const int pn = u.pn & 3, kh = u.pn >> 2;
        const int row0 = u.pm * 256 + wr * 64 + fr, col0 = pn * 256 + wc * 32 + 4 * fq; const int cd = cond_of_row(u.pm * 256);
        f32x4 gv[2][2];
#pragma unroll
        for (int bj = 0; bj < 2; ++bj)
#pragma unroll
            for (int n = 0; n < 2; ++n) gv[bj][n] = *(const f32x4*)(gate + cd * 9216 + col0 + bj * 128 + n * 16) * s;
        bf16_t* base = P + (size_t)kh * T * D;
#pragma unroll
        for (int ai = 0; ai < 2; ++ai)
#pragma unroll
            for (int m = 0; m < 4; ++m) { const size_t off = (size_t)(row0 + ai * 128 + m * 16) * D + col0;
#pragma unroll
                for (int bj = 0; bj < 2; ++bj)
#pragma unroll
                    for (int n = 0; n < 2; ++n) { const f32x4 v = acc[ai][bj][m][n] * gv[bj][n]; u32x2 w; w.x = cvt_pk_bf16(v[0], v[1]); w.y = cvt_pk_bf16(v[2], v[3]); *(u32x2*)(base + off + bj * 128 + n * 16) = w; } }
    } };
struct EpiProj { static constexpr bool PERM = true, AFTER_DRAIN = false; bf16_t* O; int ldc;
    __device__ __forceinline__ void operator()(const f32x4 (&acc)[2][2][4][2], const pg8::Unit& u, int wr, int wc, int fr, int fq) const {
        const int row0 = u.pm * 256 + wr * 64 + fr, col0 = u.pn * 256 + wc * 32 + 8 * fq;
#pragma unroll
        for (int ai = 0; ai < 2; ++ai)
#pragma unroll
            for (int m = 0; m < 4; ++m) { bf16_t* rowp = O + (size_t)(row0 + ai * 128 + m * 16) * ldc + col0;
#pragma unroll
                for (int bj = 0; bj < 2; ++bj) { const f32x4 v0 = acc[ai][bj][m][0], v1 = acc[ai][bj][m][1]; u32x4 w; w.x = cvt_pk_bf16(v0[0], v0[1]); w.y = cvt_pk_bf16(v0[2], v0[3]); w.z = cvt_pk_bf16(v1[0], v1[1]); w.w = cvt_pk_bf16(v1[2], v1[3]);
                    *(u32x4*)(rowp + bj * 128) = w; } }
    } };
struct EpiSmall { static constexpr bool PERM = true, AFTER_DRAIN = false; bf16_t* O; const float* w0; const float* a0; bf16_t* rwk; const bf16_t* rwkk; const float* ka;
    __device__ __forceinline__ void operator()(const f32x4 (&acc)[2][2][4][2], const pg8::Unit& u, int wr, int wc, int fr, int fq) const {
        const int row0 = u.pm * 256 + wr * 64 + fr, col0 = u.pn * 256 + wc * 32 + 8 * fq;
        const int kind = u.pn < 4 ? 0 : (u.pn < 6 ? 2 : 3);
        const float* bias = kind == 0 ? w0 : (kind == 2 ? a0 - 1024 : w0 - 1536);
        const float bsc = kind == 3 ? 0.f : 1.f;
#pragma unroll
        for (int bj = 0; bj < 2; ++bj) { const int cc = col0 + bj * 128; const f32x4 b0 = *(const f32x4*)(bias + cc) * bsc, b1 = *(const f32x4*)(bias + cc + 4) * bsc;
#pragma unroll
            for (int ai = 0; ai < 2; ++ai)
#pragma unroll
                for (int m = 0; m < 4; ++m) { const size_t row = row0 + ai * 128 + m * 16; const f32x4 x0 = acc[ai][bj][m][0] + b0, x1 = acc[ai][bj][m][1] + b1; float o[8];
#pragma unroll
                    for (int j = 0; j < 8; ++j) { const float x = j < 4 ? x0[j & 3] : x1[j & 3];
                        const float sg = __builtin_amdgcn_rcpf(1.0f + __expf(-x));
                        const float y01 = 1.0f - __expf(-sg * 0.60653066f);
                        o[j] = kind == 0 ? y01 : (kind == 2 ? sg : x); }
                    if (kind == 2) { float kv[8], kkv[8]; bf16_t* kp = rwk + row * 512 + (cc - 1024); unpack8(*(const u32x4*)kp, kv); unpack8(*(const u32x4*)(rwkk + row * 512 + (cc - 1024)), kkv);
                        const f32x4 ka0 = *(const f32x4*)(ka + cc - 1024), ka1 = *(const f32x4*)(ka + cc - 1024 + 4);
#pragma unroll
                        for (int j = 0; j < 8; ++j) { const float av = o[j], kaj = j < 4 ? ka0[j & 3] : ka1[j & 3]; kv[j] = kv[j] * (1.0f + (av - 1.0f) * kaj); o[j] = kkv[j] * av; }
                        *(u32x4*)kp = pack8(kv); }
                    *(u32x4*)(O + row * NSM + cc) = pack8(o); }
            asm volatile("" ::: "memory"); }
    } };
struct EpiBranch { static constexpr bool PERM = true, AFTER_DRAIN = false; bf16_t* M; const bf16_t* gates;
    __device__ __forceinline__ void operator()(const f32x4 (&acc)[2][2][4][2], const pg8::Unit& u, int wr, int wc, int fr, int fq) const {
        int upm = u.pm, upn = u.pn; asm volatile("" : "+s"(upm), "+s"(upn));
        const int b = upn >> 2, pn = upn & 3; const float keep = b ? 1.0f : 0.0f;
        const int row0 = upm * 256 + wr * 64 + fr, col0 = pn * 256 + wc * 32 + 8 * fq; const bf16_t* gb = gates + b * 1024;
#pragma unroll
        for (int ai = 0; ai < 2; ++ai)
#pragma unroll
            for (int m = 0; m < 4; ++m) { const int row = row0 + ai * 128 + m * 16;
#pragma unroll
                for (int bj = 0; bj < 2; ++bj) { const int cc = col0 + bj * 128; float gt[8], o[8];
                    unpack8(*(const u32x4*)(gb + (size_t)row * NPROJ + cc), gt);
                    bf16_t* mp = M + (size_t)row * D + cc;
                    unpack8(*(const u32x4*)mp, o);
#pragma unroll
                    for (int j = 0; j < 8; ++j) o[j] = o[j] * keep + sigmoidf_(gt[j]) * acc[ai][bj][m][j >> 2][j & 3];
                    *(u32x4*)mp = pack8(o); }
                asm volatile("" ::: "memory"); }
    } };

#ifndef GP_ALIGN
#define GP_ALIGN true
#endif
#ifndef GP_SP2
#define GP_SP2 true
#endif
template <class Epi>
__device__ __forceinline__ void run_gemm(const Ctx& c, const bf16_t* A, const bf16_t* Bt, int N, int K, const Epi& E, int ksplit = 1) {
    int Kl = K / ksplit; asm volatile("" : "+s"(Kl));
    pg8::Gemm g{A, Bt, T, N * ksplit, Kl, K, N / 256, (size_t)Kl * 2, (size_t)Kl * 2}; pg8::StaticOrder S; S.init(T, N * ksplit, c.G, c.bid);
    pg8::gemm_phase<Epi, pg8::StaticOrder, GP_ALIGN, GP_SP2>(c.lds, g, S, E);
}

struct BranchOrder { int c;
    __device__ bool next(int i, pg8::Unit& u) const { if (c >= 128 || i >= 3) return false; u.pm = c >> 2; u.pn = (c & 3) + 4 * i; return true; }
    __device__ __forceinline__ void a_ready(const pg8::Unit&) const {}
    __device__ __forceinline__ void done(const pg8::Unit&) const {}
};
__device__ __forceinline__ void ldf8(const float* p, float* f) { const f32x4 a = *(const f32x4*)p, b = *(const f32x4*)(p + 4); f[0] = a[0]; f[1] = a[1]; f[2] = a[2]; f[3] = a[3]; f[4] = b[0]; f[5] = b[1]; f[6] = b[2]; f[7] = b[3]; }
__device__ void phase_prepass(const Ctx& c, int l) {
    const float* cw = c.in[14] + l * 3 * 768; const float* cb = c.in[15] + l * 768; const float* dtb = c.in[16] + l * 16;
    const float* mu = c.in[25] + l * 1856; const float* rkk = c.in[31] + l * 512; const float* gkw = c.in[21] + l * 2 * 16 * 256; const float* gkb = c.in[22] + l * 512;
    const int lane = c.lane;
    for (int r = c.gw; r < T; r += c.NW) {
        int t, L; if (r < 4096) { t = r & 255; L = 256; } else { t = (r - 4096) & 1023; L = 1024; }
        const bool hp = t > 0, hn = t < L - 1;
        const bf16_t* p0 = c.PROJ_() + (size_t)r * NPROJ; const bf16_t* pm = hp ? p0 - NPROJ : p0; const bf16_t* pn = hn ? p0 + NPROJ : p0;
        const float fp = hp ? 1.f : 0.f, fn = hn ? 1.f : 0.f;
#pragma unroll
        for (int it = 0; it < 2; ++it) { const int g = lane + 64 * it; if (g < 96) { const int cc = g * 8; float x0[8], xm[8], xn[8], w0[8], w1[8], w2[8], bb[8], o[8];
            unpack8(*(const u32x4*)(p0 + 512 + cc), x0); unpack8(*(const u32x4*)(pm + 512 + cc), xm); unpack8(*(const u32x4*)(pn + 512 + cc), xn);
            ldf8(cw + cc, w0); ldf8(cw + 768 + cc, w1); ldf8(cw + 1536 + cc, w2); ldf8(cb + cc, bb);
#pragma unroll
            for (int j = 0; j < 8; ++j) o[j] = siluf_(bb[j] + w0[j] * xm[j] * fp + w1[j] * x0[j] + w2[j] * xn[j] * fn);
            *(u32x4*)(c.XBC_() + (size_t)r * 768 + cc) = pack8(o); } }
        if (lane < 16) c.DT_()[r * 16 + lane] = softplusf_(bf2f(p0[1280 + lane]) + dtb[lane]);
#pragma unroll
        for (int it = 0; it < 4; ++it) { const int g = lane + 64 * it; if (g < 232) { const int cc = g * 8; float x0[8], xm[8], xn[8], m8[8], o[8];
            unpack8(*(const u32x4*)(p0 + C_RW + cc), x0); unpack8(*(const u32x4*)(pm + C_RW + cc), xm); unpack8(*(const u32x4*)(pn + C_RW + cc), xn); ldf8(mu + cc, m8);
#pragma unroll
            for (int j = 0; j < 8; ++j) o[j] = x0[j] + (0.5f * (xm[j] * fp + xn[j] * fn) - x0[j]) * m8[j];
            if (it == 0) *(u32x4*)(c.RWR_() + (size_t)r * 512 + cc) = pack8(o);
            else if (it == 1) { const int ck = cc - 512; *(u32x4*)(c.RWK_() + (size_t)r * 512 + ck) = pack8(o); float kw[8], kq[8]; ldf8(rkk + ck, kw); float ss = 0.f;
#pragma unroll
                for (int j = 0; j < 8; ++j) { kq[j] = o[j] * kw[j]; ss += kq[j] * kq[j]; }
                ss = dred8(ss); const float inv = 1.0f / fmaxf(sqrtf(ss), 1e-12f);
#pragma unroll
                for (int j = 0; j < 8; ++j) kq[j] *= inv;
                *(u32x4*)(c.RWKK_() + (size_t)r * 512 + ck) = pack8(kq); }
            else if (it == 2) *(u32x4*)(c.RWV_() + (size_t)r * 512 + (cc - 1024)) = pack8(o);
            else { const int cl = cc - 1536;
#pragma unroll
                for (int j = 0; j < 8; ++j) { const float e2 = __expf(2.0f * o[j]); const float th = 1.0f - 2.0f / (1.0f + e2); const float sg = sigmoidf_(o[j]); o[j] = cl < 128 ? th : (cl < 192 ? o[j] : sg); }
                *(u32x4*)(c.LOWA_() + (size_t)r * KSM + cl) = pack8(o); } } }
        if (lane < 8) *(u32x4*)(c.LOWA_() + (size_t)r * KSM + 320 + lane * 8) = (u32x4){0u, 0u, 0u, 0u};
        {
            const int d = lane >> 5, cg = lane & 31; const float* gwp = gkw + d * 16 * 256 + cg * 8; float lr[16], acc[8];
            unpack8(*(const u32x4*)(p0 + C_GLA + 1536 + d * 16), lr); unpack8(*(const u32x4*)(p0 + C_GLA + 1536 + d * 16 + 8), lr + 8); ldf8(gkb + d * 256 + cg * 8, acc);
#pragma unroll
            for (int i = 0; i < 16; ++i) { float w[8]; ldf8(gwp + i * 256, w);
#pragma unroll
                for (int j = 0; j < 8; ++j) acc[j] += lr[i] * w[j]; }
#pragma unroll
            for (int j = 0; j < 8; ++j) acc[j] = 1.0f - __expf(softplusf_(-acc[j]) * (-1.0f / 16.0f));
            *(u32x4*)(c.SMALL_() + (size_t)r * NSM + 2048 + d * 256 + cg * 8) = pack8(acc); }
    }
}

struct SeqInfo { int L, row0, b, ctx; };
__device__ __forceinline__ SeqInfo seq_info(int s) { SeqInfo q; if (s < 16) { q.L = 256; q.row0 = s * 256; q.b = s; q.ctx = 1; } else { q.L = 1024; q.row0 = 4096 + (s - 16) * 1024; q.b = s - 16; q.ctx = 0; } return q; }

#ifndef PF_SSD
#define PF_SSD 8
#endif
#ifndef PF_GLA
#define PF_GLA 4
#endif
#ifndef PF_RW
#define PF_RW 2
#endif
__device__ __forceinline__ u32x4 ldu16(const bf16_t* ub, unsigned lo) { return *(const u32x4*)((const char*)ub + lo); }
__device__ __forceinline__ bf16_t ldu2(const bf16_t* ub, unsigned lo) { return *(const bf16_t*)((const char*)ub + lo); }
__device__ __forceinline__ float sel8(const float (&y)[8], int k) { float v = y[0]; v = k == 1 ? y[1] : v; v = k == 2 ? y[2] : v; v = k == 3 ? y[3] : v; v = k == 4 ? y[4] : v; v = k == 5 ? y[5] : v; v = k == 6 ? y[6] : v; v = k == 7 ? y[7] : v; return v; }

constexpr int REC = 336;
__device__ __forceinline__ void st8(LAS float* p, const u32x4 w) { float f[8]; unpack8(w, f); *(LAS f32x4*)p = (f32x4){f[0], f[1], f[2], f[3]}; *(LAS f32x4*)(p + 4) = (f32x4){f[4], f[5], f[6], f[7]}; }
__device__ __forceinline__ void ld8(const LAS float* p, float* f) { const f32x4 a = *(const LAS f32x4*)p, b = *(const LAS f32x4*)(p + 4); f[0] = a[0]; f[1] = a[1]; f[2] = a[2]; f[3] = a[3]; f[4] = b[0]; f[5] = b[1]; f[6] = b[2]; f[7] = b[3]; }

__device__ void scan_ssd(const Ctx& c, int l, int s, int dir, int hs) {
    const SeqInfo q = seq_info(s); const int h = hs >> 3, rg = hs & 7, lane = c.lane, r = lane >> 3, p = rg * 8 + r, np = lane & 7, g = h >> 2;
    float S[8];
    if (!q.ctx) { const float* st = c.in[2] + ((((size_t)q.b * 2 + l) * 2 + dir) * 8 + h) * 4096 + p * 64 + np * 8; const f32x4 a = *(const f32x4*)st, b = *(const f32x4*)(st + 4);
        S[0] = a[0]; S[1] = a[1]; S[2] = a[2]; S[3] = a[3]; S[4] = b[0]; S[5] = b[1]; S[6] = b[2]; S[7] = b[3]; }
    else {
#pragma unroll
        for (int j = 0; j < 8; ++j) S[j] = 0.f; }
    const float adh = -__expf(c.in[17][l * 16 + dir * 8 + h]) * 1.44269504f;
    const long sgn = dir ? -1 : 1; const size_t rbase = (size_t)q.row0 + (dir ? q.L - 1 : 0);
    LAS float* lb = (LAS float*)c.lds + c.wid * (8 * REC); LAS float* wr = lb + r * REC + np * 8; const LAS float* rd = lb + np * 8;
    const char* gX = (const char*)(c.XBC_() + (rbase + sgn * r) * 768); const float* gD = c.DT_() + (rbase + sgn * r) * 16 + dir * 8 + h; const long cX = sgn * 8 * 768 * 2, cD = sgn * 8 * 16;
    const unsigned loB = (512 + g * 64 + np * 8) * 2, loX = (h * 64 + rg * 8 + np) * 2;
    bf16_t* O = c.OUTS_() + (size_t)(0 * 2 + dir) * T * DMIX + (rbase + sgn * np) * DMIX + h * 64 + p;
    u32x4 nB, nC; bf16_t nx; float ndt;
#define SSD_LOAD() { nB = *(const u32x4*)(gX + loB); nC = *(const u32x4*)(gX + loB + 256); nx = *(const bf16_t*)(gX + loX); ndt = *gD; gX += cX; gD += cD; }
#define SSD_STORE() { st8(wr, nB); st8(wr + 64, nC); lb[r * REC + 320 + np] = bf2f(nx); lb[r * REC + 328] = ndt; }
    SSD_LOAD(); SSD_STORE();
    for (int i0 = 0; i0 < q.L; i0 += 8) {
        SSD_LOAD();
        float outv = 0.f;
#pragma unroll
        for (int j = 0; j < 8; ++j) {
            float B[8], C[8]; ld8(rd + j * REC, B); ld8(rd + j * REC + 64, C); const float x = lb[j * REC + 320 + r], dtv = lb[j * REC + 328];
            const float da = __builtin_amdgcn_exp2f(dtv * adh), xd = x * dtv; float y0 = 0.f, y1 = 0.f;
#pragma unroll
            for (int k = 0; k < 8; k += 2) { S[k] = da * S[k] + xd * B[k]; S[k + 1] = da * S[k + 1] + xd * B[k + 1]; y0 += S[k] * C[k]; y1 += S[k + 1] * C[k + 1]; }
            { const float yv = dred8(y0 + y1); outv = (np == j) ? yv : outv; }
        }
        *O = f2bf(outv); O += sgn * 8 * DMIX;
        SSD_STORE();
    }
    if (q.ctx) { float* o = c.out + OUT_SSD + ((((size_t)q.b * 2 + l) * 2 + dir) * 8 + h) * 4096 + p * 64 + np * 8; *(f32x4*)o = (f32x4){S[0], S[1], S[2], S[3]}; *(f32x4*)(o + 4) = (f32x4){S[4], S[5], S[6], S[7]}; }
}

__device__ void scan_gla(const Ctx& c, int l, int s, int dir, int hs) {
    const SeqInfo q = seq_info(s); const int h = hs >> 4, cg8 = hs & 15, lane = c.lane, r = lane >> 3, v = cg8 * 8 + r, kp = lane & 7;
    float S[8];
    if (!q.ctx) { const float* st = c.in[3] + (((((size_t)q.b * 2 + l) * 2 + dir) * 4 + h) * 64 + kp * 8) * 128 + v;
#pragma unroll
        for (int j = 0; j < 8; ++j) S[j] = st[j * 128]; }
    else {
#pragma unroll
        for (int j = 0; j < 8; ++j) S[j] = 0.f; }
    const long sgn = dir ? -1 : 1; const size_t rbase = (size_t)q.row0 + (dir ? q.L - 1 : 0);
    LAS float* lb = (LAS float*)c.lds + c.wid * (8 * REC); LAS float* wr = lb + r * REC + kp * 8; const LAS float* rd = lb + kp * 8;
    const char* gP = (const char*)(c.PROJ_() + (rbase + sgn * r) * NPROJ); const char* gS = (const char*)(c.SMALL_() + (rbase + sgn * r) * NSM); const long cP = sgn * 8 * NPROJ * 2, cS = sgn * 8 * NSM * 2;
    const unsigned loQ = (C_GLA + h * 64 + kp * 8) * 2, loV = (C_GLA + 512 + h * 128 + cg8 * 8 + kp) * 2, loG = (2048 + dir * 256 + h * 64 + kp * 8) * 2;
    bf16_t* O = c.OUTS_() + (size_t)(1 * 2 + dir) * T * DMIX + (rbase + sgn * kp) * DMIX + h * 128 + v;
    u32x4 nQ, nK, nG; bf16_t nv;
#define GLA_LOAD() { nQ = *(const u32x4*)(gP + loQ); nK = *(const u32x4*)(gP + loQ + 512); nG = *(const u32x4*)(gS + loG); nv = *(const bf16_t*)(gP + loV); gP += cP; gS += cS; }
#define GLA_STORE() { st8(wr, nQ); st8(wr + 64, nK); st8(wr + 128, nG); lb[r * REC + 320 + kp] = bf2f(nv); }
    GLA_LOAD(); GLA_STORE();
    for (int i0 = 0; i0 < q.L; i0 += 8) {
        GLA_LOAD();
        float outv = 0.f;
#pragma unroll
        for (int j = 0; j < 8; ++j) {
            float Q[8], K[8], G[8]; ld8(rd + j * REC, Q); ld8(rd + j * REC + 64, K); ld8(rd + j * REC + 128, G); const float vv = lb[j * REC + 320 + r]; float o0 = 0.f, o1 = 0.f;
#pragma unroll
            for (int k = 0; k < 8; k += 2) { S[k] = (S[k] - S[k] * G[k]) + K[k] * vv; S[k + 1] = (S[k + 1] - S[k + 1] * G[k + 1]) + K[k + 1] * vv; o0 += Q[k] * S[k]; o1 += Q[k + 1] * S[k + 1]; }
            { const float yv = dred8(o0 + o1); outv = (kp == j) ? yv : outv; }
        }
        *O = f2bf(outv * 0.125f); O += sgn * 8 * DMIX;
        GLA_STORE();
    }
    if (q.ctx) { float* o = c.out + OUT_GLA + (((((size_t)q.b * 2 + l) * 2 + dir) * 4 + h) * 64 + kp * 8) * 128 + v;
#pragma unroll
        for (int j = 0; j < 8; ++j) o[j * 128] = S[j]; }
}

__device__ void scan_rwkv(const Ctx& c, int l, int s, int dir, int hs) {
    const SeqInfo q = seq_info(s); const int h = hs >> 3, rg = hs & 7, lane = c.lane, r = lane >> 3, vr = rg * 8 + r, kp = lane & 7;
    float S[8];
    if (!q.ctx) { const float* st = c.in[4] + ((((size_t)q.b * 2 + l) * 2 + dir) * 8 + h) * 4096 + vr * 64 + kp * 8; const f32x4 a = *(const f32x4*)st, b = *(const f32x4*)(st + 4);
        S[0] = a[0]; S[1] = a[1]; S[2] = a[2]; S[3] = a[3]; S[4] = b[0]; S[5] = b[1]; S[6] = b[2]; S[7] = b[3]; }
    else {
#pragma unroll
        for (int j = 0; j < 8; ++j) S[j] = 0.f; }
    const long sgn = dir ? -1 : 1; const size_t rbase = (size_t)q.row0 + (dir ? q.L - 1 : 0);
    constexpr size_t AS2 = (size_t)T * DMIX * 2;
    LAS float* lb = (LAS float*)c.lds + c.wid * (8 * REC); LAS float* wr = lb + r * REC + kp * 8; const LAS float* rd = lb + kp * 8;
    const char* gR = (const char*)(c.RWR_() + (rbase + sgn * r) * 512 + h * 64 + kp * 8); const char* gS = (const char*)(c.SMALL_() + (rbase + sgn * r) * NSM + h * 64 + kp * 8);
    const char* gV = (const char*)(c.RWV_() + (rbase + sgn * r) * 512 + h * 64 + rg * 8 + kp); const long cR = sgn * 8 * 512 * 2, cS = sgn * 8 * NSM * 2;
    const unsigned loW = dir * 1024;
    bf16_t* O = c.OUTS_() + (size_t)(2 * 2 + dir) * T * DMIX + (rbase + sgn * kp) * DMIX + h * 64 + vr;
    u32x4 nR, nK, nKK, nA, nW; bf16_t nv;
#define RW_LOAD() { nR = *(const u32x4*)gR; nK = *(const u32x4*)(gR + AS2); nKK = *(const u32x4*)(gR + 3 * AS2); nA = *(const u32x4*)(gS + 2048); nW = *(const u32x4*)(gS + loW); nv = *(const bf16_t*)gV; gR += cR; gS += cS; gV += cR; }
#define RW_STORE() { st8(wr, nR); st8(wr + 64, nK); st8(wr + 128, nKK); st8(wr + 192, nA); st8(wr + 256, nW); lb[r * REC + 320 + kp] = bf2f(nv); }
    RW_LOAD(); RW_STORE();
    for (int i0 = 0; i0 < q.L; i0 += 8) {
        RW_LOAD();
        float outv = 0.f;
#pragma unroll
        for (int j = 0; j < 8; ++j) {
            float R[8], K[8], KK[8], A[8], W[8]; ld8(rd + j * REC, R); ld8(rd + j * REC + 64, K); ld8(rd + j * REC + 128, KK); ld8(rd + j * REC + 192, A); ld8(rd + j * REC + 256, W); const float vv = lb[j * REC + 320 + r];
            float s0 = 0.f, s1 = 0.f;
#pragma unroll
            for (int k = 0; k < 8; k += 2) { s0 += S[k] * KK[k]; s1 += S[k + 1] * KK[k + 1]; }
            const float skk = dred8(s0 + s1); float o0 = 0.f, o1 = 0.f;
#pragma unroll
            for (int k = 0; k < 8; k += 2) {
                S[k] = (S[k] - S[k] * W[k]) - skk * A[k] + vv * K[k]; S[k + 1] = (S[k + 1] - S[k + 1] * W[k + 1]) - skk * A[k + 1] + vv * K[k + 1];
                o0 += S[k] * R[k]; o1 += S[k + 1] * R[k + 1]; }
            { const float yv = dred8(o0 + o1); outv = (kp == j) ? yv : outv; }
        }
        *O = f2bf(outv); O += sgn * 8 * DMIX;
        RW_STORE();
    }
    if (q.ctx) { float* o = c.out + OUT_RWK + ((((size_t)q.b * 2 + l) * 2 + dir) * 8 + h) * 4096 + vr * 64 + kp * 8; *(f32x4*)o = (f32x4){S[0], S[1], S[2], S[3]}; *(f32x4*)(o + 4) = (f32x4){S[4], S[5], S[6], S[7]}; }
}

__device__ __forceinline__ void scan_item(const Ctx& c, int l, int bit) {
    int br, s, sub;
    if (bit < 192) { br = bit % 3; const int n = bit / 3; s = 16 + (n >> 4); sub = n & 15; }
    else { const int b2 = bit - 192; br = b2 % 3; const int n = b2 / 3; s = n >> 4; sub = n & 15; }
    const int dir = sub >> 3, hs = (sub & 7) * 8 + c.wid;
#ifdef ONLY_BR
    if (br == ONLY_BR) { if (ONLY_BR == 0) scan_ssd(c, l, s, dir, hs); else if (ONLY_BR == 1) scan_gla(c, l, s, dir, hs); else scan_rwkv(c, l, s, dir, hs); }
#else
    if (br == 0) scan_ssd(c, l, s, dir, hs); else if (br == 1) scan_gla(c, l, s, dir, hs); else scan_rwkv(c, l, s, dir, hs);
#endif
}
__device__ void phase_scan(const Ctx& c, int l) {
    if (c.G == 256) {
        const int ty = c.bid & 3, ix = c.bid >> 2; const int n = ty == 0 ? 2 : (ty == 3 ? 7 : 3);
        for (int k = 0; k < n; ++k) {
            int it;
            if (ty == 0) it = k == 0 ? ix * 3 + 2 : 192 + ix * 3 + 0;
            else if (ty == 1) it = k == 0 ? ix * 3 + 1 : (k == 1 ? 192 + ix * 3 + 2 : 192 + ix * 3 + 1);
            else if (ty == 2) it = k == 0 ? ix * 3 + 0 : 192 + (64 + 2 * ix + (k - 1)) * 3 + 2;
            else it = k == 0 ? 192 + (192 + ix) * 3 + 2 : (k < 4 ? 192 + (64 + 3 * ix + (k - 1)) * 3 + 1 : 192 + (64 + 3 * ix + (k - 4)) * 3 + 0);
            scan_item(c, l, it);
        }
    } else { for (int it = c.bid; it < 960; it += c.G) scan_item(c, l, it); }
}

__device__ void phase_postpass(const Ctx& c, int l) {
    const int lane = c.lane, c0 = lane * 8;
    const float* Dp = c.in[18] + l * 16; const float* snorm = c.in[19] + l * 512; const float* gnorm = c.in[23] + l * 128;
    const float* rk = c.in[33] + l * 512; const float* lnw = c.in[34] + l * 512; const float* lnb = c.in[35] + l * 512;
    constexpr size_t SL = (size_t)T * DMIX;
    for (int r0 = c.gw; r0 < T; r0 += 2 * c.NW) {
        u32x4 q[2][13];
#pragma unroll
        for (int e = 0; e < 2; ++e) { const int r = min(r0 + e * c.NW, T - 1); const bf16_t* p0 = c.PROJ_() + (size_t)r * NPROJ; const bf16_t* of = c.OUTS_() + (size_t)r * DMIX + c0;
            q[e][0] = *(const u32x4*)of; q[e][1] = *(const u32x4*)(of + SL); q[e][2] = *(const u32x4*)(c.XBC_() + (size_t)r * 768 + c0); q[e][3] = *(const u32x4*)(p0 + c0);
            q[e][4] = *(const u32x4*)(of + 2 * SL); q[e][5] = *(const u32x4*)(of + 3 * SL); q[e][6] = *(const u32x4*)(p0 + C_GLA + 1024 + c0);
            q[e][7] = *(const u32x4*)(of + 4 * SL); q[e][8] = *(const u32x4*)(of + 5 * SL); q[e][9] = *(const u32x4*)(c.RWR_() + (size_t)r * 512 + c0); q[e][10] = *(const u32x4*)(c.RWK_() + (size_t)r * 512 + c0);
            q[e][11] = *(const u32x4*)(c.RWV_() + (size_t)r * 512 + c0); q[e][12] = *(const u32x4*)(c.SMALL_() + (size_t)r * NSM + 1536 + c0); }
#pragma unroll
        for (int e = 0; e < 2; ++e) { const int r = r0 + e * c.NW; if (r >= T) break;
            bf16_t* of = c.OUTS_() + (size_t)r * DMIX + c0;
            {
                float a[8], b[8], x[8], z[8], y[8]; unpack8(q[e][0], a); unpack8(q[e][1], b); unpack8(q[e][2], x); unpack8(q[e][3], z);
                const int h = lane >> 3; const float dsum = Dp[h] + Dp[8 + h]; float ss = 0.f;
#pragma unroll
                for (int j = 0; j < 8; ++j) { y[j] = (x[j] * dsum + a[j] + b[j]) * siluf_(z[j]); ss += y[j] * y[j]; }
                ss = wave_sum(ss, c.lane); const float rs = rsqrtf(ss * (1.0f / 512.0f) + 1e-6f);
#pragma unroll
                for (int j = 0; j < 8; ++j) y[j] = y[j] * rs * snorm[c0 + j];
                *(u32x4*)of = pack8(y);
            }
            {
                float a[8], b[8], g[8], y[8]; unpack8(q[e][4], a); unpack8(q[e][5], b); unpack8(q[e][6], g);
                float ss = 0.f;
#pragma unroll
                for (int j = 0; j < 8; ++j) { y[j] = a[j] + b[j]; ss += y[j] * y[j]; }
                ss = dred8(ss); ss += shx(ss, c.lane, 8);
                const float rs = rsqrtf(ss * (1.0f / 128.0f) + 1e-6f);
#pragma unroll
                for (int j = 0; j < 8; ++j) y[j] = y[j] * rs * gnorm[(c0 + j) & 127] * siluf_(g[j]);
                *(u32x4*)(of + 2 * SL) = pack8(y);
            }
            {
                float a[8], b[8], rr[8], kk[8], vv[8], gg[8], y[8];
                unpack8(q[e][7], a); unpack8(q[e][8], b); unpack8(q[e][9], rr); unpack8(q[e][10], kk); unpack8(q[e][11], vv); unpack8(q[e][12], gg);
                float sm = 0.f, bon = 0.f;
#pragma unroll
                for (int j = 0; j < 8; ++j) { y[j] = a[j] + b[j]; sm += y[j]; bon += rr[j] * kk[j] * rk[c0 + j]; }
                sm = dred8(sm); bon = dred8(bon); const float mean = sm * (1.0f / 64.0f); float vs = 0.f;
#pragma unroll
                for (int j = 0; j < 8; ++j) { y[j] -= mean; vs += y[j] * y[j]; }
                vs = dred8(vs); const float rs = rsqrtf(vs * (1.0f / 64.0f) + 64e-5f);
#pragma unroll
                for (int j = 0; j < 8; ++j) y[j] = (y[j] * rs * lnw[c0 + j] + lnb[c0 + j] + bon * vv[j]) * gg[j];
                *(u32x4*)(of + 4 * SL) = pack8(y);
            }
        }
    }
}

#ifndef RMASK
#define RMASK 0
#endif
#ifndef RMASK3
#define RMASK3 0
#endif
constexpr int N_PHASES = 2 + 2 * (14 + __builtin_popcount(RMASK) + 2 * __builtin_popcount(RMASK3));
__global__ void __launch_bounds__(NT, 2) fwd_kernel(Args a) {
    extern __shared__ __attribute__((aligned(16))) unsigned char lds_raw[];
    Ctx c; c.in = a.in; c.out = a.out; c.ws = a.ws; c.lds = (LAS unsigned char*)lds_raw;
    cg::grid_group grid = cg::this_grid();
    volatile LAS unsigned* st = (volatile LAS unsigned*)(c.lds + LDS_STAGE);
    if (threadIdx.x < 4) st[threadIdx.x] = 0u;
    __syncthreads();
    const XcdBarrier bar = xcd_barrier_post((unsigned*)(a.ws + WS_BAR), st);
    if (a.ph_hi < 0) grid.sync();
    for (int ph = a.ph_lo; ph < a.ph_hi; ++ph) {
#ifndef EXTRA_SYNC
#define EXTRA_SYNC 0
#endif
        if (ph > a.ph_lo) { xcd_barrier(bar); for (int e = 0; e < EXTRA_SYNC; ++e) xcd_barrier(bar); }
        { int tl = threadIdx.x, bl = blockIdx.x, gl = gridDim.x; asm volatile("" : "+v"(tl), "+s"(bl), "+s"(gl)); c.G = gl; c.NW = gl * 8;
          c.tid = tl; c.lane = tl & 63; c.wid = __builtin_amdgcn_readfirstlane(tl >> 6); c.bid = bl; c.gw = bl * 8 + c.wid; }
        if (ph == 0) { phase_init(c); __syncthreads(); const int base = convert_ffn(c, 0, 0, 0); convert_mixer(c, 0, base); continue; }
        if (ph == N_PHASES - 1) { phase_final_norm(c); continue; }
#ifndef RMASK
#define RMASK 0
#endif
        constexpr int LAYER_LEN = 14 + __builtin_popcount(RMASK) + 2 * __builtin_popcount(RMASK3);
        const int l = (ph - 1) / LAYER_LEN; int sp = 0; float sgn = 1.0f;
        if (RMASK | RMASK3) { int k = (ph - 1) % LAYER_LEN; for (sp = 0; sp < 14; ++sp) { const int reps = 1 + ((RMASK >> sp) & 1) + 2 * ((RMASK3 >> sp) & 1); if (k < reps) break; k -= reps; } sgn = (k & 1) ? -1.0f : 1.0f; }
        else sp = (ph - 1) % 14;
        const float* ada_l = c.ADA_() + l * 5 * 9216;
#ifndef PMASK
#define PMASK 0xFFFF
#endif
#define PON(k) ((PMASK >> (k)) & 1)
        switch (sp) {
            case 0: if (PON(0)) { phase_norm(c, l, 0, l > 0); if (l > 0) { __syncthreads(); int base = convert_ffn(c, l, 0, 0); convert_mixer(c, l, base); } } break;
            case 1: case 12: if (PON(1)) run_gemm(c, c.H_(), c.WGU_(), 5632, 1024, EpiGU{c.PROJ_()}); break;
            case 2: if (PON(2)) run_gemm(c, c.PROJ_(), c.WD_(), 1024, DFF, EpiResid{c.OUTS_(), ada_l + 2 * 1024, 0.5f * sgn}, 2); break;
            case 13: if (PON(2)) run_gemm(c, c.PROJ_(), c.WD_(), 1024, DFF, EpiResid{c.OUTS_(), ada_l + 8 * 1024, 0.5f * sgn}, 2); break;
            case 3: if (PON(3)) phase_norm(c, l, 1, true); break;
            case 4: if (PON(4)) run_gemm(c, c.H_(), c.WIN_(), NPROJ, 1024, EpiProj{c.PROJ_(), NPROJ}); break;
            case 5: if (PON(5)) phase_prepass(c, l); break;
            case 6: if (PON(6)) run_gemm(c, c.LOWA_(), c.WSM_(), 2048, KSM, EpiSmall{c.SMALL_(), c.in[26] + l * 1024, c.in[28] + l * 512, c.RWK_(), c.RWKK_(), c.in[32] + l * 512}); break;
            case 7: if (PON(7)) phase_scan(c, l); break;
            case 8: if (PON(8)) phase_postpass(c, l); break;
            case 9: if (PON(9)) { int Kl = 512; asm volatile("" : "+s"(Kl));
                pg8::Gemm g{c.OUTS_(), c.WBO_(), T, 3072, Kl, 512, 4, (size_t)2 * T * DMIX * 2, (size_t)1024 * 512 * 2}; BranchOrder S{c.bid};
                pg8::gemm_phase<EpiBranch, BranchOrder, GP_ALIGN, GP_SP2>(c.lds, g, S, EpiBranch{c.H_(), c.PROJ_() + C_GATE});
                if (c.G > 128 && c.bid >= 128) { Ctx c2 = c; c2.bid = c.bid - 128; c2.G = c.G - 128; (void)convert_ffn(c2, l, 1, 0); } } break;
            case 10: if (PON(10)) run_gemm(c, c.H_(), c.WOUT_(), 1024, 1024, EpiResid{c.OUTS_(), ada_l + 5 * 1024, 1.0f * sgn}, 2); break;
            case 11: if (PON(11)) { phase_norm(c, l, 2, true); if (c.G <= 128) { __syncthreads(); (void)convert_ffn(c, l, 1, 0); } } break;
        }
    }
}

#ifndef N_LAUNCH_MODE
#define N_LAUNCH_MODE 1
#endif
extern "C" void kernel_launch(void* const* d_in, const int* in_sizes, int n_in, void* d_out, int out_size, void* d_ws, size_t ws_size, hipStream_t stream) {
    static int grid = 0;
    if (grid == 0) {
        if (n_in != 39 || ws_size < WS_END) { fprintf(stderr, "kernel_launch: need 39 inputs and %zu bytes of workspace; got %d, %zu\n", (size_t)WS_END, n_in, ws_size); grid = -1; return; }
        if (hipFuncSetAttribute((const void*)fwd_kernel, hipFuncAttributeMaxDynamicSharedMemorySize, LDS_BYTES) != hipSuccess) { fprintf(stderr, "kernel_launch: hipFuncSetAttribute failed\n"); grid = -1; return; }
        int dev = 0, cus = 0, per_cu = 0;
        hipGetDevice(&dev); hipDeviceGetAttribute(&cus, hipDeviceAttributeMultiprocessorCount, dev);
        hipOccupancyMaxActiveBlocksPerMultiprocessor(&per_cu, (const void*)fwd_kernel, NT, LDS_BYTES);
        if (per_cu < 1) { fprintf(stderr, "kernel_launch: occupancy query says %d blocks per CU\n", per_cu); per_cu = 1; }
        (void)hipGetLastError();
        grid = cus;
    }
    if (grid < 0) return;
    Args a{};
    for (int i = 0; i < 39; ++i) a.in[i] = (const float*)d_in[i];
    a.out = (float*)d_out; a.ws = (unsigned char*)d_ws;
#if N_LAUNCH_MODE == 0
    for (int ph = 0; ph < N_PHASES; ++ph) { a.ph_lo = ph; a.ph_hi = ph + 1; hipLaunchKernelGGL(fwd_kernel, dim3(grid), dim3(NT), LDS_BYTES, stream, a); }
#else
    if (hipMemsetAsync((unsigned char*)d_ws + WS_BAR, 0, XCD_BAR_WORDS * 4, stream) != hipSuccess) { fprintf(stderr, "kernel_launch: memset of the barrier words failed\n"); return; }
    a.ph_lo = 0; a.ph_hi = N_PHASES;
    void* args[] = {&a};
    hipError_t e = hipLaunchCooperativeKernel((const void*)fwd_kernel, dim3(grid), dim3(NT), args, LDS_BYTES, stream);
    if (e != hipSuccess) fprintf(stderr, "cooperative launch failed: %s (grid %d)\n", hipGetErrorString(e), grid);
#endif
}
```

```cpp
#include <hip/hip_runtime.h>
#include <hip/hip_cooperative_groups.h>
#include <cstdio>
namespace cg = cooperative_groups;
namespace pg8 {
#define PG8_LAS __attribute__((address_space(3)))
typedef unsigned short bf16_t;
typedef short bf16x8 __attribute__((ext_vector_type(8)));
typedef float f32x4 __attribute__((ext_vector_type(4)));
typedef unsigned u32x4 __attribute__((ext_vector_type(4)));
constexpr int BM = 256, BK = 64, HALF = 128, HTB = HALF * BK * 2  , STAGE_BYTES = 8 * HTB, NXCD = 8, WGM = 8;

__host__ __device__ __forceinline__ int lds_byte(int r, int c) { const int st = (r >> 4) * 2 + (c >> 5), rr = r & 15, cc = c & 31, ob = rr * 64 + cc * 2; return st * 1024 + (ob ^ (((ob >> 9) & 1) << 5)); }
__host__ __device__ __forceinline__ void stage_rc(int b, int& R, int& C) { const int st = b / 1024, sb = b % 1024, swz = sb ^ (((sb >> 9) & 1) << 5); R = (st >> 1) * 16 + swz / 64; C = (st & 1) * 32 + (swz % 64) / 2; }
__host__ __device__ __forceinline__ int perm32(int rho) { const int n = rho >> 4, i = rho & 15; return 8 * (i >> 2) + 4 * n + (i & 3); }

struct Unit { int pm, pn; };
struct Gemm { const bf16_t* A; const bf16_t* Bt; int M, N, K, ld, nreal; size_t asl, bsl; };

struct StaticOrder {
    int nM, nN, nwg, G, c;
    __host__ __device__ void init(int M, int N, int G_, int c_) { nM = M / BM; nN = N / BM; nwg = nM * nN; G = G_; c = c_; }
    __host__ __device__ bool next(int i, Unit& u) const {
        const long L = (long)i * G + c; if (L >= nwg) return false;
        int wgid = (int)L; { const int q = nwg / NXCD, r = nwg % NXCD, xcd = wgid % NXCD, off = wgid / NXCD; wgid = (xcd < r ? xcd * (q + 1) : r * (q + 1) + (xcd - r) * q) + off; }
        const int nig = WGM * nN, gid = wgid / nig, fm = gid * WGM, gsz = (nM - fm) < WGM ? (nM - fm) : WGM;
        u.pm = fm + ((wgid % nig) % gsz); u.pn = (wgid % nig) / gsz; return true;
    }
    __device__ __forceinline__ void a_ready(const Unit&) const {}
    __device__ __forceinline__ void done(const Unit&) const {}
};
__device__ __forceinline__ unsigned cvt_pk_bf16(float lo, float hi) { unsigned r; asm volatile("v_cvt_pk_bf16_f32 %0, %1, %2" : "=v"(r) : "v"(lo), "v"(hi)); return r; }
template <class Epi, class Sched, bool ALIGN_EPI = false, bool SP2 = false>
__device__ __forceinline__ void gemm_phase(PG8_LAS unsigned char* lds, const Gemm g, const Sched& S, const Epi& E) {
    int tid_l = threadIdx.x; asm volatile("" : "+v"(tid_l));
    const int tid = tid_l, wid = __builtin_amdgcn_readfirstlane(tid >> 6), lane = tid & 63, wr = wid >> 2, wc = wid & 3, fr = lane & 15, fq = lane >> 4;
    const int K = g.K, LD = g.ld, nt = K / BK;
    unsigned voffA[2], voffB[2];
#pragma unroll
    for (int i = 0; i < 2; ++i) { int R, C; stage_rc(tid * 16 + i * 8192, R, C); const int Rb = Epi::PERM ? ((R & ~31) + perm32(R & 31)) : R;
        voffA[i] = (unsigned)(R * LD + C) * 2u; voffB[i] = (unsigned)(Rb * LD + C) * 2u; }
    const size_t kstep = (size_t)(BK * 2);
    const size_t hstep = (size_t)HALF * LD * 2;
    const size_t tstep = 2 * hstep;
    const unsigned ldsw = (unsigned)wid * 1024u;
    const int aoff = lds_byte(wr * 64 + fr, fq * 8), boff = lds_byte(wc * 32 + fr, fq * 8);
#define PG8_SA(b, h) (((b) * 2 + (h)) * HTB)
#define PG8_SB(b, h) ((4 + (b) * 2 + (h)) * HTB)
#define PG8_STAGE(bufoff, gbase, voff) do { _Pragma("unroll") for (int _i = 0; _i < 2; ++_i) \
        __builtin_amdgcn_global_load_lds((const unsigned*)((const char*)(gbase) + (voff)[_i]), (PG8_LAS unsigned*)(lds + (bufoff) + ldsw + _i * 8192), 16, 0, 0); } while (0)
#define PG8_LDA(dst, b, h) do { _Pragma("unroll") for (int m = 0; m < 4; ++m) _Pragma("unroll") for (int k = 0; k < 2; ++k) dst[m][k] = *(const PG8_LAS bf16x8*)(lds + PG8_SA(b, h) + aoff + m * 2048 + k * 1024); } while (0)
#define PG8_LDB(dst, b, h) do { _Pragma("unroll") for (int n = 0; n < 2; ++n) _Pragma("unroll") for (int k = 0; k < 2; ++k) dst[n][k] = *(const PG8_LAS bf16x8*)(lds + PG8_SB(b, h) + boff + n * 2048 + k * 1024); } while (0)
#define PG8_MMA(ai, bj, At, Bt) do { __builtin_amdgcn_s_setprio(1); _Pragma("unroll") for (int m = 0; m < 4; ++m) _Pragma("unroll") for (int n = 0; n < 2; ++n) _Pragma("unroll") for (int k = 0; k < 2; ++k) \
        acc[ai][bj][m][n] = __builtin_amdgcn_mfma_f32_16x16x32_bf16(Bt[n][k], At[m][k], acc[ai][bj][m][n], 0, 0, 0); __builtin_amdgcn_s_setprio(0); } while (0)
#define PG8_WAIT_V(n) asm volatile("s_waitcnt vmcnt(" #n ")" ::: "memory")
#define PG8_WAIT_L(n) asm volatile("s_waitcnt lgkmcnt(" #n ")" ::: "memory")
#define PG8_BAR __builtin_amdgcn_s_barrier()
#define PG8_SCHED __builtin_amdgcn_sched_barrier(0)
    Unit cur, nxt; int ui = 0;
    if (!S.next(0, cur)) return;
    f32x4 acc[2][2][4][2];
#pragma unroll
    for (int a = 0; a < 2; ++a)
#pragma unroll
        for (int b = 0; b < 2; ++b)
#pragma unroll
            for (int m = 0; m < 4; ++m)
#pragma unroll
                for (int n = 0; n < 2; ++n) acc[a][b][m][n] = (f32x4){0.f, 0.f, 0.f, 0.f};
    bf16x8 At[4][2], B0[2][2], B1[2][2];
    const char* cA = (const char*)g.A + (size_t)cur.pm * tstep + (size_t)(cur.pn / g.nreal) * g.asl; const char* cB = (const char*)g.Bt + (size_t)(cur.pn % g.nreal) * tstep + (size_t)(cur.pn / g.nreal) * g.bsl;
    S.a_ready(cur);
    if constexpr (SP2) {
        PG8_STAGE(PG8_SB(0, 0), cB, voffB); PG8_STAGE(PG8_SB(0, 1), cB + hstep, voffB); PG8_STAGE(PG8_SA(0, 0), cA, voffA); PG8_STAGE(PG8_SA(0, 1), cA + hstep, voffA);
        if (wr == 1) PG8_BAR;
        PG8_WAIT_V(2); PG8_BAR;
        PG8_STAGE(PG8_SB(1, 0), cB + kstep, voffB); PG8_STAGE(PG8_SA(1, 0), cA + kstep, voffA); PG8_STAGE(PG8_SB(1, 1), cB + hstep + kstep, voffB);
        PG8_WAIT_V(6); PG8_BAR;
    } else {
        PG8_STAGE(PG8_SB(0, 0), cB, voffB); PG8_STAGE(PG8_SA(0, 0), cA, voffA); PG8_STAGE(PG8_SB(0, 1), cB + hstep, voffB); PG8_STAGE(PG8_SA(0, 1), cA + hstep, voffA);
        if (wr == 1) PG8_BAR;
        PG8_WAIT_V(4); PG8_BAR;
        PG8_STAGE(PG8_SB(1, 0), cB + kstep, voffB); PG8_STAGE(PG8_SA(1, 0), cA + kstep, voffA); PG8_STAGE(PG8_SB(1, 1), cB + hstep + kstep, voffB);
        PG8_WAIT_V(6); PG8_BAR;
    }
    for (;;) {
        const bool has_next = S.next(ui + 1, nxt);
        const char* nA = has_next ? (const char*)g.A + (size_t)nxt.pm * tstep + (size_t)(nxt.pn / g.nreal) * g.asl : cA; const char* nB = has_next ? (const char*)g.Bt + (size_t)(nxt.pn % g.nreal) * tstep + (size_t)(nxt.pn / g.nreal) * g.bsl : cB;
        for (int t = 0; t < nt; t += 2) {
            const bool last = (t == nt - 2);
            const char* a1 = cA + (size_t)(t + 1) * kstep;
            const char* a2 = last ? nA : cA + (size_t)(t + 2) * kstep; const char* b2 = last ? nB : cB + (size_t)(t + 2) * kstep;
            const char* a3 = a2 + kstep; const char* b3 = b2 + kstep;
            if (last && has_next) S.a_ready(nxt);
            if constexpr (SP2) {
            PG8_LDB(B0, 0, 0); PG8_LDB(B1, 0, 1); PG8_SCHED; PG8_LDA(At, 0, 0); PG8_STAGE(PG8_SA(1, 1), a1 + hstep, voffA);
            PG8_WAIT_V(8); PG8_WAIT_L(0); PG8_BAR; PG8_MMA(0, 0, At, B0); PG8_MMA(0, 1, At, B1); PG8_BAR; PG8_SCHED;
            PG8_LDA(At, 0, 1); PG8_STAGE(PG8_SB(0, 0), b2, voffB); PG8_STAGE(PG8_SB(0, 1), b2 + hstep, voffB); PG8_STAGE(PG8_SA(0, 0), a2, voffA);
            PG8_WAIT_V(8); PG8_WAIT_L(0); PG8_BAR; PG8_MMA(1, 0, At, B0); PG8_MMA(1, 1, At, B1); PG8_BAR; PG8_SCHED;
            PG8_LDB(B0, 1, 0); PG8_LDB(B1, 1, 1); PG8_SCHED; PG8_LDA(At, 1, 0); PG8_STAGE(PG8_SA(0, 1), a2 + hstep, voffA);
            PG8_WAIT_V(8); PG8_WAIT_L(0); PG8_BAR; PG8_MMA(0, 0, At, B0); PG8_MMA(0, 1, At, B1); PG8_BAR; PG8_SCHED;
            PG8_LDA(At, 1, 1); PG8_STAGE(PG8_SB(1, 0), b3, voffB); PG8_STAGE(PG8_SB(1, 1), b3 + hstep, voffB); PG8_STAGE(PG8_SA(1, 0), a3, voffA);
            PG8_WAIT_V(8); PG8_WAIT_L(0); PG8_BAR; PG8_MMA(1, 0, At, B0); PG8_MMA(1, 1, At, B1); PG8_BAR; PG8_SCHED;
            } else {
            PG8_LDB(B0, 0, 0); PG8_SCHED; PG8_LDA(At, 0, 0); PG8_STAGE(PG8_SA(1, 1), a1 + hstep, voffA);
            PG8_WAIT_L(8); PG8_BAR; PG8_WAIT_L(0); PG8_MMA(0, 0, At, B0); PG8_BAR; PG8_SCHED;
            PG8_LDB(B1, 0, 1); PG8_STAGE(PG8_SB(0, 0), b2, voffB);
            PG8_BAR; PG8_WAIT_L(0); PG8_MMA(0, 1, At, B1); PG8_BAR;
            PG8_LDA(At, 0, 1); PG8_STAGE(PG8_SA(0, 0), a2, voffA);
            PG8_BAR; PG8_WAIT_L(0); PG8_MMA(1, 0, At, B0); PG8_BAR; PG8_SCHED;
            PG8_STAGE(PG8_SB(0, 1), b2 + hstep, voffB);
            PG8_WAIT_V(6); PG8_BAR; PG8_MMA(1, 1, At, B1); PG8_BAR;
            PG8_LDB(B0, 1, 0); PG8_SCHED; PG8_LDA(At, 1, 0); PG8_STAGE(PG8_SA(0, 1), a2 + hstep, voffA);
            PG8_WAIT_L(8); PG8_BAR; PG8_WAIT_L(0); PG8_MMA(0, 0, At, B0); PG8_BAR; PG8_SCHED;
            PG8_LDB(B1, 1, 1); PG8_STAGE(PG8_SB(1, 0), b3, voffB);
            PG8_BAR; PG8_WAIT_L(0); PG8_MMA(0, 1, At, B1); PG8_BAR;
            PG8_LDA(At, 1, 1); PG8_STAGE(PG8_SA(1, 0), a3, voffA);
            PG8_BAR; PG8_WAIT_L(0); PG8_MMA(1, 0, At, B0); PG8_BAR; PG8_SCHED;
            PG8_STAGE(PG8_SB(1, 1), b3 + hstep, voffB);
            PG8_WAIT_V(6); PG8_BAR; PG8_MMA(1, 1, At, B1); PG8_BAR;
            }
        }
        if constexpr (ALIGN_EPI) { if (wr == 0) PG8_BAR; }
        if constexpr (!Epi::AFTER_DRAIN) { E(acc, cur, wr, wc, fr, fq); S.done(cur); }
        if (!has_next) break;
#pragma unroll
        for (int a = 0; a < 2; ++a)
#pragma unroll
            for (int b = 0; b < 2; ++b)
#pragma unroll
                for (int m = 0; m < 4; ++m)
#pragma unroll
                    for (int n = 0; n < 2; ++n) acc[a][b][m][n] = (f32x4){0.f, 0.f, 0.f, 0.f};
        cur = nxt; cA = nA; cB = nB; ++ui;
        if constexpr (ALIGN_EPI) { if (wr == 1) PG8_BAR; }
    }
    PG8_WAIT_V(0);
    if constexpr (!ALIGN_EPI) { if (wr == 0) PG8_BAR; }
    PG8_BAR;
    if constexpr (Epi::AFTER_DRAIN) { E.fused(acc, cur, wr, wc, fr, fq, lds, wid, lane); S.done(cur); }
#undef PG8_SA
#undef PG8_SB
#undef PG8_STAGE
#undef PG8_LDA
#undef PG8_LDB
#undef PG8_MMA
#undef PG8_WAIT_V
#undef PG8_WAIT_L
#undef PG8_BAR
#undef PG8_SCHED
}
}
#define LAS __attribute__((address_space(3)))
#define XB_TMO      128
#define XB_XCNT(j)  (256  + 64 * (j))
#define XB_XSUB(j)  (1280 + 64 * (j))
#define XB_XGEN(j)  (2304 + 64 * (j))
#define XB_TOP      3328
#define XB_TOPGEN   3392
#define XCD_BAR_WORDS 3456
#define XB_SPIN_CAP (1u << 18)

__device__ __forceinline__ unsigned xb_ld(unsigned* p)              { return __hip_atomic_load(p, __ATOMIC_RELAXED, __HIP_MEMORY_SCOPE_AGENT); }
__device__ __forceinline__ unsigned xb_add(unsigned* p, unsigned v) { return __hip_atomic_fetch_add(p, v, __ATOMIC_RELAXED, __HIP_MEMORY_SCOPE_AGENT); }
__device__ __forceinline__ unsigned xb_xcc_id() { return (unsigned)__builtin_amdgcn_s_getreg((3 << 11) | 20) & 0xFu; }
#define XB_SPIN(cond, bar) do { unsigned _sp = 0; while (cond) { __builtin_amdgcn_s_sleep(1); \
    if ((++_sp & 255u) == 0u) { if (xb_ld(&(bar)[XB_TMO])) break; if (_sp > XB_SPIN_CAP) { atomicAdd(&(bar)[XB_TMO], 1u); break; } } } } while (0)

struct XcdBarrier {
    unsigned* bar; unsigned x;
    volatile LAS unsigned* st;
};

__device__ __forceinline__ XcdBarrier xcd_barrier_post(unsigned* bar, volatile LAS unsigned* st) {
    XcdBarrier b; b.bar = bar; b.x = xb_xcc_id(); b.st = st;
    if (threadIdx.x == 0) (void)xb_add(&bar[XB_XCNT(b.x)], 1u);
    return b;
}
__device__ __forceinline__ void xcd_barrier_complete(unsigned* bar, unsigned x, unsigned& nloc, unsigned& nx) {
    const unsigned G = gridDim.x * gridDim.y * gridDim.z;
    unsigned sum, cnt, mine, sp = 0u;
    for (;;) {
        sum = 0u; cnt = 0u; mine = 0u;
#pragma unroll
        for (unsigned j = 0; j < 16; ++j) { const unsigned c = xb_ld(&bar[XB_XCNT(j)]); sum += c; cnt += (c > 0u) ? 1u : 0u; mine = (j == x) ? c : mine; }
        if (sum == G) break;
        __builtin_amdgcn_s_sleep(1);
        if ((++sp & 255u) == 0u) { if (xb_ld(&bar[XB_TMO])) break; if (sp > XB_SPIN_CAP) { atomicAdd(&bar[XB_TMO], 1u); break; } }
    }
    nloc = mine > 0u ? mine : 1u; nx = cnt > 0u ? cnt : 1u;
}

__device__ __forceinline__ void xcd_barrier(const XcdBarrier& b) {
    asm volatile("s_waitcnt vmcnt(0)" ::: "memory");
    __syncthreads();
    if (threadIdx.x == 0) {
        unsigned* bar = b.bar;
        __builtin_amdgcn_s_waitcnt(0);
        unsigned nloc = b.st[0], nx = b.st[1];
        if (nloc == 0u) { xcd_barrier_complete(bar, b.x, nloc, nx); b.st[0] = nloc; b.st[1] = nx; }
        const unsigned old = xb_add(&bar[XB_XSUB(b.x)], 1u);
        const unsigned gen = old / nloc;
        if (old + 1u == (gen + 1u) * nloc) {
            __builtin_amdgcn_fence(__ATOMIC_RELEASE, "agent");
            asm volatile("s_waitcnt vmcnt(0)" ::: "memory");
            const unsigned og = xb_add(&bar[XB_TOP], 1u);
            const unsigned tg = og / nx;
            if (og + 1u == (tg + 1u) * nx) xb_add(&bar[XB_TOPGEN], 1u);
            else XB_SPIN(xb_ld(&bar[XB_TOPGEN]) == tg, bar);
            __builtin_amdgcn_fence(__ATOMIC_ACQUIRE, "agent");
            xb_add(&bar[XB_XGEN(b.x)], 1u);
            asm volatile("s_waitcnt vmcnt(0)" ::: "memory");
        } else {
            XB_SPIN(xb_ld(&bar[XB_XGEN(b.x)]) == gen, bar);
            __builtin_amdgcn_fence(__ATOMIC_ACQUIRE, "agent");
            asm volatile("s_waitcnt vmcnt(0)" ::: "memory");
        }
    }
    __syncthreads();
}

using pg8::bf16_t; using pg8::f32x4; using pg8::u32x4; using pg8::cvt_pk_bf16;
typedef unsigned u32x2 __attribute__((ext_vector_type(2)));

constexpr int T = 8192, D = 1024, DFF = 2816, DMIX = 512, NPROJ = 7936, NIN = 7792, NSM = 2560, KSM = 384, NT = 512, LDS_STAGE = 131072, LDS_BYTES = LDS_STAGE + 16;
constexpr int C_GLA = 1296, C_RW = 2864, C_GATE = 4720;
constexpr size_t WS_ADA = 0;
constexpr size_t WS_WGU = WS_ADA + 2ull * 5 * 9216 * 4;
constexpr size_t WS_WD = WS_WGU + 5632ull * 1024 * 2;
constexpr size_t WS_WIN = WS_WD + 1024ull * 2816 * 2;
constexpr size_t WS_WBO = WS_WIN + (size_t)NPROJ * 1024 * 2;
constexpr size_t WS_WOUT = WS_WBO + 3ull * 1024 * 512 * 2;
constexpr size_t WS_WSM = WS_WOUT + 1024ull * 1024 * 2;
constexpr size_t WS_H = WS_WSM + (size_t)NSM * KSM * 2;
constexpr size_t WS_PROJ = WS_H + (size_t)T * D * 2;
constexpr size_t WS_RW = WS_PROJ + (size_t)T * NPROJ * 2;
constexpr size_t WS_LOWA = WS_RW + 4ull * T * DMIX * 2;
constexpr size_t WS_SMALL = WS_LOWA + (size_t)T * KSM * 2;
constexpr size_t WS_OUT = WS_SMALL + (size_t)T * NSM * 2;
constexpr size_t WS_BAR = WS_OUT + 6ull * T * DMIX * 2;
constexpr size_t WS_END = WS_BAR + XCD_BAR_WORDS * 4;
constexpr size_t WS_XBC = WS_WGU;
constexpr size_t WS_DT = WS_XBC + (size_t)T * 768 * 2;
static_assert(WS_DT + (size_t)T * 16 * 4 <= WS_WIN, "xbc alias");
constexpr size_t OUT_SSD = 8388608, OUT_GLA = OUT_SSD + 2097152, OUT_RWK = OUT_GLA + 2097152;

struct Args { const float* in[39]; float* out; unsigned char* ws; int ph_lo, ph_hi; };

struct Ctx {
    const float* const* in; float* out; unsigned char* ws; LAS unsigned char* lds; int tid, lane, wid, G, bid, gw, NW;
    __device__ __forceinline__ float* X_() const { return out; }
    __device__ __forceinline__ float* ADA_() const { return (float*)(ws + WS_ADA); }
    __device__ __forceinline__ bf16_t* WGU_() const { return (bf16_t*)(ws + WS_WGU); }
    __device__ __forceinline__ bf16_t* WD_() const { return (bf16_t*)(ws + WS_WD); }
    __device__ __forceinline__ bf16_t* WIN_() const { return (bf16_t*)(ws + WS_WIN); }
    __device__ __forceinline__ bf16_t* WBO_() const { return (bf16_t*)(ws + WS_WBO); }
    __device__ __forceinline__ bf16_t* WOUT_() const { return (bf16_t*)(ws + WS_WOUT); }
    __device__ __forceinline__ bf16_t* WSM_() const { return (bf16_t*)(ws + WS_WSM); }
    __device__ __forceinline__ bf16_t* H_() const { return (bf16_t*)(ws + WS_H); }
    __device__ __forceinline__ bf16_t* PROJ_() const { return (bf16_t*)(ws + WS_PROJ); }
    __device__ __forceinline__ bf16_t* RWR_() const { return (bf16_t*)(ws + WS_RW); }
    __device__ __forceinline__ bf16_t* RWK_() const { return (bf16_t*)(ws + WS_RW) + (size_t)T * DMIX; }
    __device__ __forceinline__ bf16_t* RWV_() const { return (bf16_t*)(ws + WS_RW) + (size_t)2 * T * DMIX; }
    __device__ __forceinline__ bf16_t* RWKK_() const { return (bf16_t*)(ws + WS_RW) + (size_t)3 * T * DMIX; }
    __device__ __forceinline__ bf16_t* LOWA_() const { return (bf16_t*)(ws + WS_LOWA); }
    __device__ __forceinline__ bf16_t* SMALL_() const { return (bf16_t*)(ws + WS_SMALL); }
    __device__ __forceinline__ bf16_t* OUTS_() const { return (bf16_t*)(ws + WS_OUT); }
    __device__ __forceinline__ bf16_t* XBC_() const { return (bf16_t*)(ws + WS_XBC); }
    __device__ __forceinline__ float* DT_() const { return (float*)(ws + WS_DT); }
};

__device__ __forceinline__ float bf2f(bf16_t v) { return __uint_as_float((unsigned)v << 16); }
__device__ __forceinline__ float bflo(unsigned v) { return __uint_as_float(v << 16); }
__device__ __forceinline__ float bfhi(unsigned v) { return __uint_as_float(v & 0xffff0000u); }
__device__ __forceinline__ bf16_t f2bf(float f) { return (bf16_t)(cvt_pk_bf16(f, 0.f) & 0xffffu); }
__device__ __forceinline__ float sigmoidf_(float x) { return __builtin_amdgcn_rcpf(1.0f + __expf(-x)); }
__device__ __forceinline__ float siluf_(float x) { return x * __builtin_amdgcn_rcpf(1.0f + __expf(-x)); }
__device__ __forceinline__ float softplusf_(float x) { return fmaxf(x, 0.f) + __logf(1.0f + __expf(-fabsf(x))); }
__device__ __forceinline__ void unpack8(const u32x4 w, float* f) { f[0] = bflo(w.x); f[1] = bfhi(w.x); f[2] = bflo(w.y); f[3] = bfhi(w.y); f[4] = bflo(w.z); f[5] = bfhi(w.z); f[6] = bflo(w.w); f[7] = bfhi(w.w); }
__device__ __forceinline__ u32x4 pack8(const float* f) { u32x4 w; w.x = cvt_pk_bf16(f[0], f[1]); w.y = cvt_pk_bf16(f[2], f[3]); w.z = cvt_pk_bf16(f[4], f[5]); w.w = cvt_pk_bf16(f[6], f[7]); return w; }
__device__ __forceinline__ float shx(float x, int lane, int m) { return __int_as_float(__builtin_amdgcn_ds_bpermute((lane ^ m) << 2, __float_as_int(x))); }
__device__ __forceinline__ float wave_sum(float x, int lane) { x += shx(x, lane, 32); x += shx(x, lane, 16); x += shx(x, lane, 8); x += shx(x, lane, 4); x += shx(x, lane, 2); x += shx(x, lane, 1); return x; }
__device__ __forceinline__ float red8(float x, int lane) { x += shx(x, lane, 1); x += shx(x, lane, 2); x += shx(x, lane, 4); return x; }
template <int CTRL> __device__ __forceinline__ float dppf(float x) { return __int_as_float(__builtin_amdgcn_update_dpp(0, __float_as_int(x), CTRL, 0xF, 0xF, true)); }
__device__ __forceinline__ float dred8(float x) { x += dppf<0xB1>(x); x += dppf<0x4E>(x); x += dppf<0x141>(x); return x; }
__device__ __forceinline__ int cond_of_row(int r) { return r < 4096 ? 0 : 1 + ((r - 4096) >> 10); }

template <class F>
__device__ __forceinline__ int conv_tiles(const Ctx& c, F colptr, int ld, bf16_t* dst, int K, int N, int base) {
    LAS float* tile = (LAS float*)c.lds;
    const int nkt = K / 64, ntl = (N / 256) * nkt;
    int first = (c.bid - (base % c.G) + c.G) % c.G;
    for (int tl = first; tl < ntl; tl += c.G) {
        const int n0 = (tl / nkt) * 256, k0 = (tl % nkt) * 64;
        const int n4 = c.lane * 4;
        const float* p = colptr(n0 + n4);
        f32x4 v[8];
#pragma unroll
        for (int j = 0; j < 8; ++j) { const int k = c.wid + 8 * j; v[j] = p ? *(const f32x4*)(p + (size_t)(k0 + k) * ld) : (f32x4){0.f, 0.f, 0.f, 0.f}; }
#pragma unroll
        for (int j = 0; j < 8; ++j) { const int k = c.wid + 8 * j; LAS float* t = tile + k * 257 + n4; t[0] = v[j][0]; t[1] = v[j][1]; t[2] = v[j][2]; t[3] = v[j][3]; }
        __syncthreads();
        const int kc = c.tid & 7, nn0 = c.tid >> 3;
#pragma unroll
        for (int j = 0; j < 4; ++j) { const int n = nn0 + 64 * j; float f[8];
#pragma unroll
            for (int i = 0; i < 8; ++i) f[i] = tile[(kc * 8 + i) * 257 + n];
            *(u32x4*)(dst + (size_t)(n0 + n) * K + k0 + kc * 8) = pack8(f); }
        __syncthreads();
    }
    return base + ntl;
}
struct ColGU { const float* g; const float* u; __device__ const float* operator()(int n) const { const int pn = n >> 8, bj = (n >> 7) & 1, i = n & 127; return g + (u - g) * (long)bj + pn * 128 + i; } };
struct ColPlain { const float* w; int nvalid; __device__ const float* operator()(int n) const { return n < nvalid ? w + n : nullptr; } };

__device__ __forceinline__ int convert_ffn(const Ctx& c, int l, int f, int base) {
    const size_t o = ((size_t)l * 2 + f) * 1024 * 2816;
    base = conv_tiles(c, ColGU{c.in[10] + o, c.in[11] + o}, DFF, c.WGU_(), 1024, 5632, base);
    return conv_tiles(c, ColPlain{c.in[12] + o, 1024}, 1024, c.WD_(), DFF, 1024, base);
}
__device__ __forceinline__ void convert_mixer(const Ctx& c, int l, int base) {
    base = conv_tiles(c, ColPlain{c.in[13] + (size_t)l * 1024 * NIN, NIN}, NIN, c.WIN_(), 1024, NPROJ, base);
    base = conv_tiles(c, ColPlain{c.in[20] + (size_t)l * 512 * 1024, 1024}, 1024, c.WBO_(), 512, 1024, base);
    base = conv_tiles(c, ColPlain{c.in[24] + (size_t)l * 512 * 1024, 1024}, 1024, c.WBO_() + 1024 * 512, 512, 1024, base);
    base = conv_tiles(c, ColPlain{c.in[36] + (size_t)l * 512 * 1024, 1024}, 1024, c.WBO_() + 2 * 1024 * 512, 512, 1024, base);
    base = conv_tiles(c, ColPlain{c.in[37] + (size_t)l * 1024 * 1024, 1024}, 1024, c.WOUT_(), 1024, 1024, base);
    const float* w2 = c.in[27] + (size_t)l * 2 * 64 * 512; const float* a2 = c.in[29] + (size_t)l * 64 * 512; const float* g2 = c.in[30] + (size_t)l * 128 * 512; const float* gk = c.in[21] + (size_t)l * 2 * 16 * 256;
    for (int i = c.bid * NT + c.tid; i < NSM * KSM; i += c.G * NT) {
        const int n = i / KSM, k = i % KSM; float v = 0.f;
        if (n < 512) { if (k < 64) v = w2[k * 512 + n]; }
        else if (n < 1024) { if (k >= 64 && k < 128) v = w2[64 * 512 + (k - 64) * 512 + (n - 512)]; }
        else if (n < 1536) { if (k >= 128 && k < 192) v = a2[(k - 128) * 512 + (n - 1024)]; }
        else if (n < 2048) { if (k >= 192 && k < 320) v = g2[(k - 192) * 512 + (n - 1536)]; }
        else if (n < 2304) { if (k >= 320 && k < 336) v = gk[(k - 320) * 256 + (n - 2048)]; }
        else { if (k >= 336 && k < 352) v = gk[16 * 256 + (k - 336) * 256 + (n - 2304)]; }
        c.WSM_()[i] = f2bf(v);
    }
}

__device__ void phase_init(const Ctx& c) {
    const float* xp = c.in[0]; const float* xs = c.in[1];
    for (int i = c.bid * NT + c.tid; i < T * D / 4; i += c.G * NT) {
        const int r = i >> 8, c4 = (i & 255) * 4;
        f32x4 v;
        if (r < 4096) v = *(const f32x4*)(xp + (size_t)r * D + c4);
        else {
            v = *(const f32x4*)(xs + (size_t)(r - 4096) * D + c4);
            const int t = (r - 4096) & 1023, gr = t >> 6, gc = t & 63;
#pragma unroll
            for (int j = 0; j < 4; ++j) { const int cc = c4 + j, seg = cc >> 8, ii = cc & 255;
                const float omega = __expf(-(float)ii * (9.210340371976184f / 256.0f)); const float ang = (float)(seg < 2 ? gr : gc) * omega;
                v[j] += (seg & 1) ? __cosf(ang) : __sinf(ang); }
        }
        *(f32x4*)(c.X_() + (size_t)r * D + c4) = v;
    }
    LAS float* sc = (LAS float*)c.lds;
    LAS float* red = sc + 5 * 1024;
    for (int i = c.tid; i < 5 * 1024; i += NT) { const int cd = i >> 10, k = i & 1023; const float x = cd == 0 ? c.in[6][k] : c.in[5][(cd - 1) * 1024 + k]; sc[i] = siluf_(x); }
    __syncthreads();
    for (int it = c.bid; it < 288; it += c.G) {
        const int l = it / 144, n0 = (it % 144) * 64, col = c.tid & 63, kg = c.tid >> 6;
        const float* w = c.in[8] + (size_t)l * 1024 * 9216 + n0 + col;
        float a0 = 0.f, a1 = 0.f, a2 = 0.f, a3 = 0.f, a4 = 0.f;
#pragma unroll 16
        for (int k = kg * 128; k < kg * 128 + 128; ++k) { const float wv = w[(size_t)k * 9216]; a0 += sc[k] * wv; a1 += sc[1024 + k] * wv; a2 += sc[2048 + k] * wv; a3 += sc[3072 + k] * wv; a4 += sc[4096 + k] * wv; }
        red[(kg * 5 + 0) * 64 + col] = a0; red[(kg * 5 + 1) * 64 + col] = a1; red[(kg * 5 + 2) * 64 + col] = a2; red[(kg * 5 + 3) * 64 + col] = a3; red[(kg * 5 + 4) * 64 + col] = a4;
        __syncthreads();
        if (c.tid < 320) { const int cd = c.tid >> 6, cl = c.tid & 63; float s = c.in[9][l * 9216 + n0 + cl];
#pragma unroll
            for (int g = 0; g < 8; ++g) s += red[(g * 5 + cd) * 64 + cl];
            c.ADA_()[(l * 5 + cd) * 9216 + n0 + cl] = s; }
        __syncthreads();
    }
}

__device__ void phase_norm(const Ctx& c, int l, int which, bool addP) {
    const bf16_t* P = c.OUTS_();
    const float* g = c.in[7] + (l * 3 + which) * 1024;
    for (int r = c.gw; r < T; r += c.NW) {
        float* xr = c.X_() + (size_t)r * D; f32x4 v[4]; float ss = 0.f;
#pragma unroll
        for (int j = 0; j < 4; ++j) { v[j] = *(const f32x4*)(xr + (c.lane + 64 * j) * 4); if (addP) { const u32x2 pw = *(const u32x2*)(P + (size_t)r * D + (c.lane + 64 * j) * 4), pv = *(const u32x2*)(P + (size_t)T * D + (size_t)r * D + (c.lane + 64 * j) * 4); v[j] = v[j] + ((f32x4){bflo(pw.x), bfhi(pw.x), bflo(pw.y), bfhi(pw.y)} + (f32x4){bflo(pv.x), bfhi(pv.x), bflo(pv.y), bfhi(pv.y)}); *(f32x4*)(xr + (c.lane + 64 * j) * 4) = v[j]; } ss += v[j][0] * v[j][0] + v[j][1] * v[j][1] + v[j][2] * v[j][2] + v[j][3] * v[j][3]; }
        ss = wave_sum(ss, c.lane); const float rs = rsqrtf(ss * (1.0f / 1024.0f) + 1e-6f);
        const float* sh = c.ADA_() + (l * 5 + cond_of_row(r)) * 9216 + (which * 3) * 1024; const float* scl = sh + 1024;
#pragma unroll
        for (int j = 0; j < 4; ++j) { const int cc = (c.lane + 64 * j) * 4; const f32x4 gg = *(const f32x4*)(g + cc), s1 = *(const f32x4*)(scl + cc), s0 = *(const f32x4*)(sh + cc);
            const f32x4 o = v[j] * rs * gg * (s1 + 1.0f) + s0; u32x2 w; w.x = cvt_pk_bf16(o[0], o[1]); w.y = cvt_pk_bf16(o[2], o[3]); *(u32x2*)(c.H_() + (size_t)r * D + cc) = w; }
    }
}
__device__ void phase_final_norm(const Ctx& c) {
    const float* g = c.in[38]; const bf16_t* P = c.OUTS_();
    for (int r = c.gw; r < T; r += c.NW) {
        float* xr = c.X_() + (size_t)r * D; f32x4 v[4]; float ss = 0.f;
#pragma unroll
        for (int j = 0; j < 4; ++j) { const u32x2 pw = *(const u32x2*)(P + (size_t)r * D + (c.lane + 64 * j) * 4), pv = *(const u32x2*)(P + (size_t)T * D + (size_t)r * D + (c.lane + 64 * j) * 4); v[j] = *(const f32x4*)(xr + (c.lane + 64 * j) * 4) + ((f32x4){bflo(pw.x), bfhi(pw.x), bflo(pw.y), bfhi(pw.y)} + (f32x4){bflo(pv.x), bfhi(pv.x), bflo(pv.y), bfhi(pv.y)}); ss += v[j][0] * v[j][0] + v[j][1] * v[j][1] + v[j][2] * v[j][2] + v[j][3] * v[j][3]; }
        ss = wave_sum(ss, c.lane); const float rs = rsqrtf(ss * (1.0f / 1024.0f) + 1e-6f);
#pragma unroll
        for (int j = 0; j < 4; ++j) { const int cc = (c.lane + 64 * j) * 4; *(f32x4*)(xr + cc) = v[j] * rs * *(const f32x4*)(g + cc); }
    }
}

struct EpiGU { static constexpr bool PERM = true, AFTER_DRAIN = false; bf16_t* O;
    __device__ __forceinline__ void operator()(const f32x4 (&acc)[2][2][4][2], const pg8::Unit& u, int wr, int wc, int fr, int fq) const {
        const int row0 = u.pm * 256 + wr * 64 + fr, col0 = u.pn * 128 + wc * 32 + 8 * fq;
#pragma unroll
        for (int ai = 0; ai < 2; ++ai)
#pragma unroll
            for (int m = 0; m < 4; ++m) { float o[8];
#pragma unroll
                for (int n = 0; n < 2; ++n)
#pragma unroll
                    for (int j = 0; j < 4; ++j) o[n * 4 + j] = siluf_(acc[ai][0][m][n][j]) * acc[ai][1][m][n][j];
                *(u32x4*)(O + (size_t)(row0 + ai * 128 + m * 16) * DFF + col0) = pack8(o); }
    } };
struct EpiResid { static constexpr bool PERM = false, AFTER_DRAIN = false; bf16_t* P; const float* gate; float s;
    __device__ __forceinline__ void operator()(const f32x4 (&acc)[2][2][4][2], const pg8::Unit& u, int wr, int wc, int fr, int fq) const {
        const int pn = u.pn & 3, kh = u.pn >> 2;
        const int row0 = u.pm * 256 + wr * 64 + fr, col0 = pn * 256 + wc * 32 + 4 * fq; const int cd = cond_of_row(u.pm * 256);
        f32x4 gv[2][2];
#pragma unroll
        for (int bj = 0; bj < 2; ++bj)
#pragma unroll
            for (int n = 0; n < 2; ++n) gv[bj][n] = *(const f32x4*)(gate + cd * 9216 + col0 + bj * 128 + n * 16) * s;
        bf16_t* base = P + (size_t)kh * T * D;
#pragma unroll
        for (int ai = 0; ai < 2; ++ai)
#pragma unroll
            for (int m = 0; m < 4; ++m) { const size_t off = (size_t)(row0 + ai * 128 + m * 16) * D + col0;
#pragma unroll
                for (int bj = 0; bj < 2; ++bj)
#pragma unroll
                    for (int n = 0; n < 2; ++n) { const f32x4 v = acc[ai][bj][m][n] * gv[bj][n]; u32x2 w; w.x = cvt_pk_bf16(v[0], v[1]); w.y = cvt_pk_bf16(v[2], v[3]); *(u32x2*)(base + off + bj * 128 + n * 16) = w; } }
    } };
struct EpiProj { static constexpr bool PERM = true, AFTER_DRAIN = false; bf16_t* O; int ldc;
    __device__ __forceinline__ void operator()(const f32x4 (&acc)[2][2][4][2], const pg8::Unit& u, int wr, int wc, int fr, int fq) const {
        const int row0 = u.pm * 256 + wr * 64 + fr, col0 = u.pn * 256 + wc * 32 + 8 * fq;
#pragma unroll
        for (int ai = 0; ai < 2; ++ai)
#pragma unroll
            for (int m = 0; m < 4; ++m) { bf16_t* rowp = O + (size_t)(row0 + ai * 128 + m * 16) * ldc + col0;
#pragma unroll
                for (int bj = 0; bj < 2; ++bj) { const f32x4 v0 = acc[ai][bj][m][0], v1 = acc[ai][bj][m][1]; u32x4 w; w.x = cvt_pk_bf16(v0[0], v0[1]); w.y = cvt_pk_bf16(v0[2], v0[3]); w.z = cvt_pk_bf16(v1[0], v1[1]); w.w = cvt_pk_bf16(v1[2], v1[3]);
                    *(u32x4*)(rowp + bj * 128) = w; } }
    } };
struct EpiSmall { static constexpr bool PERM = true, AFTER_DRAIN = false; bf16_t* O; const float* w0; const float* a0; bf16_t* rwk; const bf16_t* rwkk; const float* ka;
    __device__ __forceinline__ void operator()(const f32x4 (&acc)[2][2][4][2], const pg8::Unit& u, int wr, int wc, int fr, int fq) const {
        const int row0 = u.pm * 256 + wr * 64 + fr, col0 = u.pn * 256 + wc * 32 + 8 * fq;
        const int kind = u.pn < 4 ? 0 : (u.pn < 6 ? 2 : 3);
        const float* bias = kind == 0 ? w0 : (kind == 2 ? a0 - 1024 : w0 - 1536);
        const float bsc = kind == 3 ? 0.f : 1.f;
#pragma unroll
        for (int bj = 0; bj < 2; ++bj) { const int cc = col0 + bj * 128; const f32x4 b0 = *(const f32x4*)(bias + cc) * bsc, b1 = *(const f32x4*)(bias + cc + 4) * bsc;
#pragma unroll
            for (int ai = 0; ai < 2; ++ai)
#pragma unroll
                for (int m = 0; m < 4; ++m) { const size_t row = row0 + ai * 128 + m * 16; const f32x4 x0 = acc[ai][bj][m][0] + b0, x1 = acc[ai][bj][m][1] + b1; float o[8];
#pragma unroll
                    for (int j = 0; j < 8; ++j) { const float x = j < 4 ? x0[j & 3] : x1[j & 3];
                        const float sg = __builtin_amdgcn_rcpf(1.0f + __expf(-x));
                        const float y01 = 1.0f - __expf(-sg * 0.60653066f);
                        o[j] = kind == 0 ? y01 : (kind == 2 ? sg : x); }
                    if (kind == 2) { float kv[8], kkv[8]; bf16_t* kp = rwk + row * 512 + (cc - 1024); unpack8(*(const u32x4*)kp, kv); unpack8(*(const u32x4*)(rwkk + row * 512 + (cc - 1024)), kkv);
                        const f32x4 ka0 = *(const f32x4*)(ka + cc - 1024), ka1 = *(const f32x4*)(ka + cc - 1024 + 4);
#pragma unroll
                        for (int j = 0; j < 8; ++j) { const float av = o[j], kaj = j < 4 ? ka0[j & 3] : ka1[j & 3]; kv[j] = kv[j] * (1.0f + (av - 1.0f) * kaj); o[j] = kkv[j] * av; }
                        *(u32x4*)kp = pack8(kv); }
                    *(u32x4*)(O + row * NSM + cc) = pack8(o); }
            asm volatile("" ::: "memory"); }
    } };
struct EpiBranch { static constexpr bool PERM = true, AFTER_DRAIN = false; bf16_t* M; const bf16_t* gates;
    __device__ __forceinline__ void operator()(const f32x4 (&acc)[2][2][4][2], const pg8::Unit& u, int wr, int wc, int fr, int fq) const {
        int upm = u.pm, upn = u.pn; asm volatile("" : "+s"(upm), "+s"(upn));
        const int b = upn >> 2, pn = upn & 3; const float keep = b ? 1.0f : 0.0f;
        const int row0 = upm * 256 + wr * 64 + fr, col0 = pn * 256 + wc * 32 + 8 * fq; const bf16_t* gb = gates + b * 1024;
#pragma unroll
        for (int ai = 0; ai < 2; ++ai)
#pragma unroll
            for (int m = 0; m < 4; ++m) { const int row = row0 + ai * 128 + m * 16;
#pragma unroll
                for (int bj = 0; bj < 2; ++bj) { const int cc = col0 + bj * 128; float gt[8], o[8];
                    unpack8(*(const u32x4*)(gb + (size_t)row * NPROJ + cc), gt);
                    bf16_t* mp = M + (size_t)row * D + cc;
                    unpack8(*(const u32x4*)mp, o);
#pragma unroll
                    for (int j = 0; j < 8; ++j) o[j] = o[j] * keep + sigmoidf_(gt[j]) * acc[ai][bj][m][j >> 2][j & 3];
                    *(u32x4*)mp = pack8(o); }
                asm volatile("" ::: "memory"); }
    } };

#ifndef GP_ALIGN
#define GP_ALIGN true
#endif
#ifndef GP_SP2
#define GP_SP2 true
#endif
template <class Epi>
__device__ __forceinline__ void run_gemm(const Ctx& c, const bf16_t* A, const bf16_t* Bt, int N, int K, const Epi& E, int ksplit = 1) {
    int Kl = K / ksplit; asm volatile("" : "+s"(Kl));
    pg8::Gemm g{A, Bt, T, N * ksplit, Kl, K, N / 256, (size_t)Kl * 2, (size_t)Kl * 2}; pg8::StaticOrder S; S.init(T, N * ksplit, c.G, c.bid);
    pg8::gemm_phase<Epi, pg8::StaticOrder, GP_ALIGN, GP_SP2>(c.lds, g, S, E);
}

struct BranchOrder { int c;
    __device__ bool next(int i, pg8::Unit& u) const { if (c >= 128 || i >= 3) return false; u.pm = c >> 2; u.pn = (c & 3) + 4 * i; return true; }
    __device__ __forceinline__ void a_ready(const pg8::Unit&) const {}
    __device__ __forceinline__ void done(const pg8::Unit&) const {}
};
__device__ __forceinline__ void ldf8(const float* p, float* f) { const f32x4 a = *(const f32x4*)p, b = *(const f32x4*)(p + 4); f[0] = a[0]; f[1] = a[1]; f[2] = a[2]; f[3] = a[3]; f[4] = b[0]; f[5] = b[1]; f[6] = b[2]; f[7] = b[3]; }
__device__ void phase_prepass(const Ctx& c, int l) {
    const float* cw = c.in[14] + l * 3 * 768; const float* cb = c.in[15] + l * 768; const float* dtb = c.in[16] + l * 16;
    const float* mu = c.in[25] + l * 1856; const float* rkk = c.in[31] + l * 512; const float* gkw = c.in[21] + l * 2 * 16 * 256; const float* gkb = c.in[22] + l * 512;
    const int lane = c.lane;
    for (int r = c.gw; r < T; r += c.NW) {
        int t, L; if (r < 4096) { t = r & 255; L = 256; } else { t = (r - 4096) & 1023; L = 1024; }
        const bool hp = t > 0, hn = t < L - 1;
        const bf16_t* p0 = c.PROJ_() + (size_t)r * NPROJ; const bf16_t* pm = hp ? p0 - NPROJ : p0; const bf16_t* pn = hn ? p0 + NPROJ : p0;
        const float fp = hp ? 1.f : 0.f, fn = hn ? 1.f : 0.f;
#pragma unroll
        for (int it = 0; it < 2; ++it) { const int g = lane + 64 * it; if (g < 96) { const int cc = g * 8; float x0[8], xm[8], xn[8], w0[8], w1[8], w2[8], bb[8], o[8];
            unpack8(*(const u32x4*)(p0 + 512 + cc), x0); unpack8(*(const u32x4*)(pm + 512 + cc), xm); unpack8(*(const u32x4*)(pn + 512 + cc), xn);
            ldf8(cw + cc, w0); ldf8(cw + 768 + cc, w1); ldf8(cw + 1536 + cc, w2); ldf8(cb + cc, bb);
#pragma unroll
            for (int j = 0; j < 8; ++j) o[j] = siluf_(bb[j] + w0[j] * xm[j] * fp + w1[j] * x0[j] + w2[j] * xn[j] * fn);
            *(u32x4*)(c.XBC_() + (size_t)r * 768 + cc) = pack8(o); } }
        if (lane < 16) c.DT_()[r * 16 + lane] = softplusf_(bf2f(p0[1280 + lane]) + dtb[lane]);
#pragma unroll
        for (int it = 0; it < 4; ++it) { const int g = lane + 64 * it; if (g < 232) { const int cc = g * 8; float x0[8], xm[8], xn[8], m8[8], o[8];
            unpack8(*(const u32x4*)(p0 + C_RW + cc), x0); unpack8(*(const u32x4*)(pm + C_RW + cc), xm); unpack8(*(const u32x4*)(pn + C_RW + cc), xn); ldf8(mu + cc, m8);
#pragma unroll
            for (int j = 0; j < 8; ++j) o[j] = x0[j] + (0.5f * (xm[j] * fp + xn[j] * fn) - x0[j]) * m8[j];
            if (it == 0) *(u32x4*)(c.RWR_() + (size_t)r * 512 + cc) = pack8(o);
            else if (it == 1) { const int ck = cc - 512; *(u32x4*)(c.RWK_() + (size_t)r * 512 + ck) = pack8(o); float kw[8], kq[8]; ldf8(rkk + ck, kw); float ss = 0.f;
#pragma unroll
                for (int j = 0; j < 8; ++j) { kq[j] = o[j] * kw[j]; ss += kq[j] * kq[j]; }
                ss = dred8(ss); const float inv = 1.0f / fmaxf(sqrtf(ss), 1e-12f);
#pragma unroll
                for (int j = 0; j < 8; ++j) kq[j] *= inv;
                *(u32x4*)(c.RWKK_() + (size_t)r * 512 + ck) = pack8(kq); }
            else if (it == 2) *(u32x4*)(c.RWV_() + (size_t)r * 512 + (cc - 1024)) = pack8(o);
            else { const int cl = cc - 1536;
#pragma unroll
                for (int j = 0; j < 8; ++j) { const float e2 = __expf(2.0f * o[j]); const float th = 1.0f - 2.0f / (1.0f + e2); const float sg = sigmoidf_(o[j]); o[j] = cl < 128 ? th : (cl < 192 ? o[j] : sg); }
                *(u32x4*)(c.LOWA_() + (size_t)r * KSM + cl) = pack8(o); } } }
        if (lane < 8) { unsigned z = 0u; asm volatile("" : "+v"(z)); *(u32x4*)(c.LOWA_() + (size_t)r * KSM + 320 + lane * 8) = (u32x4){z, z, z, z}; }
        {
            const int d = lane >> 5, cg = lane & 31; const float* gwp = gkw + d * 16 * 256 + cg * 8; float lr[16], acc[8];
            unpack8(*(const u32x4*)(p0 + C_GLA + 1536 + d * 16), lr); unpack8(*(const u32x4*)(p0 + C_GLA + 1536 + d * 16 + 8), lr + 8); ldf8(gkb + d * 256 + cg * 8, acc);
#pragma unroll
            for (int i = 0; i < 16; ++i) { float w[8]; ldf8(gwp + i * 256, w);
#pragma unroll
                for (int j = 0; j < 8; ++j) acc[j] += lr[i] * w[j]; }
#pragma unroll
            for (int j = 0; j < 8; ++j) acc[j] = 1.0f - __expf(softplusf_(-acc[j]) * (-1.0f / 16.0f));
            *(u32x4*)(c.SMALL_() + (size_t)r * NSM + 2048 + d * 256 + cg * 8) = pack8(acc); }
    }
}

struct SeqInfo { int L, row0, b, ctx; };
__device__ __forceinline__ SeqInfo seq_info(int s) { SeqInfo q; if (s < 16) { q.L = 256; q.row0 = s * 256; q.b = s; q.ctx = 1; } else { q.L = 1024; q.row0 = 4096 + (s - 16) * 1024; q.b = s - 16; q.ctx = 0; } return q; }

#ifndef PF_SSD
#define PF_SSD 8
#endif
#ifndef PF_GLA
#define PF_GLA 4
#endif
#ifndef PF_RW
#define PF_RW 2
#endif
__device__ __forceinline__ u32x4 ldu16(const bf16_t* ub, unsigned lo) { return *(const u32x4*)((const char*)ub + lo); }
__device__ __forceinline__ bf16_t ldu2(const bf16_t* ub, unsigned lo) { return *(const bf16_t*)((const char*)ub + lo); }
__device__ __forceinline__ float sel8(const float (&y)[8], int k) { float v = y[0]; v = k == 1 ? y[1] : v; v = k == 2 ? y[2] : v; v = k == 3 ? y[3] : v; v = k == 4 ? y[4] : v; v = k == 5 ? y[5] : v; v = k == 6 ? y[6] : v; v = k == 7 ? y[7] : v; return v; }

constexpr int REC = 336;
__device__ __forceinline__ void st8(LAS float* p, const u32x4 w) { float f[8]; unpack8(w, f); *(LAS f32x4*)p = (f32x4){f[0], f[1], f[2], f[3]}; *(LAS f32x4*)(p + 4) = (f32x4){f[4], f[5], f[6], f[7]}; }
__device__ __forceinline__ void ld8(const LAS float* p, float* f) { const f32x4 a = *(const LAS f32x4*)p, b = *(const LAS f32x4*)(p + 4); f[0] = a[0]; f[1] = a[1]; f[2] = a[2]; f[3] = a[3]; f[4] = b[0]; f[5] = b[1]; f[6] = b[2]; f[7] = b[3]; }

__device__ void scan_ssd(const Ctx& c, int l, int s, int dir, int hp) {
    const SeqInfo q = seq_info(s); const int h = hp * 2 + (c.wid >> 2), w4 = c.wid & 3, lane = c.lane, r = lane >> 3, p0 = w4 * 16 + r, np = lane & 7, g = h >> 2;
    float S[2][8];
#pragma unroll
    for (int e = 0; e < 2; ++e) {
        if (!q.ctx) { const float* st = c.in[2] + ((((size_t)q.b * 2 + l) * 2 + dir) * 8 + h) * 4096 + (p0 + 8 * e) * 64 + np * 8; const f32x4 a = *(const f32x4*)st, b = *(const f32x4*)(st + 4);
            S[e][0] = a[0]; S[e][1] = a[1]; S[e][2] = a[2]; S[e][3] = a[3]; S[e][4] = b[0]; S[e][5] = b[1]; S[e][6] = b[2]; S[e][7] = b[3]; }
        else {
#pragma unroll
            for (int j = 0; j < 8; ++j) S[e][j] = 0.f; } }
    const float adh = -__expf(c.in[17][l * 16 + dir * 8 + h]) * 1.44269504f;
    const long sgn = dir ? -1 : 1; const size_t rbase = (size_t)q.row0 + (dir ? q.L - 1 : 0);
    LAS float* lb = (LAS float*)c.lds + c.wid * (8 * REC); LAS float* wr = lb + r * REC + np * 8; const LAS float* rd = lb + np * 8;
    const char* gX = (const char*)(c.XBC_() + (rbase + sgn * r) * 768); const float* gD = c.DT_() + (rbase + sgn * r) * 16 + dir * 8 + h; const long cX = sgn * 8 * 768 * 2, cD = sgn * 8 * 16;
    const unsigned loB = (512 + g * 64 + np * 8) * 2, loX = (h * 64 + w4 * 16 + np) * 2;
    bf16_t* O = c.OUTS_() + (size_t)(0 * 2 + dir) * T * DMIX + (rbase + sgn * np) * DMIX + h * 64 + p0;
    u32x4 nB, nC; bf16_t nx0, nx1; float ndt;
#define SSD_LOAD() { nB = *(const u32x4*)(gX + loB); nC = *(const u32x4*)(gX + loB + 256); nx0 = *(const bf16_t*)(gX + loX); nx1 = *(const bf16_t*)(gX + loX + 16); ndt = *gD; gX += cX; gD += cD; }
#define SSD_STORE() { st8(wr, nB); st8(wr + 64, nC); lb[r * REC + 128 + np] = bf2f(nx0); lb[r * REC + 136 + np] = bf2f(nx1); lb[r * REC + 144] = ndt; }
    SSD_LOAD(); SSD_STORE();
    for (int i0 = 0; i0 < q.L; i0 += 8) {
        SSD_LOAD();
        float out0 = 0.f, out1 = 0.f;
#pragma unroll
        for (int j = 0; j < 8; ++j) {
            float B[8], C[8]; ld8(rd + j * REC, B); ld8(rd + j * REC + 64, C); const float x0 = lb[j * REC + 128 + r], x1 = lb[j * REC + 136 + r], dtv = lb[j * REC + 144];
            const float da = __builtin_amdgcn_exp2f(dtv * adh), xd0 = x0 * dtv, xd1 = x1 * dtv; float ya = 0.f, yb = 0.f, za = 0.f, zb = 0.f;
#pragma unroll
            for (int k = 0; k < 8; k += 2) {
                S[0][k] = da * S[0][k] + xd0 * B[k]; S[0][k + 1] = da * S[0][k + 1] + xd0 * B[k + 1]; ya += S[0][k] * C[k]; yb += S[0][k + 1] * C[k + 1];
                S[1][k] = da * S[1][k] + xd1 * B[k]; S[1][k + 1] = da * S[1][k + 1] + xd1 * B[k + 1]; za += S[1][k] * C[k]; zb += S[1][k + 1] * C[k + 1]; }
            { const float yv = dred8(ya + yb), zv = dred8(za + zb); out0 = (np == j) ? yv : out0; out1 = (np == j) ? zv : out1; }
        }
        O[0] = f2bf(out0); O[8] = f2bf(out1); O += sgn * 8 * DMIX;
        SSD_STORE();
    }
    if (q.ctx) {
#pragma unroll
        for (int e = 0; e < 2; ++e) { int ln = lane; asm volatile("" : "+v"(ln)); float* o = c.out + OUT_SSD + ((((size_t)q.b * 2 + l) * 2 + dir) * 8 + h) * 4096 + (w4 * 16 + (ln >> 3) + 8 * e) * 64 + (ln & 7) * 8; *(f32x4*)o = (f32x4){S[e][0], S[e][1], S[e][2], S[e][3]}; *(f32x4*)(o + 4) = (f32x4){S[e][4], S[e][5], S[e][6], S[e][7]}; } }
}

__device__ void scan_gla(const Ctx& c, int l, int s, int dir, int h) {
    const SeqInfo q = seq_info(s); const int lane = c.lane, r = lane >> 3, v0 = c.wid * 16 + r, kp = lane & 7;
    float S[2][8];
#pragma unroll
    for (int e = 0; e < 2; ++e) {
        if (!q.ctx) { const float* st = c.in[3] + (((((size_t)q.b * 2 + l) * 2 + dir) * 4 + h) * 64 + kp * 8) * 128 + v0 + 8 * e;
#pragma unroll
            for (int j = 0; j < 8; ++j) S[e][j] = st[j * 128]; }
        else {
#pragma unroll
            for (int j = 0; j < 8; ++j) S[e][j] = 0.f; } }
    const long sgn = dir ? -1 : 1; const size_t rbase = (size_t)q.row0 + (dir ? q.L - 1 : 0);
    LAS float* lb = (LAS float*)c.lds + c.wid * (8 * REC); LAS float* wr = lb + r * REC + kp * 8; const LAS float* rd = lb + kp * 8;
    const char* gP = (const char*)(c.PROJ_() + (rbase + sgn * r) * NPROJ); const char* gS = (const char*)(c.SMALL_() + (rbase + sgn * r) * NSM); const long cP = sgn * 8 * NPROJ * 2, cS = sgn * 8 * NSM * 2;
    const unsigned loQ = (C_GLA + h * 64 + kp * 8) * 2, loV = (C_GLA + 512 + h * 128 + c.wid * 16 + kp) * 2, loG = (2048 + dir * 256 + h * 64 + kp * 8) * 2;
    bf16_t* O = c.OUTS_() + (size_t)(1 * 2 + dir) * T * DMIX + (rbase + sgn * kp) * DMIX + h * 128 + v0;
    u32x4 nQ, nK, nG; bf16_t nv0, nv1;
#define GLA_LOAD() { nQ = *(const u32x4*)(gP + loQ); nK = *(const u32x4*)(gP + loQ + 512); nG = *(const u32x4*)(gS + loG); nv0 = *(const bf16_t*)(gP + loV); nv1 = *(const bf16_t*)(gP + loV + 16); gP += cP; gS += cS; }
#define GLA_STORE() { st8(wr, nQ); st8(wr + 64, nK); st8(wr + 128, nG); lb[r * REC + 192 + kp] = bf2f(nv0); lb[r * REC + 200 + kp] = bf2f(nv1); }
    GLA_LOAD(); GLA_STORE();
    for (int i0 = 0; i0 < q.L; i0 += 8) {
        GLA_LOAD();
        float out0 = 0.f, out1 = 0.f;
#pragma unroll 4
        for (int j = 0; j < 8; ++j) {
            float Q[8], K[8], G[8]; ld8(rd + j * REC, Q); ld8(rd + j * REC + 64, K); ld8(rd + j * REC + 128, G); const float va = lb[j * REC + 192 + r], vb = lb[j * REC + 200 + r];
            float oa = 0.f, ob = 0.f, pa = 0.f, pb = 0.f;
#pragma unroll
            for (int k = 0; k < 8; k += 2) {
                S[0][k] = (S[0][k] - S[0][k] * G[k]) + K[k] * va; S[0][k + 1] = (S[0][k + 1] - S[0][k + 1] * G[k + 1]) + K[k + 1] * va; oa += Q[k] * S[0][k]; ob += Q[k + 1] * S[0][k + 1];
                S[1][k] = (S[1][k] - S[1][k] * G[k]) + K[k] * vb; S[1][k + 1] = (S[1][k + 1] - S[1][k + 1] * G[k + 1]) + K[k + 1] * vb; pa += Q[k] * S[1][k]; pb += Q[k + 1] * S[1][k + 1]; }
            { const float yv = dred8(oa + ob), zv = dred8(pa + pb); out0 = (kp == j) ? yv : out0; out1 = (kp == j) ? zv : out1; }
        }
        O[0] = f2bf(out0 * 0.125f); O[8] = f2bf(out1 * 0.125f); O += sgn * 8 * DMIX;
        GLA_STORE();
    }
    if (q.ctx) {
#pragma unroll
        for (int e = 0; e < 2; ++e) { int ln = lane; asm volatile("" : "+v"(ln)); float* o = c.out + OUT_GLA + (((((size_t)q.b * 2 + l) * 2 + dir) * 4 + h) * 64 + (ln & 7) * 8) * 128 + c.wid * 16 + (ln >> 3) + 8 * e;
#pragma unroll
            for (int j = 0; j < 8; ++j) o[j * 128] = S[e][j]; } }
}

__device__ void scan_rwkv(const Ctx& c, int l, int s, int dir, int hs) {
    const SeqInfo q = seq_info(s); const int h = hs >> 3, rg = hs & 7, lane = c.lane, r = lane >> 3, vr = rg * 8 + r, kp = lane & 7;
    float S[8];
    if (!q.ctx) { const float* st = c.in[4] + ((((size_t)q.b * 2 + l) * 2 + dir) * 8 + h) * 4096 + vr * 64 + kp * 8; const f32x4 a = *(const f32x4*)st, b = *(const f32x4*)(st + 4);
        S[0] = a[0]; S[1] = a[1]; S[2] = a[2]; S[3] = a[3]; S[4] = b[0]; S[5] = b[1]; S[6] = b[2]; S[7] = b[3]; }
    else {
#pragma unroll
        for (int j = 0; j < 8; ++j) S[j] = 0.f; }
    const long sgn = dir ? -1 : 1; const size_t rbase = (size_t)q.row0 + (dir ? q.L - 1 : 0);
    constexpr size_t AS2 = (size_t)T * DMIX * 2;
    LAS float* lb = (LAS float*)c.lds + c.wid * (8 * REC); LAS float* wr = lb + r * REC + kp * 8; const LAS float* rd = lb + kp * 8;
    const char* gR = (const char*)(c.RWR_() + (rbase + sgn * r) * 512 + h * 64 + kp * 8); const char* gS = (const char*)(c.SMALL_() + (rbase + sgn * r) * NSM + h * 64 + kp * 8);
    const char* gV = (const char*)(c.RWV_() + (rbase + sgn * r) * 512 + h * 64 + rg * 8 + kp); const long cR = sgn * 8 * 512 * 2, cS = sgn * 8 * NSM * 2;
    const unsigned loW = dir * 1024;
    bf16_t* O = c.OUTS_() + (size_t)(2 * 2 + dir) * T * DMIX + (rbase + sgn * kp) * DMIX + h * 64 + vr;
    u32x4 nR, nK, nKK, nA, nW; bf16_t nv;
#define RW_LOAD() { nR = *(const u32x4*)gR; nK = *(const u32x4*)(gR + AS2); nKK = *(const u32x4*)(gR + 3 * AS2); nA = *(const u32x4*)(gS + 2048); nW = *(const u32x4*)(gS + loW); nv = *(const bf16_t*)gV; gR += cR; gS += cS; gV += cR; }
#define RW_STORE() { st8(wr, nR); st8(wr + 64, nK); st8(wr + 128, nKK); st8(wr + 192, nA); st8(wr + 256, nW); lb[r * REC + 320 + kp] = bf2f(nv); }
    RW_LOAD(); RW_STORE();
    for (int i0 = 0; i0 < q.L; i0 += 8) {
        RW_LOAD();
        float outv = 0.f;
#pragma unroll
        for (int j = 0; j < 8; ++j) {
            float R[8], K[8], KK[8], A[8], W[8]; ld8(rd + j * REC, R); ld8(rd + j * REC + 64, K); ld8(rd + j * REC + 128, KK); ld8(rd + j * REC + 192, A); ld8(rd + j * REC + 256, W); const float vv = lb[j * REC + 320 + r];
            float s0 = 0.f, s1 = 0.f;
#pragma unroll
            for (int k = 0; k < 8; k += 2) { s0 += S[k] * KK[k]; s1 += S[k + 1] * KK[k + 1]; }
            const float skk = dred8(s0 + s1); float o0 = 0.f, o1 = 0.f;
#pragma unroll
            for (int k = 0; k < 8; k += 2) {
                S[k] = (S[k] - S[k] * W[k]) - skk * A[k] + vv * K[k]; S[k + 1] = (S[k + 1] - S[k + 1] * W[k + 1]) - skk * A[k + 1] + vv * K[k + 1];
                o0 += S[k] * R[k]; o1 += S[k + 1] * R[k + 1]; }
            { const float yv = dred8(o0 + o1); outv = (kp == j) ? yv : outv; }
        }
        *O = f2bf(outv); O += sgn * 8 * DMIX;
        RW_STORE();
    }
    if (q.ctx) { float* o = c.out + OUT_RWK + ((((size_t)q.b * 2 + l) * 2 + dir) * 8 + h) * 4096 + vr * 64 + kp * 8; *(f32x4*)o = (f32x4){S[0], S[1], S[2], S[3]}; *(f32x4*)(o + 4) = (f32x4){S[4], S[5], S[6], S[7]}; }
}

__device__ __forceinline__ void scan_item(const Ctx& c, int l, int id) {
    if (id < 320) { int n = id, s; if (n < 64) s = 16 + (n >> 4); else { n -= 64; s = n >> 4; }
        const int sub = n & 15; scan_rwkv(c, l, s, sub >> 3, (sub & 7) * 8 + c.wid); }
    else { const bool gla = id < 480; int m = gla ? id - 320 : id - 480, s; if (m < 32) s = 16 + (m >> 3); else { m -= 32; s = m >> 3; }
        const int sub = m & 7; if (gla) scan_gla(c, l, s, sub >> 2, sub & 3); else scan_ssd(c, l, s, sub >> 2, sub & 3); }
}
#define RW_L(n) (n)
#define RW_S(n) (64 + (n))
#define GLA_L(m) (320 + (m))
#define GLA_S(m) (320 + 32 + (m))
#define SSD_L(m) (480 + (m))
#define SSD_S(m) (480 + 32 + (m))
__device__ void phase_scan(const Ctx& c, int l) {
    const bool bal = c.G == 256; const int n = bal ? ((c.bid & 7) < 4 ? 1 : 4) : (640 - c.bid + c.G - 1) / c.G;
    for (int k = 0; k < n; ++k) {
        int bl = c.bid; asm volatile("" : "+s"(bl));
        const int cl = bl & 7, ix = bl >> 3, j = (cl - 4) * 32 + ix;
        const int id = !bal ? bl + k * c.G : (cl < 2 ? RW_L(ix * 2 + cl) : (cl == 2 ? GLA_L(ix) : (cl == 3 ? SSD_L(ix) : (k == 0 ? RW_S(2 * j) : (k == 1 ? RW_S(2 * j + 1) : (k == 2 ? GLA_S(j) : SSD_S(j)))))));
        scan_item(c, l, id);
    }
}

#ifndef PPT
#define PPT 1
#endif
__device__ void phase_postpass(const Ctx& c, int l) {
    const int lane = c.lane, c0 = lane * 8;
    const float* Dp = c.in[18] + l * 16; const float* snorm = c.in[19] + l * 512; const float* gnorm = c.in[23] + l * 128;
    const float* rk = c.in[33] + l * 512; const float* lnw = c.in[34] + l * 512; const float* lnb = c.in[35] + l * 512;
    constexpr size_t SL = (size_t)T * DMIX;
    for (int r0 = c.gw; r0 < T; r0 += PPT * c.NW) {
        u32x4 q[PPT][13];
#pragma unroll
        for (int e = 0; e < PPT; ++e) { const int r = min(r0 + e * c.NW, T - 1); const bf16_t* p0 = c.PROJ_() + (size_t)r * NPROJ; const bf16_t* of = c.OUTS_() + (size_t)r * DMIX + c0;
            q[e][0] = *(const u32x4*)of; q[e][1] = *(const u32x4*)(of + SL); q[e][2] = *(const u32x4*)(c.XBC_() + (size_t)r * 768 + c0); q[e][3] = *(const u32x4*)(p0 + c0);
            q[e][4] = *(const u32x4*)(of + 2 * SL); q[e][5] = *(const u32x4*)(of + 3 * SL); q[e][6] = *(const u32x4*)(p0 + C_GLA + 1024 + c0);
            q[e][7] = *(const u32x4*)(of + 4 * SL); q[e][8] = *(const u32x4*)(of + 5 * SL); q[e][9] = *(const u32x4*)(c.RWR_() + (size_t)r * 512 + c0); q[e][10] = *(const u32x4*)(c.RWK_() + (size_t)r * 512 + c0);
            q[e][11] = *(const u32x4*)(c.RWV_() + (size_t)r * 512 + c0); q[e][12] = *(const u32x4*)(c.SMALL_() + (size_t)r * NSM + 1536 + c0); }
#pragma unroll
        for (int e = 0; e < PPT; ++e) { const int r = r0 + e * c.NW; if (r >= T) break;
            bf16_t* of = c.OUTS_() + (size_t)r * DMIX + c0;
            {
                float a[8], b[8], x[8], z[8], y[8]; unpack8(q[e][0], a); unpack8(q[e][1], b); unpack8(q[e][2], x); unpack8(q[e][3], z);
                const int h = lane >> 3; const float dsum = Dp[h] + Dp[8 + h]; float ss = 0.f;
#pragma unroll
                for (int j = 0; j < 8; ++j) { y[j] = (x[j] * dsum + a[j] + b[j]) * siluf_(z[j]); ss += y[j] * y[j]; }
                ss = wave_sum(ss, c.lane); const float rs = rsqrtf(ss * (1.0f / 512.0f) + 1e-6f);
#pragma unroll
                for (int j = 0; j < 8; ++j) y[j] = y[j] * rs * snorm[c0 + j];
                *(u32x4*)of = pack8(y);
            }
            {
                float a[8], b[8], g[8], y[8]; unpack8(q[e][4], a); unpack8(q[e][5], b); unpack8(q[e][6], g);
                float ss = 0.f;
#pragma unroll
                for (int j = 0; j < 8; ++j) { y[j] = a[j] + b[j]; ss += y[j] * y[j]; }
                ss = dred8(ss); ss += shx(ss, c.lane, 8);
                const float rs = rsqrtf(ss * (1.0f / 128.0f) + 1e-6f);
#pragma unroll
                for (int j = 0; j < 8; ++j) y[j] = y[j] * rs * gnorm[(c0 + j) & 127] * siluf_(g[j]);
                *(u32x4*)(of + 2 * SL) = pack8(y);
            }
            {
                float a[8], b[8], rr[8], kk[8], vv[8], gg[8], y[8];
                unpack8(q[e][7], a); unpack8(q[e][8], b); unpack8(q[e][9], rr); unpack8(q[e][10], kk); unpack8(q[e][11], vv); unpack8(q[e][12], gg);
                float sm = 0.f, bon = 0.f;
#pragma unroll
                for (int j = 0; j < 8; ++j) { y[j] = a[j] + b[j]; sm += y[j]; bon += rr[j] * kk[j] * rk[c0 + j]; }
                sm = dred8(sm); bon = dred8(bon); const float mean = sm * (1.0f / 64.0f); float vs = 0.f;
#pragma unroll
                for (int j = 0; j < 8; ++j) { y[j] -= mean; vs += y[j] * y[j]; }
                vs = dred8(vs); const float rs = rsqrtf(vs * (1.0f / 64.0f) + 64e-5f);
#pragma unroll
                for (int j = 0; j < 8; ++j) y[j] = (y[j] * rs * lnw[c0 + j] + lnb[c0 + j] + bon * vv[j]) * gg[j];
                *(u32x4*)(of + 4 * SL) = pack8(y);
            }
        }
    }
}

#ifndef RMASK
#define RMASK 0
#endif
#ifndef RMASK3
#define RMASK3 0
#endif
constexpr int N_PHASES = 2 + 2 * (14 + __builtin_popcount(RMASK) + 2 * __builtin_popcount(RMASK3));
__global__ void __launch_bounds__(NT, 2) fwd_kernel(Args a) {
    extern __shared__ __attribute__((aligned(16))) unsigned char lds_raw[];
    Ctx c; c.in = a.in; c.out = a.out; c.ws = a.ws; c.lds = (LAS unsigned char*)lds_raw;
    cg::grid_group grid = cg::this_grid();
    volatile LAS unsigned* st = (volatile LAS unsigned*)(c.lds + LDS_STAGE);
    if (threadIdx.x < 4) st[threadIdx.x] = 0u;
    __syncthreads();
    const XcdBarrier bar = xcd_barrier_post((unsigned*)(a.ws + WS_BAR), st);
    if (a.ph_hi < 0) grid.sync();
    for (int ph = a.ph_lo; ph < a.ph_hi; ++ph) {
#ifndef EXTRA_SYNC
#define EXTRA_SYNC 0
#endif
        if (ph > a.ph_lo) { xcd_barrier(bar); for (int e = 0; e < EXTRA_SYNC; ++e) xcd_barrier(bar); }
        { int tl = threadIdx.x, bl = blockIdx.x, gl = gridDim.x; asm volatile("" : "+v"(tl), "+s"(bl), "+s"(gl)); c.G = gl; c.NW = gl * 8;
          c.tid = tl; c.lane = tl & 63; c.wid = __builtin_amdgcn_readfirstlane(tl >> 6); c.bid = bl; c.gw = bl * 8 + c.wid; }
        if (ph == 0) { phase_init(c); __syncthreads(); const int base = convert_ffn(c, 0, 0, 0); convert_mixer(c, 0, base); continue; }
        if (ph == N_PHASES - 1) { phase_final_norm(c); continue; }
#ifndef RMASK
#define RMASK 0
#endif
        constexpr int LAYER_LEN = 14 + __builtin_popcount(RMASK) + 2 * __builtin_popcount(RMASK3);
        const int l = (ph - 1) / LAYER_LEN; int sp = 0; float sgn = 1.0f;
        if (RMASK | RMASK3) { int k = (ph - 1) % LAYER_LEN; for (sp = 0; sp < 14; ++sp) { const int reps = 1 + ((RMASK >> sp) & 1) + 2 * ((RMASK3 >> sp) & 1); if (k < reps) break; k -= reps; } sgn = (k & 1) ? -1.0f : 1.0f; }
        else sp = (ph - 1) % 14;
        const float* ada_l = c.ADA_() + l * 5 * 9216;
#ifndef PMASK
#define PMASK 0xFFFF
#endif
#define PON(k) ((PMASK >> (k)) & 1)
        switch (sp) {
            case 0: if (PON(0)) { phase_norm(c, l, 0, l > 0); if (l > 0) { __syncthreads(); int base = convert_ffn(c, l, 0, 0); convert_mixer(c, l, base); } } break;
            case 1: case 12: if (PON(1)) run_gemm(c, c.H_(), c.WGU_(), 5632, 1024, EpiGU{c.PROJ_()}); break;
            case 2: if (PON(2)) run_gemm(c, c.PROJ_(), c.WD_(), 1024, DFF, EpiResid{c.OUTS_(), ada_l + 2 * 1024, 0.5f * sgn}, 2); break;
            case 13: if (PON(2)) run_gemm(c, c.PROJ_(), c.WD_(), 1024, DFF, EpiResid{c.OUTS_(), ada_l + 8 * 1024, 0.5f * sgn}, 2); break;
            case 3: if (PON(3)) phase_norm(c, l, 1, true); break;
            case 4: if (PON(4)) run_gemm(c, c.H_(), c.WIN_(), NPROJ, 1024, EpiProj{c.PROJ_(), NPROJ}); break;
            case 5: if (PON(5)) phase_prepass(c, l); break;
            case 6: if (PON(6)) run_gemm(c, c.LOWA_(), c.WSM_(), 2048, KSM, EpiSmall{c.SMALL_(), c.in[26] + l * 1024, c.in[28] + l * 512, c.RWK_(), c.RWKK_(), c.in[32] + l * 512}); break;
            case 7: if (PON(7)) phase_scan(c, l); break;
            case 8: if (PON(8)) phase_postpass(c, l); break;
            case 9: if (PON(9)) { int Kl = 512; asm volatile("" : "+s"(Kl));
                pg8::Gemm g{c.OUTS_(), c.WBO_(), T, 3072, Kl, 512, 4, (size_t)2 * T * DMIX * 2, (size_t)1024 * 512 * 2}; BranchOrder S{c.bid};
                pg8::gemm_phase<EpiBranch, BranchOrder, GP_ALIGN, GP_SP2>(c.lds, g, S, EpiBranch{c.H_(), c.PROJ_() + C_GATE});
                if (c.G > 128 && c.bid >= 128) { Ctx c2 = c; c2.bid = c.bid - 128; c2.G = c.G - 128; (void)convert_ffn(c2, l, 1, 0); } } break;
            case 10: if (PON(10)) run_gemm(c, c.H_(), c.WOUT_(), 1024, 1024, EpiResid{c.OUTS_(), ada_l + 5 * 1024, 1.0f * sgn}, 2); break;
            case 11: if (PON(11)) { phase_norm(c, l, 2, true); if (c.G <= 128) { __syncthreads(); (void)convert_ffn(c, l, 1, 0); } } break;
        }
    }
}

#ifndef N_LAUNCH_MODE
#define N_LAUNCH_MODE 1
#endif
extern "C" void kernel_launch(void* const* d_in, const int* in_sizes, int n_in, void* d_out, int out_size, void* d_ws, size_t ws_size, hipStream_t stream) {
    static int grid = 0;
    if (grid == 0) {
        if (n_in != 39 || ws_size < WS_END) { fprintf(stderr, "kernel_launch: need 39 inputs and %zu bytes of workspace; got %d, %zu\n", (size_t)WS_END, n_in, ws_size); grid = -1; return; }
        if (hipFuncSetAttribute((const void*)fwd_kernel, hipFuncAttributeMaxDynamicSharedMemorySize, LDS_BYTES) != hipSuccess) { fprintf(stderr, "kernel_launch: hipFuncSetAttribute failed\n"); grid = -1; return; }
        int dev = 0, cus = 0, per_cu = 0;
        hipGetDevice(&dev); hipDeviceGetAttribute(&cus, hipDeviceAttributeMultiprocessorCount, dev);
        hipOccupancyMaxActiveBlocksPerMultiprocessor(&per_cu, (const void*)fwd_kernel, NT, LDS_BYTES);
        if (per_cu < 1) { fprintf(stderr, "kernel_launch: occupancy query says %d blocks per CU\n", per_cu); per_cu = 1; }
        (void)hipGetLastError();
        grid = cus;
    }
    if (grid < 0) return;
    Args a{};
    for (int i = 0; i < 39; ++i) a.in[i] = (const float*)d_in[i];
    a.out = (float*)d_out; a.ws = (unsigned char*)d_ws;
#if N_LAUNCH_MODE == 0
    for (int ph = 0; ph < N_PHASES; ++ph) { a.ph_lo = ph; a.ph_hi = ph + 1; hipLaunchKernelGGL(fwd_kernel, dim3(grid), dim3(NT), LDS_BYTES, stream, a); }
#else
    if (hipMemsetAsync((unsigned char*)d_ws + WS_BAR, 0, XCD_BAR_WORDS * 4, stream) != hipSuccess) { fprintf(stderr, "kernel_launch: memset of the barrier words failed\n"); return; }
    a.ph_lo = 0; a.ph_hi = N_PHASES;
    void* args[] = {&a};
    hipError_t e = hipLaunchCooperativeKernel((const void*)fwd_kernel, dim3(grid), dim3(NT), args, LDS_BYTES, stream);
    if (e != hipSuccess) fprintf(stderr, "cooperative launch failed: %s (grid %d)\n", hipGetErrorString(e), grid);
#endif
}
```

```cpp
#include <hip/hip_runtime.h>
#include <hip/hip_cooperative_groups.h>
#include <cstdio>
namespace cg = cooperative_groups;
namespace pg8 {
#define PG8_LAS __attribute__((address_space(3)))
typedef unsigned short bf16_t;
typedef short bf16x8 __attribute__((ext_vector_type(8)));
typedef float f32x4 __attribute__((ext_vector_type(4)));
typedef unsigned u32x4 __attribute__((ext_vector_type(4)));
constexpr int BM = 256, BK = 64, HALF = 128, HTB = HALF * BK * 2  , STAGE_BYTES = 8 * HTB, NXCD = 8, WGM = 8;

__host__ __device__ __forceinline__ int lds_byte(int r, int c) { const int st = (r >> 4) * 2 + (c >> 5), rr = r & 15, cc = c & 31, ob = rr * 64 + cc * 2; return st * 1024 + (ob ^ (((ob >> 9) & 1) << 5)); }
__host__ __device__ __forceinline__ void stage_rc(int b, int& R, int& C) { const int st = b / 1024, sb = b % 1024, swz = sb ^ (((sb >> 9) & 1) << 5); R = (st >> 1) * 16 + swz / 64; C = (st & 1) * 32 + (swz % 64) / 2; }
__host__ __device__ __forceinline__ int perm32(int rho) { const int n = rho >> 4, i = rho & 15; return 8 * (i >> 2) + 4 * n + (i & 3); }

struct Unit { int pm, pn; };
struct Gemm { const bf16_t* A; const bf16_t* Bt; int M, N, K, ld, nreal; size_t asl, bsl; };

struct StaticOrder {
    int nM, nN, nwg, G, c;
    __host__ __device__ void init(int M, int N, int G_, int c_) { nM = M / BM; nN = N / BM; nwg = nM * nN; G = G_; c = c_; }
    __host__ __device__ bool next(int i, Unit& u) const {
        const long L = (long)i * G + c; if (L >= nwg) return false;
        int wgid = (int)L; { const int q = nwg / NXCD, r = nwg % NXCD, xcd = wgid % NXCD, off = wgid / NXCD; wgid = (xcd < r ? xcd * (q + 1) : r * (q + 1) + (xcd - r) * q) + off; }
        const int nig = WGM * nN, gid = wgid / nig, fm = gid * WGM, gsz = (nM - fm) < WGM ? (nM - fm) : WGM;
        u.pm = fm + ((wgid % nig) % gsz); u.pn = (wgid % nig) / gsz; return true;
    }
    __device__ __forceinline__ void a_ready(const Unit&) const {}
    __device__ __forceinline__ void done(const Unit&) const {}
};
__device__ __forceinline__ unsigned cvt_pk_bf16(float lo, float hi) { unsigned r; asm volatile("v_cvt_pk_bf16_f32 %0, %1, %2" : "=v"(r) : "v"(lo), "v"(hi)); return r; }
template <class Epi, class Sched, bool ALIGN_EPI = false, bool SP2 = false>
__device__ __forceinline__ void gemm_phase(PG8_LAS unsigned char* lds, const Gemm g, const Sched& S, const Epi& E) {
    int tid_l = threadIdx.x; asm volatile("" : "+v"(tid_l));
    const int tid = tid_l, wid = __builtin_amdgcn_readfirstlane(tid >> 6), lane = tid & 63, wr = wid >> 2, wc = wid & 3, fr = lane & 15, fq = lane >> 4;
    const int K = g.K, LD = g.ld, nt = K / BK;
    unsigned voffA[2], voffB[2];
#pragma unroll
    for (int i = 0; i < 2; ++i) { int R, C; stage_rc(tid * 16 + i * 8192, R, C); const int Rb = Epi::PERM ? ((R & ~31) + perm32(R & 31)) : R;
        voffA[i] = (unsigned)(R * LD + C) * 2u; voffB[i] = (unsigned)(Rb * LD + C) * 2u; }
    const size_t kstep = (size_t)(BK * 2);
    const size_t hstep = (size_t)HALF * LD * 2;
    const size_t tstep = 2 * hstep;
    const unsigned ldsw = (unsigned)wid * 1024u;
    const int aoff = lds_byte(wr * 64 + fr, fq * 8), boff = lds_byte(wc * 32 + fr, fq * 8);
#define PG8_SA(b, h) (((b) * 2 + (h)) * HTB)
#define PG8_SB(b, h) ((4 + (b) * 2 + (h)) * HTB)
#define PG8_STAGE(bufoff, gbase, voff) do { _Pragma("unroll") for (int _i = 0; _i < 2; ++_i) \
        __builtin_amdgcn_global_load_lds((const unsigned*)((const char*)(gbase) + (voff)[_i]), (PG8_LAS unsigned*)(lds + (bufoff) + ldsw + _i * 8192), 16, 0, 0); } while (0)
#define PG8_LDA(dst, b, h) do { _Pragma("unroll") for (int m = 0; m < 4; ++m) _Pragma("unroll") for (int k = 0; k < 2; ++k) dst[m][k] = *(const PG8_LAS bf16x8*)(lds + PG8_SA(b, h) + aoff + m * 2048 + k * 1024); } while (0)
#define PG8_LDB(dst, b, h) do { _Pragma("unroll") for (int n = 0; n < 2; ++n) _Pragma("unroll") for (int k = 0; k < 2; ++k) dst[n][k] = *(const PG8_LAS bf16x8*)(lds + PG8_SB(b, h) + boff + n * 2048 + k * 1024); } while (0)
#define PG8_MMA(ai, bj, At, Bt) do { __builtin_amdgcn_s_setprio(1); _Pragma("unroll") for (int m = 0; m < 4; ++m) _Pragma("unroll") for (int n = 0; n < 2; ++n) _Pragma("unroll") for (int k = 0; k < 2; ++k) \
        acc[ai][bj][m][n] = __builtin_amdgcn_mfma_f32_16x16x32_bf16(Bt[n][k], At[m][k], acc[ai][bj][m][n], 0, 0, 0); __builtin_amdgcn_s_setprio(0); } while (0)
#define PG8_WAIT_V(n) asm volatile("s_waitcnt vmcnt(" #n ")" ::: "memory")
#define PG8_WAIT_L(n) asm volatile("s_waitcnt lgkmcnt(" #n ")" ::: "memory")
#define PG8_BAR __builtin_amdgcn_s_barrier()
#define PG8_SCHED __builtin_amdgcn_sched_barrier(0)
    Unit cur, nxt; int ui = 0;
    if (!S.next(0, cur)) return;
    f32x4 acc[2][2][4][2];
#pragma unroll
    for (int a = 0; a < 2; ++a)
#pragma unroll
        for (int b = 0; b < 2; ++b)
#pragma unroll
            for (int m = 0; m < 4; ++m)
#pragma unroll
                for (int n = 0; n < 2; ++n) acc[a][b][m][n] = (f32x4){0.f, 0.f, 0.f, 0.f};
    bf16x8 At[4][2], B0[2][2], B1[2][2];
    const char* cA = (const char*)g.A + (size_t)cur.pm * tstep + (size_t)(cur.pn / g.nreal) * g.asl; const char* cB = (const char*)g.Bt + (size_t)(cur.pn % g.nreal) * tstep + (size_t)(cur.pn / g.nreal) * g.bsl;
    S.a_ready(cur);
    if constexpr (SP2) {
        PG8_STAGE(PG8_SB(0, 0), cB, voffB); PG8_STAGE(PG8_SB(0, 1), cB + hstep, voffB); PG8_STAGE(PG8_SA(0, 0), cA, voffA); PG8_STAGE(PG8_SA(0, 1), cA + hstep, voffA);
        if (wr == 1) PG8_BAR;
        PG8_WAIT_V(2); PG8_BAR;
        PG8_STAGE(PG8_SB(1, 0), cB + kstep, voffB); PG8_STAGE(PG8_SA(1, 0), cA + kstep, voffA); PG8_STAGE(PG8_SB(1, 1), cB + hstep + kstep, voffB);
        PG8_WAIT_V(6); PG8_BAR;
    } else {
        PG8_STAGE(PG8_SB(0, 0), cB, voffB); PG8_STAGE(PG8_SA(0, 0), cA, voffA); PG8_STAGE(PG8_SB(0, 1), cB + hstep, voffB); PG8_STAGE(PG8_SA(0, 1), cA + hstep, voffA);
        if (wr == 1) PG8_BAR;
        PG8_WAIT_V(4); PG8_BAR;
        PG8_STAGE(PG8_SB(1, 0), cB + kstep, voffB); PG8_STAGE(PG8_SA(1, 0), cA + kstep, voffA); PG8_STAGE(PG8_SB(1, 1), cB + hstep + kstep, voffB);
        PG8_WAIT_V(6); PG8_BAR;
    }
    for (;;) {
        const bool has_next = S.next(ui + 1, nxt);
        const char* nA = has_next ? (const char*)g.A + (size_t)nxt.pm * tstep + (size_t)(nxt.pn / g.nreal) * g.asl : cA; const char* nB = has_next ? (const char*)g.Bt + (size_t)(nxt.pn % g.nreal) * tstep + (size_t)(nxt.pn / g.nreal) * g.bsl : cB;
        for (int t = 0; t < nt; t += 2) {
            const bool last = (t == nt - 2);
            const char* a1 = cA + (size_t)(t + 1) * kstep;
            const char* a2 = last ? nA : cA + (size_t)(t + 2) * kstep; const char* b2 = last ? nB : cB + (size_t)(t + 2) * kstep;
            const char* a3 = a2 + kstep; const char* b3 = b2 + kstep;
            if (last && has_next) S.a_ready(nxt);
            if constexpr (SP2) {
            PG8_LDB(B0, 0, 0); PG8_LDB(B1, 0, 1); PG8_SCHED; PG8_LDA(At, 0, 0); PG8_STAGE(PG8_SA(1, 1), a1 + hstep, voffA);
            PG8_WAIT_V(8); PG8_WAIT_L(0); PG8_BAR; PG8_MMA(0, 0, At, B0); PG8_MMA(0, 1, At, B1); PG8_BAR; PG8_SCHED;
            PG8_LDA(At, 0, 1); PG8_STAGE(PG8_SB(0, 0), b2, voffB); PG8_STAGE(PG8_SB(0, 1), b2 + hstep, voffB); PG8_STAGE(PG8_SA(0, 0), a2, voffA);
            PG8_WAIT_V(8); PG8_WAIT_L(0); PG8_BAR; PG8_MMA(1, 0, At, B0); PG8_MMA(1, 1, At, B1); PG8_BAR; PG8_SCHED;
            PG8_LDB(B0, 1, 0); PG8_LDB(B1, 1, 1); PG8_SCHED; PG8_LDA(At, 1, 0); PG8_STAGE(PG8_SA(0, 1), a2 + hstep, voffA);
            PG8_WAIT_V(8); PG8_WAIT_L(0); PG8_BAR; PG8_MMA(0, 0, At, B0); PG8_MMA(0, 1, At, B1); PG8_BAR; PG8_SCHED;
            PG8_LDA(At, 1, 1); PG8_STAGE(PG8_SB(1, 0), b3, voffB); PG8_STAGE(PG8_SB(1, 1), b3 + hstep, voffB); PG8_STAGE(PG8_SA(1, 0), a3, voffA);
            PG8_WAIT_V(8); PG8_WAIT_L(0); PG8_BAR; PG8_MMA(1, 0, At, B0); PG8_MMA(1, 1, At, B1); PG8_BAR; PG8_SCHED;
            } else {
            PG8_LDB(B0, 0, 0); PG8_SCHED; PG8_LDA(At, 0, 0); PG8_STAGE(PG8_SA(1, 1), a1 + hstep, voffA);
            PG8_WAIT_L(8); PG8_BAR; PG8_WAIT_L(0); PG8_MMA(0, 0, At, B0); PG8_BAR; PG8_SCHED;
            PG8_LDB(B1, 0, 1); PG8_STAGE(PG8_SB(0, 0), b2, voffB);
            PG8_BAR; PG8_WAIT_L(0); PG8_MMA(0, 1, At, B1); PG8_BAR;
            PG8_LDA(At, 0, 1); PG8_STAGE(PG8_SA(0, 0), a2, voffA);
            PG8_BAR; PG8_WAIT_L(0); PG8_MMA(1, 0, At, B0); PG8_BAR; PG8_SCHED;
            PG8_STAGE(PG8_SB(0, 1), b2 + hstep, voffB);
            PG8_WAIT_V(6); PG8_BAR; PG8_MMA(1, 1, At, B1); PG8_BAR;
            PG8_LDB(B0, 1, 0); PG8_SCHED; PG8_LDA(At, 1, 0); PG8_STAGE(PG8_SA(0, 1), a2 + hstep, voffA);
            PG8_WAIT_L(8); PG8_BAR; PG8_WAIT_L(0); PG8_MMA(0, 0, At, B0); PG8_BAR; PG8_SCHED;
            PG8_LDB(B1, 1, 1); PG8_STAGE(PG8_SB(1, 0), b3, voffB);
            PG8_BAR; PG8_WAIT_L(0); PG8_MMA(0, 1, At, B1); PG8_BAR;
            PG8_LDA(At, 1, 1); PG8_STAGE(PG8_SA(1, 0), a3, voffA);
            PG8_BAR; PG8_WAIT_L(0); PG8_MMA(1, 0, At, B0); PG8_BAR; PG8_SCHED;
            PG8_STAGE(PG8_SB(1, 1), b3 + hstep, voffB);
            PG8_WAIT_V(6); PG8_BAR; PG8_MMA(1, 1, At, B1); PG8_BAR;
            }
        }
        if constexpr (ALIGN_EPI) { if (wr == 0) PG8_BAR; }
        if constexpr (!Epi::AFTER_DRAIN) { E(acc, cur, wr, wc, fr, fq); S.done(cur); }
        if (!has_next) break;
#pragma unroll
        for (int a = 0; a < 2; ++a)
#pragma unroll
            for (int b = 0; b < 2; ++b)
#pragma unroll
                for (int m = 0; m < 4; ++m)
#pragma unroll
                    for (int n = 0; n < 2; ++n) acc[a][b][m][n] = (f32x4){0.f, 0.f, 0.f, 0.f};
        cur = nxt; cA = nA; cB = nB; ++ui;
        if constexpr (ALIGN_EPI) { if (wr == 1) PG8_BAR; }
    }
    PG8_WAIT_V(0);
    if constexpr (!ALIGN_EPI) { if (wr == 0) PG8_BAR; }
    PG8_BAR;
    if constexpr (Epi::AFTER_DRAIN) { E.fused(acc, cur, wr, wc, fr, fq, lds, wid, lane); S.done(cur); }
#undef PG8_SA
#undef PG8_SB
#undef PG8_STAGE
#undef PG8_LDA
#undef PG8_LDB
#undef PG8_MMA
#undef PG8_WAIT_V
#undef PG8_WAIT_L
#undef PG8_BAR
#undef PG8_SCHED
}
}
#define LAS __attribute__((address_space(3)))
#define XB_TMO      128
#define XB_XCNT(j)  (256  + 64 * (j))
#define XB_XSUB(j)  (1280 + 64 * (j))
#define XB_XGEN(j)  (2304 + 64 * (j))
#define XB_TOP      3328
#define XB_TOPGEN   3392
#define XCD_BAR_WORDS 3456
#define XB_SPIN_CAP (1u << 18)

__device__ __forceinline__ unsigned xb_ld(unsigned* p)              { return __hip_atomic_load(p, __ATOMIC_RELAXED, __HIP_MEMORY_SCOPE_AGENT); }
__device__ __forceinline__ unsigned xb_add(unsigned* p, unsigned v) { return __hip_atomic_fetch_add(p, v, __ATOMIC_RELAXED, __HIP_MEMORY_SCOPE_AGENT); }
__device__ __forceinline__ unsigned xb_xcc_id() { return (unsigned)__builtin_amdgcn_s_getreg((3 << 11) | 20) & 0xFu; }
#define XB_SPIN(cond, bar) do { unsigned _sp = 0; while (cond) { __builtin_amdgcn_s_sleep(1); \
    if ((++_sp & 255u) == 0u) { if (xb_ld(&(bar)[XB_TMO])) break; if (_sp > XB_SPIN_CAP) { atomicAdd(&(bar)[XB_TMO], 1u); break; } } } } while (0)

struct XcdBarrier {
    unsigned* bar; unsigned x;
    volatile LAS unsigned* st;
};

__device__ __forceinline__ XcdBarrier xcd_barrier_post(unsigned* bar, volatile LAS unsigned* st) {
    XcdBarrier b; b.bar = bar; b.x = xb_xcc_id(); b.st = st;
    if (threadIdx.x == 0) (void)xb_add(&bar[XB_XCNT(b.x)], 1u);
    return b;
}
__device__ __forceinline__ void xcd_barrier_complete(unsigned* bar, unsigned x, unsigned& nloc, unsigned& nx) {
    const unsigned G = gridDim.x * gridDim.y * gridDim.z;
    unsigned sum, cnt, mine, sp = 0u;
    for (;;) {
        sum = 0u; cnt = 0u; mine = 0u;
#pragma unroll
        for (unsigned j = 0; j < 16; ++j) { const unsigned c = xb_ld(&bar[XB_XCNT(j)]); sum += c; cnt += (c > 0u) ? 1u : 0u; mine = (j == x) ? c : mine; }
        if (sum == G) break;
        __builtin_amdgcn_s_sleep(1);
        if ((++sp & 255u) == 0u) { if (xb_ld(&bar[XB_TMO])) break; if (sp > XB_SPIN_CAP) { atomicAdd(&bar[XB_TMO], 1u); break; } }
    }
    nloc = mine > 0u ? mine : 1u; nx = cnt > 0u ? cnt : 1u;
}

__device__ __forceinline__ void xcd_barrier(const XcdBarrier& b) {
    asm volatile("s_waitcnt vmcnt(0)" ::: "memory");
    __syncthreads();
    if (threadIdx.x == 0) {
        unsigned* bar = b.bar;
        __builtin_amdgcn_s_waitcnt(0);
        unsigned nloc = b.st[0], nx = b.st[1];
        if (nloc == 0u) { xcd_barrier_complete(bar, b.x, nloc, nx); b.st[0] = nloc; b.st[1] = nx; }
        const unsigned old = xb_add(&bar[XB_XSUB(b.x)], 1u);
        const unsigned gen = old / nloc;
        if (old + 1u == (gen + 1u) * nloc) {
            __builtin_amdgcn_fence(__ATOMIC_RELEASE, "agent");
            asm volatile("s_waitcnt vmcnt(0)" ::: "memory");
            const unsigned og = xb_add(&bar[XB_TOP], 1u);
            const unsigned tg = og / nx;
            if (og + 1u == (tg + 1u) * nx) xb_add(&bar[XB_TOPGEN], 1u);
            else XB_SPIN(xb_ld(&bar[XB_TOPGEN]) == tg, bar);
            __builtin_amdgcn_fence(__ATOMIC_ACQUIRE, "agent");
            xb_add(&bar[XB_XGEN(b.x)], 1u);
            asm volatile("s_waitcnt vmcnt(0)" ::: "memory");
        } else {
            XB_SPIN(xb_ld(&bar[XB_XGEN(b.x)]) == gen, bar);
            __builtin_amdgcn_fence(__ATOMIC_ACQUIRE, "agent");
            asm volatile("s_waitcnt vmcnt(0)" ::: "memory");
        }
    }
    __syncthreads();
}

using pg8::bf16_t; using pg8::f32x4; using pg8::u32x4; using pg8::cvt_pk_bf16;
typedef unsigned u32x2 __attribute__((ext_vector_type(2)));

constexpr int T = 8192, D = 1024, DFF = 2816, DMIX = 512, NPROJ = 7936, NIN = 7792, NSM = 2560, KSM = 384, NT = 512, LDS_STAGE = 131072, LDS_BYTES = LDS_STAGE + 16;
constexpr int C_GLA = 1296, C_RW = 2864, C_GATE = 4720;
constexpr size_t WS_ADA = 0;
constexpr size_t WS_WGU = WS_ADA + 2ull * 5 * 9216 * 4;
constexpr size_t WS_WD = WS_WGU + 5632ull * 1024 * 2;
constexpr size_t WS_WIN = WS_WD + 1024ull * 2816 * 2;
constexpr size_t WS_WBO = WS_WIN + (size_t)NPROJ * 1024 * 2;
constexpr size_t WS_WOUT = WS_WBO + 3ull * 1024 * 512 * 2;
constexpr size_t WS_WSM = WS_WOUT + 1024ull * 1024 * 2;
constexpr size_t WS_H = WS_WSM + (size_t)NSM * KSM * 2;
constexpr size_t WS_PROJ = WS_H + (size_t)T * D * 2;
constexpr size_t WS_RW = WS_PROJ + (size_t)T * NPROJ * 2;
constexpr size_t WS_LOWA = WS_RW + 4ull * T * DMIX * 2;
constexpr size_t WS_SMALL = WS_LOWA + (size_t)T * KSM * 2;
constexpr size_t WS_OUT = WS_SMALL + (size_t)T * NSM * 2;
constexpr size_t WS_BAR = WS_OUT + 6ull * T * DMIX * 2;
constexpr size_t WS_END = WS_BAR + XCD_BAR_WORDS * 4;
constexpr size_t WS_XBC = WS_WGU;
constexpr size_t WS_DT = WS_XBC + (size_t)T * 768 * 2;
static_assert(WS_DT + (size_t)T * 16 * 4 <= WS_WIN, "xbc alias");
constexpr size_t OUT_SSD = 8388608, OUT_GLA = OUT_SSD + 2097152, OUT_RWK = OUT_GLA + 2097152;

struct Args { const float* in[39]; float* out; unsigned char* ws; int ph_lo, ph_hi; };

struct Ctx {
    const float* const* in; float* out; unsigned char* ws; LAS unsigned char* lds; int tid, lane, wid, G, bid, gw, NW;
    __device__ __forceinline__ float* X_() const { return out; }
    __device__ __forceinline__ float* ADA_() const { return (float*)(ws + WS_ADA); }
    __device__ __forceinline__ bf16_t* WGU_() const { return (bf16_t*)(ws + WS_WGU); }
    __device__ __forceinline__ bf16_t* WD_() const { return (bf16_t*)(ws + WS_WD); }
    __device__ __forceinline__ bf16_t* WIN_() const { return (bf16_t*)(ws + WS_WIN); }
    __device__ __forceinline__ bf16_t* WBO_() const { return (bf16_t*)(ws + WS_WBO); }
    __device__ __forceinline__ bf16_t* WOUT_() const { return (bf16_t*)(ws + WS_WOUT); }
    __device__ __forceinline__ bf16_t* WSM_() const { return (bf16_t*)(ws + WS_WSM); }
    __device__ __forceinline__ bf16_t* H_() const { return (bf16_t*)(ws + WS_H); }
    __device__ __forceinline__ bf16_t* PROJ_() const { return (bf16_t*)(ws + WS_PROJ); }
    __device__ __forceinline__ bf16_t* RWR_() const { return (bf16_t*)(ws + WS_RW); }
    __device__ __forceinline__ bf16_t* RWK_() const { return (bf16_t*)(ws + WS_RW) + (size_t)T * DMIX; }
    __device__ __forceinline__ bf16_t* RWV_() const { return (bf16_t*)(ws + WS_RW) + (size_t)2 * T * DMIX; }
    __device__ __forceinline__ bf16_t* RWKK_() const { return (bf16_t*)(ws + WS_RW) + (size_t)3 * T * DMIX; }
    __device__ __forceinline__ bf16_t* LOWA_() const { return (bf16_t*)(ws + WS_LOWA); }
    __device__ __forceinline__ bf16_t* SMALL_() const { return (bf16_t*)(ws + WS_SMALL); }
    __device__ __forceinline__ bf16_t* OUTS_() const { return (bf16_t*)(ws + WS_OUT); }
    __device__ __forceinline__ bf16_t* XBC_() const { return (bf16_t*)(ws + WS_XBC); }
    __device__ __forceinline__ float* DT_() const { return (float*)(ws + WS_DT); }
};

__device__ __forceinline__ float bf2f(bf16_t v) { return __uint_as_float((unsigned)v << 16); }
__device__ __forceinline__ float bflo(unsigned v) { return __uint_as_float(v << 16); }
__device__ __forceinline__ float bfhi(unsigned v) { return __uint_as_float(v & 0xffff0000u); }
__device__ __forceinline__ bf16_t f2bf(float f) { return (bf16_t)(cvt_pk_bf16(f, 0.f) & 0xffffu); }
__device__ __forceinline__ float sigmoidf_(float x) { return __builtin_amdgcn_rcpf(1.0f + __expf(-x)); }
__device__ __forceinline__ float siluf_(float x) { return x * __builtin_amdgcn_rcpf(1.0f + __expf(-x)); }
__device__ __forceinline__ float softplusf_(float x) { return fmaxf(x, 0.f) + __logf(1.0f + __expf(-fabsf(x))); }
__device__ __forceinline__ void unpack8(const u32x4 w, float* f) { f[0] = bflo(w.x); f[1] = bfhi(w.x); f[2] = bflo(w.y); f[3] = bfhi(w.y); f[4] = bflo(w.z); f[5] = bfhi(w.z); f[6] = bflo(w.w); f[7] = bfhi(w.w); }
__device__ __forceinline__ u32x4 pack8(const float* f) { u32x4 w; w.x = cvt_pk_bf16(f[0], f[1]); w.y = cvt_pk_bf16(f[2], f[3]); w.z = cvt_pk_bf16(f[4], f[5]); w.w = cvt_pk_bf16(f[6], f[7]); return w; }
__device__ __forceinline__ float shx(float x, int lane, int m) { return __int_as_float(__builtin_amdgcn_ds_bpermute((lane ^ m) << 2, __float_as_int(x))); }
__device__ __forceinline__ float wave_sum(float x, int lane) { x += shx(x, lane, 32); x += shx(x, lane, 16); x += shx(x, lane, 8); x += shx(x, lane, 4); x += shx(x, lane, 2); x += shx(x, lane, 1); return x; }
__device__ __forceinline__ float red8(float x, int lane) { x += shx(x, lane, 1); x += shx(x, lane, 2); x += shx(x, lane, 4); return x; }
template <int CTRL> __device__ __forceinline__ float dppf(float x) { return __int_as_float(__builtin_amdgcn_update_dpp(0, __float_as_int(x), CTRL, 0xF, 0xF, true)); }
__device__ __forceinline__ float dred8(float x) { x += dppf<0xB1>(x); x += dppf<0x4E>(x); x += dppf<0x141>(x); return x; }
__device__ __forceinline__ int cond_of_row(int r) { return r < 4096 ? 0 : 1 + ((r - 4096) >> 10); }

template <class F>
__device__ __forceinline__ int conv_tiles(const Ctx& c, F colptr, int ld, bf16_t* dst, int K, int N, int base) {
    LAS float* tile = (LAS float*)c.lds;
    const int nkt = K / 64, ntl = (N / 256) * nkt;
    int first = (c.bid - (base % c.G) + c.G) % c.G;
    for (int tl = first; tl < ntl; tl += c.G) {
        const int n0 = (tl / nkt) * 256, k0 = (tl % nkt) * 64;
        const int n4 = c.lane * 4;
        const float* p = colptr(n0 + n4);
        f32x4 v[8];
#pragma unroll
        for (int j = 0; j < 8; ++j) { const int k = c.wid + 8 * j; v[j] = p ? *(const f32x4*)(p + (size_t)(k0 + k) * ld) : (f32x4){0.f, 0.f, 0.f, 0.f}; }
#pragma unroll
        for (int j = 0; j < 8; ++j) { const int k = c.wid + 8 * j; LAS float* t = tile + k * 257 + n4; t[0] = v[j][0]; t[1] = v[j][1]; t[2] = v[j][2]; t[3] = v[j][3]; }
        __syncthreads();
        const int kc = c.tid & 7, nn0 = c.tid >> 3;
#pragma unroll
        for (int j = 0; j < 4; ++j) { const int n = nn0 + 64 * j; float f[8];
#pragma unroll
            for (int i = 0; i < 8; ++i) f[i] = tile[(kc * 8 + i) * 257 + n];
            *(u32x4*)(dst + (size_t)(n0 + n) * K + k0 + kc * 8) = pack8(f); }
        __syncthreads();
    }
    return base + ntl;
}
struct ColGU { const float* g; const float* u; __device__ const float* operator()(int n) const { const int pn = n >> 8, bj = (n >> 7) & 1, i = n & 127; return g + (u - g) * (long)bj + pn * 128 + i; } };
struct ColPlain { const float* w; int nvalid; __device__ const float* operator()(int n) const { return n < nvalid ? w + n : nullptr; } };

__device__ __forceinline__ int convert_ffn(const Ctx& c, int l, int f, int base) {
    const size_t o = ((size_t)l * 2 + f) * 1024 * 2816;
    base = conv_tiles(c, ColGU{c.in[10] + o, c.in[11] + o}, DFF, c.WGU_(), 1024, 5632, base);
    return conv_tiles(c, ColPlain{c.in[12] + o, 1024}, 1024, c.WD_(), DFF, 1024, base);
}
__device__ __forceinline__ void convert_mixer(const Ctx& c, int l, int base) {
    base = conv_tiles(c, ColPlain{c.in[13] + (size_t)l * 1024 * NIN, NIN}, NIN, c.WIN_(), 1024, NPROJ, base);
    base = conv_tiles(c, ColPlain{c.in[20] + (size_t)l * 512 * 1024, 1024}, 1024, c.WBO_(), 512, 1024, base);
    base = conv_tiles(c, ColPlain{c.in[24] + (size_t)l * 512 * 1024, 1024}, 1024, c.WBO_() + 1024 * 512, 512, 1024, base);
    base = conv_tiles(c, ColPlain{c.in[36] + (size_t)l * 512 * 1024, 1024}, 1024, c.WBO_() + 2 * 1024 * 512, 512, 1024, base);
    base = conv_tiles(c, ColPlain{c.in[37] + (size_t)l * 1024 * 1024, 1024}, 1024, c.WOUT_(), 1024, 1024, base);
    const float* w2 = c.in[27] + (size_t)l * 2 * 64 * 512; const float* a2 = c.in[29] + (size_t)l * 64 * 512; const float* g2 = c.in[30] + (size_t)l * 128 * 512; const float* gk = c.in[21] + (size_t)l * 2 * 16 * 256;
    for (int i = c.bid * NT + c.tid; i < NSM * KSM; i += c.G * NT) {
        const int n = i / KSM, k = i % KSM; float v = 0.f;
        if (n < 512) { if (k < 64) v = w2[k * 512 + n]; }
        else if (n < 1024) { if (k >= 64 && k < 128) v = w2[64 * 512 + (k - 64) * 512 + (n - 512)]; }
        else if (n < 1536) { if (k >= 128 && k < 192) v = a2[(k - 128) * 512 + (n - 1024)]; }
        else if (n < 2048) { if (k >= 192 && k < 320) v = g2[(k - 192) * 512 + (n - 1536)]; }
        else if (n < 2304) { if (k >= 320 && k < 336) v = gk[(k - 320) * 256 + (n - 2048)]; }
        else { if (k >= 336 && k < 352) v = gk[16 * 256 + (k - 336) * 256 + (n - 2304)]; }
        c.WSM_()[i] = f2bf(v);
    }
}

__device__ void phase_init(const Ctx& c) {
    const float* xp = c.in[0]; const float* xs = c.in[1];
    for (int i = c.bid * NT + c.tid; i < T * D / 4; i += c.G * NT) {
        const int r = i >> 8, c4 = (i & 255) * 4;
        f32x4 v;
        if (r < 4096) v = *(const f32x4*)(xp + (size_t)r * D + c4);
        else {
            v = *(const f32x4*)(xs + (size_t)(r - 4096) * D + c4);
            const int t = (r - 4096) & 1023, gr = t >> 6, gc = t & 63;
#pragma unroll
            for (int j = 0; j < 4; ++j) { const int cc = c4 + j, seg = cc >> 8, ii = cc & 255;
                const float omega = __expf(-(float)ii * (9.210340371976184f / 256.0f)); const float ang = (float)(seg < 2 ? gr : gc) * omega;
                v[j] += (seg & 1) ? __cosf(ang) : __sinf(ang); }
        }
        *(f32x4*)(c.X_() + (size_t)r * D + c4) = v;
    }
    LAS float* sc = (LAS float*)c.lds;
    LAS float* red = sc + 5 * 1024;
    for (int i = c.tid; i < 5 * 1024; i += NT) { const int cd = i >> 10, k = i & 1023; const float x = cd == 0 ? c.in[6][k] : c.in[5][(cd - 1) * 1024 + k]; sc[i] = siluf_(x); }
    __syncthreads();
    for (int it = c.bid; it < 288; it += c.G) {
        const int l = it / 144, n0 = (it % 144) * 64, col = c.tid & 63, kg = c.tid >> 6;
        const float* w = c.in[8] + (size_t)l * 1024 * 9216 + n0 + col;
        float a0 = 0.f, a1 = 0.f, a2 = 0.f, a3 = 0.f, a4 = 0.f;
#pragma unroll 16
        for (int k = kg * 128; k < kg * 128 + 128; ++k) { const float wv = w[(size_t)k * 9216]; a0 += sc[k] * wv; a1 += sc[1024 + k] * wv; a2 += sc[2048 + k] * wv; a3 += sc[3072 + k] * wv; a4 += sc[4096 + k] * wv; }
        red[(kg * 5 + 0) * 64 + col] = a0; red[(kg * 5 + 1) * 64 + col] = a1; red[(kg * 5 + 2) * 64 + col] = a2; red[(kg * 5 + 3) * 64 + col] = a3; red[(kg * 5 + 4) * 64 + col] = a4;
        __syncthreads();
        if (c.tid < 320) { const int cd = c.tid >> 6, cl = c.tid & 63; float s = c.in[9][l * 9216 + n0 + cl];
#pragma unroll
            for (int g = 0; g < 8; ++g) s += red[(g * 5 + cd) * 64 + cl];
            c.ADA_()[(l * 5 + cd) * 9216 + n0 + cl] = s; }
        __syncthreads();
    }
}

__device__ void phase_norm(const Ctx& c, int l, int which, bool addP) {
    const bf16_t* P = c.OUTS_();
    const float* g = c.in[7] + (l * 3 + which) * 1024;
    for (int r = c.gw; r < T; r += c.NW) {
        float* xr = c.X_() + (size_t)r * D; f32x4 v[4]; float ss = 0.f;
#pragma unroll
        for (int j = 0; j < 4; ++j) { v[j] = *(const f32x4*)(xr + (c.lane + 64 * j) * 4); if (addP) { const u32x2 pw = *(const u32x2*)(P + (size_t)r * D + (c.lane + 64 * j) * 4), pv = *(const u32x2*)(P + (size_t)T * D + (size_t)r * D + (c.lane + 64 * j) * 4); v[j] = v[j] + ((f32x4){bflo(pw.x), bfhi(pw.x), bflo(pw.y), bfhi(pw.y)} + (f32x4){bflo(pv.x), bfhi(pv.x), bflo(pv.y), bfhi(pv.y)}); *(f32x4*)(xr + (c.lane + 64 * j) * 4) = v[j]; } ss += v[j][0] * v[j][0] + v[j][1] * v[j][1] + v[j][2] * v[j][2] + v[j][3] * v[j][3]; }
        ss = wave_sum(ss, c.lane); const float rs = rsqrtf(ss * (1.0f / 1024.0f) + 1e-6f);
        const float* sh = c.ADA_() + (l * 5 + cond_of_row(r)) * 9216 + (which * 3) * 1024; const float* scl = sh + 1024;
#pragma unroll
        for (int j = 0; j < 4; ++j) { const int cc = (c.lane + 64 * j) * 4; const f32x4 gg = *(const f32x4*)(g + cc), s1 = *(const f32x4*)(scl + cc), s0 = *(const f32x4*)(sh + cc);
            const f32x4 o = v[j] * rs * gg * (s1 + 1.0f) + s0; u32x2 w; w.x = cvt_pk_bf16(o[0], o[1]); w.y = cvt_pk_bf16(o[2], o[3]); *(u32x2*)(c.H_() + (size_t)r * D + cc) = w; }
    }
}
__device__ void phase_final_norm(const Ctx& c) {
    const float* g = c.in[38]; const bf16_t* P = c.OUTS_();
    for (int r = c.gw; r < T; r += c.NW) {
        float* xr = c.X_() + (size_t)r * D; f32x4 v[4]; float ss = 0.f;
#pragma unroll
        for (int j = 0; j < 4; ++j) { const u32x2 pw = *(const u32x2*)(P + (size_t)r * D + (c.lane + 64 * j) * 4), pv = *(const u32x2*)(P + (size_t)T * D + (size_t)r * D + (c.lane + 64 * j) * 4); v[j] = *(const f32x4*)(xr + (c.lane + 64 * j) * 4) + ((f32x4){bflo(pw.x), bfhi(pw.x), bflo(pw.y), bfhi(pw.y)} + (f32x4){bflo(pv.x), bfhi(pv.x), bflo(pv.y), bfhi(pv.y)}); ss += v[j][0] * v[j][0] + v[j][1] * v[j][1] + v[j][2] * v[j][2] + v[j][3] * v[j][3]; }
        ss = wave_sum(ss, c.lane); const float rs = rsqrtf(ss * (1.0f / 1024.0f) + 1e-6f);
#pragma unroll
        for (int j = 0; j < 4; ++j) { const int cc = (c.lane + 64 * j) * 4; *(f32x4*)(xr + cc) = v[j] * rs * *(const f32x4*)(g + cc); }
    }
}

struct EpiGU { static constexpr bool PERM = true, AFTER_DRAIN = false; bf16_t* O;
    __device__ __forceinline__ void operator()(const f32x4 (&acc)[2][2][4][2], const pg8::Unit& u, int wr, int wc, int fr, int fq) const {
        const int row0 = u.pm * 256 + wr * 64 + fr, col0 = u.pn * 128 + wc * 32 + 8 * fq;
#pragma unroll
        for (int ai = 0; ai < 2; ++ai)
#pragma unroll
            for (int m = 0; m < 4; ++m) { float o[8];
#pragma unroll
                for (int n = 0; n < 2; ++n)
#pragma unroll
                    for (int j = 0; j < 4; ++j) o[n * 4 + j] = siluf_(acc[ai][0][m][n][j]) * acc[ai][1][m][n][j];
                *(u32x4*)(O + (size_t)(row0 + ai * 128 + m * 16) * DFF + col0) = pack8(o); }
    } };
struct EpiResid { static constexpr bool PERM = false, AFTER_DRAIN = false; bf16_t* P; const float* gate; float s;
    __device__ __forceinline__ void operator()(const f32x4 (&acc)[2][2][4][2], const pg8::Unit& u, int wr, int wc, int fr, int fq) const {
        const int pn = u.pn & 3, kh = u.pn >> 2;
        const int row0 = u.pm * 256 + wr * 64 + fr, col0 = pn * 256 + wc * 32 + 4 * fq; const int cd = cond_of_row(u.pm * 256);
        f32x4 gv[2][2];
#pragma unroll
        for (int bj = 0; bj < 2; ++bj)
#pragma unroll
            for (int n = 0; n < 2; ++n) gv[bj][n] = *(const f32x4*)(gate + cd * 9216 + col0 + bj * 128 + n * 16) * s;
        bf16_t* base = P + (size_t)kh * T * D;
#pragma unroll
        for (int ai = 0; ai < 2; ++ai)
#pragma unroll
            for (int m = 0; m < 4; ++m) { const size_t off = (size_t)(row0 + ai * 128 + m * 16) * D + col0;
#pragma unroll
                for (int bj = 0; bj < 2; ++bj)
#pragma unroll
                    for (int n = 0; n < 2; ++n) { const f32x4 v = acc[ai][bj][m][n] * gv[bj][n]; u32x2 w; w.x = cvt_pk_bf16(v[0], v[1]); w.y = cvt_pk_bf16(v[2], v[3]); *(u32x2*)(base + off + bj * 128 + n * 16) = w; } }
    } };
struct EpiProj { static constexpr bool PERM = true, AFTER_DRAIN = false; bf16_t* O; int ldc;
    __device__ __forceinline__ void operator()(const f32x4 (&acc)[2][2][4][2], const pg8::Unit& u, int wr, int wc, int fr, int fq) const {
        const int row0 = u.pm * 256 + wr * 64 + fr, col0 = u.pn * 256 + wc * 32 + 8 * fq;
#pragma unroll
        for (int ai = 0; ai < 2; ++ai)
#pragma unroll
            for (int m = 0; m < 4; ++m) { bf16_t* rowp = O + (size_t)(row0 + ai * 128 + m * 16) * ldc + col0;
#pragma unroll
                for (int bj = 0; bj < 2; ++bj) { const f32x4 v0 = acc[ai][bj][m][0], v1 = acc[ai][bj][m][1]; u32x4 w; w.x = cvt_pk_bf16(v0[0], v0[1]); w.y = cvt_pk_bf16(v0[2], v0[3]); w.z = cvt_pk_bf16(v1[0], v1[1]); w.w = cvt_pk_bf16(v1[2], v1[3]);
                    *(u32x4*)(rowp + bj * 128) = w; } }
    } };
struct EpiSmall { static constexpr bool PERM = true, AFTER_DRAIN = false; bf16_t* O; const float* w0; const float* a0; bf16_t* rwk; const bf16_t* rwkk; const float* ka;
    __device__ __forceinline__ void operator()(const f32x4 (&acc)[2][2][4][2], const pg8::Unit& u, int wr, int wc, int fr, int fq) const {
        const int row0 = u.pm * 256 + wr * 64 + fr, col0 = u.pn * 256 + wc * 32 + 8 * fq;
        const int kind = u.pn < 4 ? 0 : (u.pn < 6 ? 2 : 3);
        const float* bias = kind == 0 ? w0 : (kind == 2 ? a0 - 1024 : w0 - 1536);
        const float bsc = kind == 3 ? 0.f : 1.f;
#pragma unroll
        for (int bj = 0; bj < 2; ++bj) { const int cc = col0 + bj * 128; const f32x4 b0 = *(const f32x4*)(bias + cc) * bsc, b1 = *(const f32x4*)(bias + cc + 4) * bsc;
#pragma unroll
            for (int ai = 0; ai < 2; ++ai)
#pragma unroll
                for (int m = 0; m < 4; ++m) { const size_t row = row0 + ai * 128 + m * 16; const f32x4 x0 = acc[ai][bj][m][0] + b0, x1 = acc[ai][bj][m][1] + b1; float o[8];
#pragma unroll
                    for (int j = 0; j < 8; ++j) { const float x = j < 4 ? x0[j & 3] : x1[j & 3];
                        const float sg = __builtin_amdgcn_rcpf(1.0f + __expf(-x));
                        const float y01 = 1.0f - __expf(-sg * 0.60653066f);
                        o[j] = kind == 0 ? y01 : (kind == 2 ? sg : x); }
                    if (kind == 2) { float kv[8], kkv[8]; bf16_t* kp = rwk + row * 512 + (cc - 1024); unpack8(*(const u32x4*)kp, kv); unpack8(*(const u32x4*)(rwkk + row * 512 + (cc - 1024)), kkv);
                        const f32x4 ka0 = *(const f32x4*)(ka + cc - 1024), ka1 = *(const f32x4*)(ka + cc - 1024 + 4);
#pragma unroll
                        for (int j = 0; j < 8; ++j) { const float av = o[j], kaj = j < 4 ? ka0[j & 3] : ka1[j & 3]; kv[j] = kv[j] * (1.0f + (av - 1.0f) * kaj); o[j] = kkv[j] * av; }
                        *(u32x4*)kp = pack8(kv); }
                    *(u32x4*)(O + row * NSM + cc) = pack8(o); }
            asm volatile("" ::: "memory"); }
    } };
struct EpiBranch { static constexpr bool PERM = true, AFTER_DRAIN = false; bf16_t* M; const bf16_t* gates;
    __device__ __forceinline__ void operator()(const f32x4 (&acc)[2][2][4][2], const pg8::Unit& u, int wr, int wc, int fr, int fq) const {
        int upm = u.pm, upn = u.pn; asm volatile("" : "+s"(upm), "+s"(upn));
        const int b = upn >> 2, pn = upn & 3; const float keep = b ? 1.0f : 0.0f;
        const int row0 = upm * 256 + wr * 64 + fr, col0 = pn * 256 + wc * 32 + 8 * fq; const bf16_t* gb = gates + b * 1024;
#pragma unroll
        for (int ai = 0; ai < 2; ++ai)
#pragma unroll
            for (int m = 0; m < 4; ++m) { const int row = row0 + ai * 128 + m * 16;
#pragma unroll
                for (int bj = 0; bj < 2; ++bj) { const int cc = col0 + bj * 128; float gt[8], o[8];
                    unpack8(*(const u32x4*)(gb + (size_t)row * NPROJ + cc), gt);
                    bf16_t* mp = M + (size_t)row * D + cc;
                    unpack8(*(const u32x4*)mp, o);
#pragma unroll
                    for (int j = 0; j < 8; ++j) o[j] = o[j] * keep + sigmoidf_(gt[j]) * acc[ai][bj][m][j >> 2][j & 3];
                    *(u32x4*)mp = pack8(o); }
                asm volatile("" ::: "memory"); }
    } };

#ifndef GP_ALIGN
#define GP_ALIGN true
#endif
#ifndef GP_SP2
#define GP_SP2 true
#endif
template <class Epi>
__device__ __forceinline__ void run_gemm(const Ctx& c, const bf16_t* A, const bf16_t* Bt, int N, int K, const Epi& E, int ksplit = 1) {
    int Kl = K / ksplit; asm volatile("" : "+s"(Kl));
    pg8::Gemm g{A, Bt, T, N * ksplit, Kl, K, N / 256, (size_t)Kl * 2, (size_t)Kl * 2}; pg8::StaticOrder S; S.init(T, N * ksplit, c.G, c.bid);
    pg8::gemm_phase<Epi, pg8::StaticOrder, GP_ALIGN, GP_SP2>(c.lds, g, S, E);
}

struct BranchOrder { int c;
    __device__ bool next(int i, pg8::Unit& u) const { if (c >= 128 || i >= 3) return false; u.pm = c >> 2; u.pn = (c & 3) + 4 * i; return true; }
    __device__ __forceinline__ void a_ready(const pg8::Unit&) const {}
    __device__ __forceinline__ void done(const pg8::Unit&) const {}
};
__device__ __forceinline__ void ldf8(const float* p, float* f) { const f32x4 a = *(const f32x4*)p, b = *(const f32x4*)(p + 4); f[0] = a[0]; f[1] = a[1]; f[2] = a[2]; f[3] = a[3]; f[4] = b[0]; f[5] = b[1]; f[6] = b[2]; f[7] = b[3]; }
__device__ void phase_prepass(const Ctx& c, int l) {
    const float* cw = c.in[14] + l * 3 * 768; const float* cb = c.in[15] + l * 768; const float* dtb = c.in[16] + l * 16;
    const float* mu = c.in[25] + l * 1856; const float* rkk = c.in[31] + l * 512; const float* gkw = c.in[21] + l * 2 * 16 * 256; const float* gkb = c.in[22] + l * 512;
    const int lane = c.lane;
    for (int r = c.gw; r < T; r += c.NW) {
        int t, L; if (r < 4096) { t = r & 255; L = 256; } else { t = (r - 4096) & 1023; L = 1024; }
        const bool hp = t > 0, hn = t < L - 1;
        const bf16_t* p0 = c.PROJ_() + (size_t)r * NPROJ; const bf16_t* pm = hp ? p0 - NPROJ : p0; const bf16_t* pn = hn ? p0 + NPROJ : p0;
        const float fp = hp ? 1.f : 0.f, fn = hn ? 1.f : 0.f;
#pragma unroll
        for (int it = 0; it < 2; ++it) { const int g = lane + 64 * it; if (g < 96) { const int cc = g * 8; float x0[8], xm[8], xn[8], w0[8], w1[8], w2[8], bb[8], o[8];
            unpack8(*(const u32x4*)(p0 + 512 + cc), x0); unpack8(*(const u32x4*)(pm + 512 + cc), xm); unpack8(*(const u32x4*)(pn + 512 + cc), xn);
            ldf8(cw + cc, w0); ldf8(cw + 768 + cc, w1); ldf8(cw + 1536 + cc, w2); ldf8(cb + cc, bb);
#pragma unroll
            for (int j = 0; j < 8; ++j) o[j] = siluf_(bb[j] + w0[j] * xm[j] * fp + w1[j] * x0[j] + w2[j] * xn[j] * fn);
            *(u32x4*)(c.XBC_() + (size_t)r * 768 + cc) = pack8(o); } }
        if (lane < 16) c.DT_()[r * 16 + lane] = softplusf_(bf2f(p0[1280 + lane]) + dtb[lane]);
#pragma unroll
        for (int it = 0; it < 4; ++it) { const int g = lane + 64 * it; if (g < 232) { const int cc = g * 8; float x0[8], xm[8], xn[8], m8[8], o[8];
            unpack8(*(const u32x4*)(p0 + C_RW + cc), x0); unpack8(*(const u32x4*)(pm + C_RW + cc), xm); unpack8(*(const u32x4*)(pn + C_RW + cc), xn); ldf8(mu + cc, m8);
#pragma unroll
            for (int j = 0; j < 8; ++j) o[j] = x0[j] + (0.5f * (xm[j] * fp + xn[j] * fn) - x0[j]) * m8[j];
            if (it == 0) *(u32x4*)(c.RWR_() + (size_t)r * 512 + cc) = pack8(o);
            else if (it == 1) { const int ck = cc - 512; *(u32x4*)(c.RWK_() + (size_t)r * 512 + ck) = pack8(o); float kw[8], kq[8]; ldf8(rkk + ck, kw); float ss = 0.f;
#pragma unroll
                for (int j = 0; j < 8; ++j) { kq[j] = o[j] * kw[j]; ss += kq[j] * kq[j]; }
                ss = dred8(ss); const float inv = 1.0f / fmaxf(sqrtf(ss), 1e-12f);
#pragma unroll
                for (int j = 0; j < 8; ++j) kq[j] *= inv;
                *(u32x4*)(c.RWKK_() + (size_t)r * 512 + ck) = pack8(kq); }
            else if (it == 2) *(u32x4*)(c.RWV_() + (size_t)r * 512 + (cc - 1024)) = pack8(o);
            else { const int cl = cc - 1536;
#pragma unroll
                for (int j = 0; j < 8; ++j) { const float e2 = __expf(2.0f * o[j]); const float th = 1.0f - 2.0f / (1.0f + e2); const float sg = sigmoidf_(o[j]); o[j] = cl < 128 ? th : (cl < 192 ? o[j] : sg); }
                *(u32x4*)(c.LOWA_() + (size_t)r * KSM + cl) = pack8(o); } } }
        if (lane < 8) { unsigned z = 0u; asm volatile("" : "+v"(z)); *(u32x4*)(c.LOWA_() + (size_t)r * KSM + 320 + lane * 8) = (u32x4){z, z, z, z}; }
        {
            const int d = lane >> 5, cg = lane & 31; const float* gwp = gkw + d * 16 * 256 + cg * 8; float lr[16], acc[8];
            unpack8(*(const u32x4*)(p0 + C_GLA + 1536 + d * 16), lr); unpack8(*(const u32x4*)(p0 + C_GLA + 1536 + d * 16 + 8), lr + 8); ldf8(gkb + d * 256 + cg * 8, acc);
#pragma unroll
            for (int i = 0; i < 16; ++i) { float w[8]; ldf8(gwp + i * 256, w);
#pragma unroll
                for (int j = 0; j < 8; ++j) acc[j] += lr[i] * w[j]; }
#pragma unroll
            for (int j = 0; j < 8; ++j) acc[j] = 1.0f - __expf(softplusf_(-acc[j]) * (-1.0f / 16.0f));
            *(u32x4*)(c.SMALL_() + (size_t)r * NSM + 2048 + d * 256 + cg * 8) = pack8(acc); }
    }
}

struct SeqInfo { int L, row0, b, ctx; };
__device__ __forceinline__ SeqInfo seq_info(int s) { SeqInfo q; if (s < 16) { q.L = 256; q.row0 = s * 256; q.b = s; q.ctx = 1; } else { q.L = 1024; q.row0 = 4096 + (s - 16) * 1024; q.b = s - 16; q.ctx = 0; } return q; }

#ifndef PF_SSD
#define PF_SSD 8
#endif
#ifndef PF_GLA
#define PF_GLA 4
#endif
#ifndef PF_RW
#define PF_RW 2
#endif
__device__ __forceinline__ u32x4 ldu16(const bf16_t* ub, unsigned lo) { return *(const u32x4*)((const char*)ub + lo); }
__device__ __forceinline__ bf16_t ldu2(const bf16_t* ub, unsigned lo) { return *(const bf16_t*)((const char*)ub + lo); }
__device__ __forceinline__ float sel8(const float (&y)[8], int k) { float v = y[0]; v = k == 1 ? y[1] : v; v = k == 2 ? y[2] : v; v = k == 3 ? y[3] : v; v = k == 4 ? y[4] : v; v = k == 5 ? y[5] : v; v = k == 6 ? y[6] : v; v = k == 7 ? y[7] : v; return v; }

constexpr int REC = 336;
__device__ __forceinline__ void st8(LAS float* p, const u32x4 w) { float f[8]; unpack8(w, f); *(LAS f32x4*)p = (f32x4){f[0], f[1], f[2], f[3]}; *(LAS f32x4*)(p + 4) = (f32x4){f[4], f[5], f[6], f[7]}; }
__device__ __forceinline__ void ld8(const LAS float* p, float* f) { const f32x4 a = *(const LAS f32x4*)p, b = *(const LAS f32x4*)(p + 4); f[0] = a[0]; f[1] = a[1]; f[2] = a[2]; f[3] = a[3]; f[4] = b[0]; f[5] = b[1]; f[6] = b[2]; f[7] = b[3]; }

__device__ void scan_ssd(const Ctx& c, int l, int s, int dir, int hp) {
    const SeqInfo q = seq_info(s); const int h = hp * 2 + (c.wid >> 2), w4 = c.wid & 3, lane = c.lane, r = lane >> 3, p0 = w4 * 16 + r, np = lane & 7, g = h >> 2;
    float S[2][8];
#pragma unroll
    for (int e = 0; e < 2; ++e) {
        if (!q.ctx) { const float* st = c.in[2] + ((((size_t)q.b * 2 + l) * 2 + dir) * 8 + h) * 4096 + (p0 + 8 * e) * 64 + np * 8; const f32x4 a = *(const f32x4*)st, b = *(const f32x4*)(st + 4);
            S[e][0] = a[0]; S[e][1] = a[1]; S[e][2] = a[2]; S[e][3] = a[3]; S[e][4] = b[0]; S[e][5] = b[1]; S[e][6] = b[2]; S[e][7] = b[3]; }
        else {
#pragma unroll
            for (int j = 0; j < 8; ++j) S[e][j] = 0.f; } }
    const float adh = -__expf(c.in[17][l * 16 + dir * 8 + h]) * 1.44269504f;
    const long sgn = dir ? -1 : 1; const size_t rbase = (size_t)q.row0 + (dir ? q.L - 1 : 0);
    LAS float* lb = (LAS float*)c.lds + c.wid * (8 * REC); LAS float* wr = lb + r * REC + np * 8; const LAS float* rd = lb + np * 8;
    const char* gX = (const char*)(c.XBC_() + (rbase + sgn * r) * 768); const float* gD = c.DT_() + (rbase + sgn * r) * 16 + dir * 8 + h; const long cX = sgn * 8 * 768 * 2, cD = sgn * 8 * 16;
    const unsigned loB = (512 + g * 64 + np * 8) * 2, loX = (h * 64 + w4 * 16 + np) * 2;
    bf16_t* O = c.OUTS_() + (size_t)(0 * 2 + dir) * T * DMIX + (rbase + sgn * np) * DMIX + h * 64 + p0;
    u32x4 nB, nC; bf16_t nx0, nx1; float ndt;
#define SSD_LOAD() { nB = *(const u32x4*)(gX + loB); nC = *(const u32x4*)(gX + loB + 256); nx0 = *(const bf16_t*)(gX + loX); nx1 = *(const bf16_t*)(gX + loX + 16); ndt = *gD; gX += cX; gD += cD; }
#define SSD_STORE() { st8(wr, nB); st8(wr + 64, nC); lb[r * REC + 128 + np] = bf2f(nx0); lb[r * REC + 136 + np] = bf2f(nx1); lb[r * REC + 144] = ndt; }
    SSD_LOAD(); SSD_STORE();
    for (int i0 = 0; i0 < q.L; i0 += 8) {
        SSD_LOAD();
        float out0 = 0.f, out1 = 0.f;
#pragma unroll
        for (int j = 0; j < 8; ++j) {
            float B[8], C[8]; ld8(rd + j * REC, B); ld8(rd + j * REC + 64, C); const float x0 = lb[j * REC + 128 + r], x1 = lb[j * REC + 136 + r], dtv = lb[j * REC + 144];
            const float da = __builtin_amdgcn_exp2f(dtv * adh), xd0 = x0 * dtv, xd1 = x1 * dtv; float ya = 0.f, yb = 0.f, za = 0.f, zb = 0.f;
#pragma unroll
            for (int k = 0; k < 8; k += 2) {
                S[0][k] = da * S[0][k] + xd0 * B[k]; S[0][k + 1] = da * S[0][k + 1] + xd0 * B[k + 1]; ya += S[0][k] * C[k]; yb += S[0][k + 1] * C[k + 1];
                S[1][k] = da * S[1][k] + xd1 * B[k]; S[1][k + 1] = da * S[1][k + 1] + xd1 * B[k + 1]; za += S[1][k] * C[k]; zb += S[1][k + 1] * C[k + 1]; }
            { const float yv = dred8(ya + yb), zv = dred8(za + zb); out0 = (np == j) ? yv : out0; out1 = (np == j) ? zv : out1; }
        }
        O[0] = f2bf(out0); O[8] = f2bf(out1); O += sgn * 8 * DMIX;
        SSD_STORE();
    }
    if (q.ctx) {
#pragma unroll
        for (int e = 0; e < 2; ++e) { int ln = lane; asm volatile("" : "+v"(ln)); float* o = c.out + OUT_SSD + ((((size_t)q.b * 2 + l) * 2 + dir) * 8 + h) * 4096 + (w4 * 16 + (ln >> 3) + 8 * e) * 64 + (ln & 7) * 8; *(f32x4*)o = (f32x4){S[e][0], S[e][1], S[e][2], S[e][3]}; *(f32x4*)(o + 4) = (f32x4){S[e][4], S[e][5], S[e][6], S[e][7]}; } }
}

__device__ void scan_gla(const Ctx& c, int l, int s, int dir, int h) {
    const SeqInfo q = seq_info(s); const int lane = c.lane, r = lane >> 3, v0 = c.wid * 16 + r, kp = lane & 7;
    float S[2][8];
#pragma unroll
    for (int e = 0; e < 2; ++e) {
        if (!q.ctx) { const float* st = c.in[3] + (((((size_t)q.b * 2 + l) * 2 + dir) * 4 + h) * 64 + kp * 8) * 128 + v0 + 8 * e;
#pragma unroll
            for (int j = 0; j < 8; ++j) S[e][j] = st[j * 128]; }
        else {
#pragma unroll
            for (int j = 0; j < 8; ++j) S[e][j] = 0.f; } }
    const long sgn = dir ? -1 : 1; const size_t rbase = (size_t)q.row0 + (dir ? q.L - 1 : 0);
    LAS float* lb = (LAS float*)c.lds + c.wid * (8 * REC); LAS float* wr = lb + r * REC + kp * 8; const LAS float* rd = lb + kp * 8;
    const char* gP = (const char*)(c.PROJ_() + (rbase + sgn * r) * NPROJ); const char* gS = (const char*)(c.SMALL_() + (rbase + sgn * r) * NSM); const long cP = sgn * 8 * NPROJ * 2, cS = sgn * 8 * NSM * 2;
    const unsigned loQ = (C_GLA + h * 64 + kp * 8) * 2, loV = (C_GLA + 512 + h * 128 + c.wid * 16 + kp) * 2, loG = (2048 + dir * 256 + h * 64 + kp * 8) * 2;
    bf16_t* O = c.OUTS_() + (size_t)(1 * 2 + dir) * T * DMIX + (rbase + sgn * kp) * DMIX + h * 128 + v0;
    u32x4 nQ, nK, nG; bf16_t nv0, nv1;
#define GLA_LOAD() { nQ = *(const u32x4*)(gP + loQ); nK = *(const u32x4*)(gP + loQ + 512); nG = *(const u32x4*)(gS + loG); nv0 = *(const bf16_t*)(gP + loV); nv1 = *(const bf16_t*)(gP + loV + 16); gP += cP; gS += cS; }
#define GLA_STORE() { st8(wr, nQ); st8(wr + 64, nK); st8(wr + 128, nG); lb[r * REC + 192 + kp] = bf2f(nv0); lb[r * REC + 200 + kp] = bf2f(nv1); }
    GLA_LOAD(); GLA_STORE();
    for (int i0 = 0; i0 < q.L; i0 += 8) {
        GLA_LOAD();
        float out0 = 0.f, out1 = 0.f;
#pragma unroll 4
        for (int j = 0; j < 8; ++j) {
            float Q[8], K[8], G[8]; ld8(rd + j * REC, Q); ld8(rd + j * REC + 64, K); ld8(rd + j * REC + 128, G); const float va = lb[j * REC + 192 + r], vb = lb[j * REC + 200 + r];
            float oa = 0.f, ob = 0.f, pa = 0.f, pb = 0.f;
#pragma unroll
            for (int k = 0; k < 8; k += 2) {
                S[0][k] = (S[0][k] - S[0][k] * G[k]) + K[k] * va; S[0][k + 1] = (S[0][k + 1] - S[0][k + 1] * G[k + 1]) + K[k + 1] * va; oa += Q[k] * S[0][k]; ob += Q[k + 1] * S[0][k + 1];
                S[1][k] = (S[1][k] - S[1][k] * G[k]) + K[k] * vb; S[1][k + 1] = (S[1][k + 1] - S[1][k + 1] * G[k + 1]) + K[k + 1] * vb; pa += Q[k] * S[1][k]; pb += Q[k + 1] * S[1][k + 1]; }
            { const float yv = dred8(oa + ob), zv = dred8(pa + pb); out0 = (kp == j) ? yv : out0; out1 = (kp == j) ? zv : out1; }
        }
        O[0] = f2bf(out0 * 0.125f); O[8] = f2bf(out1 * 0.125f); O += sgn * 8 * DMIX;
        GLA_STORE();
    }
    if (q.ctx) {
#pragma unroll
        for (int e = 0; e < 2; ++e) { int ln = lane; asm volatile("" : "+v"(ln)); float* o = c.out + OUT_GLA + (((((size_t)q.b * 2 + l) * 2 + dir) * 4 + h) * 64 + (ln & 7) * 8) * 128 + c.wid * 16 + (ln >> 3) + 8 * e;
#pragma unroll
            for (int j = 0; j < 8; ++j) o[j * 128] = S[e][j]; } }
}

__device__ void scan_rwkv(const Ctx& c, int l, int s, int dir, int hs) {
    const SeqInfo q = seq_info(s); const int h = hs >> 3, rg = hs & 7, lane = c.lane, r = lane >> 3, vr = rg * 8 + r, kp = lane & 7;
    float S[8];
    if (!q.ctx) { const float* st = c.in[4] + ((((size_t)q.b * 2 + l) * 2 + dir) * 8 + h) * 4096 + vr * 64 + kp * 8; const f32x4 a = *(const f32x4*)st, b = *(const f32x4*)(st + 4);
        S[0] = a[0]; S[1] = a[1]; S[2] = a[2]; S[3] = a[3]; S[4] = b[0]; S[5] = b[1]; S[6] = b[2]; S[7] = b[3]; }
    else {
#pragma unroll
        for (int j = 0; j < 8; ++j) S[j] = 0.f; }
    const long sgn = dir ? -1 : 1; const size_t rbase = (size_t)q.row0 + (dir ? q.L - 1 : 0);
    constexpr size_t AS2 = (size_t)T * DMIX * 2;
    LAS float* lb = (LAS float*)c.lds + c.wid * (8 * REC); LAS float* wr = lb + r * REC + kp * 8; const LAS float* rd = lb + kp * 8;
    const char* gR = (const char*)(c.RWR_() + (rbase + sgn * r) * 512 + h * 64 + kp * 8); const char* gS = (const char*)(c.SMALL_() + (rbase + sgn * r) * NSM + h * 64 + kp * 8);
    const char* gV = (const char*)(c.RWV_() + (rbase + sgn * r) * 512 + h * 64 + rg * 8 + kp); const long cR = sgn * 8 * 512 * 2, cS = sgn * 8 * NSM * 2;
    const unsigned loW = dir * 1024;
    bf16_t* O = c.OUTS_() + (size_t)(2 * 2 + dir) * T * DMIX + (rbase + sgn * kp) * DMIX + h * 64 + vr;
    u32x4 nR, nK, nKK, nA, nW; bf16_t nv;
#define RW_LOAD() { nR = *(const u32x4*)gR; nK = *(const u32x4*)(gR + AS2); nKK = *(const u32x4*)(gR + 3 * AS2); nA = *(const u32x4*)(gS + 2048); nW = *(const u32x4*)(gS + loW); nv = *(const bf16_t*)gV; gR += cR; gS += cS; gV += cR; }
#define RW_STORE() { st8(wr, nR); st8(wr + 64, nK); st8(wr + 128, nKK); st8(wr + 192, nA); st8(wr + 256, nW); lb[r * REC + 320 + kp] = bf2f(nv); }
    RW_LOAD(); RW_STORE();
    for (int i0 = 0; i0 < q.L; i0 += 8) {
        RW_LOAD();
        float outv = 0.f;
#pragma unroll 4
        for (int j = 0; j < 8; ++j) {
            float R[8], K[8], KK[8], A[8], W[8]; ld8(rd + j * REC, R); ld8(rd + j * REC + 64, K); ld8(rd + j * REC + 128, KK); ld8(rd + j * REC + 192, A); ld8(rd + j * REC + 256, W); const float vv = lb[j * REC + 320 + r];
            float s0 = 0.f, s1 = 0.f;
#pragma unroll
            for (int k = 0; k < 8; k += 2) { s0 += S[k] * KK[k]; s1 += S[k + 1] * KK[k + 1]; }
            const float skk = dred8(s0 + s1); float o0 = 0.f, o1 = 0.f;
#pragma unroll
            for (int k = 0; k < 8; k += 2) {
                S[k] = (S[k] - S[k] * W[k]) - skk * A[k] + vv * K[k]; S[k + 1] = (S[k + 1] - S[k + 1] * W[k + 1]) - skk * A[k + 1] + vv * K[k + 1];
                o0 += S[k] * R[k]; o1 += S[k + 1] * R[k + 1]; }
            { const float yv = dred8(o0 + o1); outv = (kp == j) ? yv : outv; }
        }
        *O = f2bf(outv); O += sgn * 8 * DMIX;
        RW_STORE();
    }
    if (q.ctx) { float* o = c.out + OUT_RWK + ((((size_t)q.b * 2 + l) * 2 + dir) * 8 + h) * 4096 + vr * 64 + kp * 8; *(f32x4*)o = (f32x4){S[0], S[1], S[2], S[3]}; *(f32x4*)(o + 4) = (f32x4){S[4], S[5], S[6], S[7]}; }
}

__device__ __forceinline__ void scan_item(const Ctx& c, int l, int id) {
    if (id < 320) { int n = id, s; if (n < 64) s = 16 + (n >> 4); else { n -= 64; s = n >> 4; }
        const int sub = n & 15; scan_rwkv(c, l, s, sub >> 3, (sub & 7) * 8 + c.wid); }
    else { const bool gla = id < 480; int m = gla ? id - 320 : id - 480, s; if (m < 32) s = 16 + (m >> 3); else { m -= 32; s = m >> 3; }
        const int sub = m & 7; if (gla) scan_gla(c, l, s, sub >> 2, sub & 3); else scan_ssd(c, l, s, sub >> 2, sub & 3); }
}
#define RW_L(n) (n)
#define RW_S(n) (64 + (n))
#define GLA_L(m) (320 + (m))
#define GLA_S(m) (320 + 32 + (m))
#define SSD_L(m) (480 + (m))
#define SSD_S(m) (480 + 32 + (m))
__device__ void phase_scan(const Ctx& c, int l) {
    const bool bal = c.G == 256; const int n = bal ? ((c.bid & 7) < 4 ? 1 : 4) : (640 - c.bid + c.G - 1) / c.G;
    for (int k = 0; k < n; ++k) {
        int bl = c.bid; asm volatile("" : "+s"(bl));
        const int cl = bl & 7, ix = bl >> 3, j = (cl - 4) * 32 + ix;
        const int id = !bal ? bl + k * c.G : (cl < 2 ? RW_L(ix * 2 + cl) : (cl == 2 ? GLA_L(ix) : (cl == 3 ? SSD_L(ix) : (k == 0 ? RW_S(2 * j) : (k == 1 ? RW_S(2 * j + 1) : (k == 2 ? GLA_S(j) : SSD_S(j)))))));
        scan_item(c, l, id);
    }
}

#ifndef PPT
#define PPT 1
#endif
__device__ void phase_postpass(const Ctx& c, int l) {
    const int lane = c.lane, c0 = lane * 8;
    const float* Dp = c.in[18] + l * 16; const float* snorm = c.in[19] + l * 512; const float* gnorm = c.in[23] + l * 128;
    const float* rk = c.in[33] + l * 512; const float* lnw = c.in[34] + l * 512; const float* lnb = c.in[35] + l * 512;
    constexpr size_t SL = (size_t)T * DMIX;
    for (int r0 = c.gw; r0 < T; r0 += PPT * c.NW) {
        u32x4 q[PPT][13];
#pragma unroll
        for (int e = 0; e < PPT; ++e) { const int r = min(r0 + e * c.NW, T - 1); const bf16_t* p0 = c.PROJ_() + (size_t)r * NPROJ; const bf16_t* of = c.OUTS_() + (size_t)r * DMIX + c0;
            q[e][0] = *(const u32x4*)of; q[e][1] = *(const u32x4*)(of + SL); q[e][2] = *(const u32x4*)(c.XBC_() + (size_t)r * 768 + c0); q[e][3] = *(const u32x4*)(p0 + c0);
            q[e][4] = *(const u32x4*)(of + 2 * SL); q[e][5] = *(const u32x4*)(of + 3 * SL); q[e][6] = *(const u32x4*)(p0 + C_GLA + 1024 + c0);
            q[e][7] = *(const u32x4*)(of + 4 * SL); q[e][8] = *(const u32x4*)(of + 5 * SL); q[e][9] = *(const u32x4*)(c.RWR_() + (size_t)r * 512 + c0); q[e][10] = *(const u32x4*)(c.RWK_() + (size_t)r * 512 + c0);
            q[e][11] = *(const u32x4*)(c.RWV_() + (size_t)r * 512 + c0); q[e][12] = *(const u32x4*)(c.SMALL_() + (size_t)r * NSM + 1536 + c0); }
#pragma unroll
        for (int e = 0; e < PPT; ++e) { const int r = r0 + e * c.NW; if (r >= T) break;
            bf16_t* of = c.OUTS_() + (size_t)r * DMIX + c0;
            {
                float a[8], b[8], x[8], z[8], y[8]; unpack8(q[e][0], a); unpack8(q[e][1], b); unpack8(q[e][2], x); unpack8(q[e][3], z);
                const int h = lane >> 3; const float dsum = Dp[h] + Dp[8 + h]; float ss = 0.f;
#pragma unroll
                for (int j = 0; j < 8; ++j) { y[j] = (x[j] * dsum + a[j] + b[j]) * siluf_(z[j]); ss += y[j] * y[j]; }
                ss = wave_sum(ss, c.lane); const float rs = rsqrtf(ss * (1.0f / 512.0f) + 1e-6f);
#pragma unroll
                for (int j = 0; j < 8; ++j) y[j] = y[j] * rs * snorm[c0 + j];
                *(u32x4*)of = pack8(y);
            }
            {
                float a[8], b[8], g[8], y[8]; unpack8(q[e][4], a); unpack8(q[e][5], b); unpack8(q[e][6], g);
                float ss = 0.f;
#pragma unroll
                for (int j = 0; j < 8; ++j) { y[j] = a[j] + b[j]; ss += y[j] * y[j]; }
                ss = dred8(ss); ss += shx(ss, c.lane, 8);
                const float rs = rsqrtf(ss * (1.0f / 128.0f) + 1e-6f);
#pragma unroll
                for (int j = 0; j < 8; ++j) y[j] = y[j] * rs * gnorm[(c0 + j) & 127] * siluf_(g[j]);
                *(u32x4*)(of + 2 * SL) = pack8(y);
            }
            {
                float a[8], b[8], rr[8], kk[8], vv[8], gg[8], y[8];
                unpack8(q[e][7], a); unpack8(q[e][8], b); unpack8(q[e][9], rr); unpack8(q[e][10], kk); unpack8(q[e][11], vv); unpack8(q[e][12], gg);
                float sm = 0.f, bon = 0.f;
#pragma unroll
                for (int j = 0; j < 8; ++j) { y[j] = a[j] + b[j]; sm += y[j]; bon += rr[j] * kk[j] * rk[c0 + j]; }
                sm = dred8(sm); bon = dred8(bon); const float mean = sm * (1.0f / 64.0f); float vs = 0.f;
#pragma unroll
                for (int j = 0; j < 8; ++j) { y[j] -= mean; vs += y[j] * y[j]; }
                vs = dred8(vs); const float rs = rsqrtf(vs * (1.0f / 64.0f) + 64e-5f);
#pragma unroll
                for (int j = 0; j < 8; ++j) y[j] = (y[j] * rs * lnw[c0 + j] + lnb[c0 + j] + bon * vv[j]) * gg[j];
                *(u32x4*)(of + 4 * SL) = pack8(y);
            }
        }
    }
}

#ifndef RMASK
#define RMASK 0
#endif
#ifndef RMASK3
#define RMASK3 0
#endif
constexpr int N_PHASES = 2 + 2 * (14 + __builtin_popcount(RMASK) + 2 * __builtin_popcount(RMASK3));
__global__ void __launch_bounds__(NT, 2) fwd_kernel(Args a) {
    extern __shared__ __attribute__((aligned(16))) unsigned char lds_raw[];
    Ctx c; c.in = a.in; c.out = a.out; c.ws = a.ws; c.lds = (LAS unsigned char*)lds_raw;
    cg::grid_group grid = cg::this_grid();
    volatile LAS unsigned* st = (volatile LAS unsigned*)(c.lds + LDS_STAGE);
    if (threadIdx.x < 4) st[threadIdx.x] = 0u;
    __syncthreads();
    const XcdBarrier bar = xcd_barrier_post((unsigned*)(a.ws + WS_BAR), st);
    if (a.ph_hi < 0) grid.sync();
    for (int ph = a.ph_lo; ph < a.ph_hi; ++ph) {
#ifndef EXTRA_SYNC
#define EXTRA_SYNC 0
#endif
        if (ph > a.ph_lo) { xcd_barrier(bar); for (int e = 0; e < EXTRA_SYNC; ++e) xcd_barrier(bar); }
        { int tl = threadIdx.x, bl = blockIdx.x, gl = gridDim.x; asm volatile("" : "+v"(tl), "+s"(bl), "+s"(gl)); c.G = gl; c.NW = gl * 8;
          c.tid = tl; c.lane = tl & 63; c.wid = __builtin_amdgcn_readfirstlane(tl >> 6); c.bid = bl; c.gw = bl * 8 + c.wid; }
        if (ph == 0) { phase_init(c); __syncthreads(); const int base = convert_ffn(c, 0, 0, 0); convert_mixer(c, 0, base); continue; }
        if (ph == N_PHASES - 1) { phase_final_norm(c); continue; }
#ifndef RMASK
#define RMASK 0
#endif
        constexpr int LAYER_LEN = 14 + __builtin_popcount(RMASK) + 2 * __builtin_popcount(RMASK3);
        const int l = (ph - 1) / LAYER_LEN; int sp = 0; float sgn = 1.0f;
        if (RMASK | RMASK3) { int k = (ph - 1) % LAYER_LEN; for (sp = 0; sp < 14; ++sp) { const int reps = 1 + ((RMASK >> sp) & 1) + 2 * ((RMASK3 >> sp) & 1); if (k < reps) break; k -= reps; } sgn = (k & 1) ? -1.0f : 1.0f; }
        else sp = (ph - 1) % 14;
        const float* ada_l = c.ADA_() + l * 5 * 9216;
#ifndef PMASK
#define PMASK 0xFFFF
#endif
#define PON(k) ((PMASK >> (k)) & 1)
        switch (sp) {
            case 0: if (PON(0)) { phase_norm(c, l, 0, l > 0); if (l > 0) { __syncthreads(); int base = convert_ffn(c, l, 0, 0); convert_mixer(c, l, base); } } break;
            case 1: case 12: if (PON(1)) run_gemm(c, c.H_(), c.WGU_(), 5632, 1024, EpiGU{c.PROJ_()}); break;
            case 2: if (PON(2)) run_gemm(c, c.PROJ_(), c.WD_(), 1024, DFF, EpiResid{c.OUTS_(), ada_l + 2 * 1024, 0.5f * sgn}, 2); break;
            case 13: if (PON(2)) run_gemm(c, c.PROJ_(), c.WD_(), 1024, DFF, EpiResid{c.OUTS_(), ada_l + 8 * 1024, 0.5f * sgn}, 2); break;
            case 3: if (PON(3)) phase_norm(c, l, 1, true); break;
            case 4: if (PON(4)) run_gemm(c, c.H_(), c.WIN_(), NPROJ, 1024, EpiProj{c.PROJ_(), NPROJ}); break;
            case 5: if (PON(5)) phase_prepass(c, l); break;
            case 6: if (PON(6)) run_gemm(c, c.LOWA_(), c.WSM_(), 2048, KSM, EpiSmall{c.SMALL_(), c.in[26] + l * 1024, c.in[28] + l * 512, c.RWK_(), c.RWKK_(), c.in[32] + l * 512}); break;
            case 7: if (PON(7)) phase_scan(c, l); break;
            case 8: if (PON(8)) phase_postpass(c, l); break;
            case 9: if (PON(9)) { int Kl = 512; asm volatile("" : "+s"(Kl));
                pg8::Gemm g{c.OUTS_(), c.WBO_(), T, 3072, Kl, 512, 4, (size_t)2 * T * DMIX * 2, (size_t)1024 * 512 * 2}; BranchOrder S{c.bid};
                pg8::gemm_phase<EpiBranch, BranchOrder, GP_ALIGN, GP_SP2>(c.lds, g, S, EpiBranch{c.H_(), c.PROJ_() + C_GATE});
                if (c.G > 128 && c.bid >= 128) { Ctx c2 = c; c2.bid = c.bid - 128; c2.G = c.G - 128; (void)convert_ffn(c2, l, 1, 0); } } break;
            case 10: if (PON(10)) run_gemm(c, c.H_(), c.WOUT_(), 1024, 1024, EpiResid{c.OUTS_(), ada_l + 5 * 1024, 1.0f * sgn}, 2); break;
            case 11: if (PON(11)) { phase_norm(c, l, 2, true); if (c.G <= 128) { __syncthreads(); (void)convert_ffn(c, l, 1, 0); } } break;
        }
    }
}

#ifndef N_LAUNCH_MODE
#define N_LAUNCH_MODE 1
#endif
extern "C" void kernel_launch(void* const* d_in, const int* in_sizes, int n_in, void* d_out, int out_size, void* d_ws, size_t ws_size, hipStream_t stream) {
    static int grid = 0;
    if (grid == 0) {
        if (n_in != 39 || ws_size < WS_END) { fprintf(stderr, "kernel_launch: need 39 inputs and %zu bytes of workspace; got %d, %zu\n", (size_t)WS_END, n_in, ws_size); grid = -1; return; }
        if (hipFuncSetAttribute((const void*)fwd_kernel, hipFuncAttributeMaxDynamicSharedMemorySize, LDS_BYTES) != hipSuccess) { fprintf(stderr, "kernel_launch: hipFuncSetAttribute failed\n"); grid = -1; return; }
        int dev = 0, cus = 0, per_cu = 0;
        hipGetDevice(&dev); hipDeviceGetAttribute(&cus, hipDeviceAttributeMultiprocessorCount, dev);
        hipOccupancyMaxActiveBlocksPerMultiprocessor(&per_cu, (const void*)fwd_kernel, NT, LDS_BYTES);
        if (per_cu < 1) { fprintf(stderr, "kernel_launch: occupancy query says %d blocks per CU\n", per_cu); per_cu = 1; }
        (void)hipGetLastError();
        grid = cus;
    }
    if (grid < 0) return;
    Args a{};
    for (int i = 0; i < 39; ++i) a.in[i] = (const float*)d_in[i];
    a.out = (float*)d_out; a.ws = (unsigned char*)d_ws;
#if N_LAUNCH_MODE == 0
    for (int ph = 0; ph < N_PHASES; ++ph) { a.ph_lo = ph; a.ph_hi = ph + 1; hipLaunchKernelGGL(fwd_kernel, dim3(grid), dim3(NT), LDS_BYTES, stream, a); }
#else
    if (hipMemsetAsync((unsigned char*)d_ws + WS_BAR, 0, XCD_BAR_WORDS * 4, stream) != hipSuccess) { fprintf(stderr, "kernel_launch: memset of the barrier words failed\n"); return; }
    a.ph_lo = 0; a.ph_hi = N_PHASES;
    void* args[] = {&a};
    hipError_t e = hipLaunchCooperativeKernel((const void*)fwd_kernel, dim3(grid), dim3(NT), args, LDS_BYTES, stream);
    if (e != hipSuccess) fprintf(stderr, "cooperative launch failed: %s (grid %d)\n", hipGetErrorString(e), grid);
#endif
}
```

```cpp
#include <hip/hip_runtime.h>
#include <hip/hip_cooperative_groups.h>
#include <cstdio>
namespace cg = cooperative_groups;
namespace pg8 {
#define PG8_LAS __attribute__((address_space(3)))
typedef unsigned short bf16_t;
typedef short bf16x8 __attribute__((ext_vector_type(8)));
typedef float f32x4 __attribute__((ext_vector_type(4)));
typedef unsigned u32x4 __attribute__((ext_vector_type(4)));
constexpr int BM = 256, BK = 64, HALF = 128, HTB = HALF * BK * 2  , STAGE_BYTES = 8 * HTB, NXCD = 8, WGM = 8;

__host__ __device__ __forceinline__ int lds_byte(int r, int c) { const int st = (r >> 4) * 2 + (c >> 5), rr = r & 15, cc = c & 31, ob = rr * 64 + cc * 2; return st * 1024 + (ob ^ (((ob >> 9) & 1) << 5)); }
__host__ __device__ __forceinline__ void stage_rc(int b, int& R, int& C) { const int st = b / 1024, sb = b % 1024, swz = sb ^ (((sb >> 9) & 1) << 5); R = (st >> 1) * 16 + swz / 64; C = (st & 1) * 32 + (swz % 64) / 2; }
__host__ __device__ __forceinline__ int perm32(int rho) { const int n = rho >> 4, i = rho & 15; return 8 * (i >> 2) + 4 * n + (i & 3); }

struct Unit { int pm, pn; };
struct Gemm { const bf16_t* A; const bf16_t* Bt; int M, N, K, ld, nreal; size_t asl, bsl; };

struct StaticOrder {
    int nM, nN, nwg, G, c;
    __host__ __device__ void init(int M, int N, int G_, int c_) { nM = M / BM; nN = N / BM; nwg = nM * nN; G = G_; c = c_; }
    __host__ __device__ bool next(int i, Unit& u) const {
        const long L = (long)i * G + c; if (L >= nwg) return false;
        int wgid = (int)L; { const int q = nwg / NXCD, r = nwg % NXCD, xcd = wgid % NXCD, off = wgid / NXCD; wgid = (xcd < r ? xcd * (q + 1) : r * (q + 1) + (xcd - r) * q) + off; }
        const int nig = WGM * nN, gid = wgid / nig, fm = gid * WGM, gsz = (nM - fm) < WGM ? (nM - fm) : WGM;
        u.pm = fm + ((wgid % nig) % gsz); u.pn = (wgid % nig) / gsz; return true;
    }
    __device__ __forceinline__ void a_ready(const Unit&) const {}
    __device__ __forceinline__ void done(const Unit&) const {}
};
__device__ __forceinline__ unsigned cvt_pk_bf16(float lo, float hi) { unsigned r; asm volatile("v_cvt_pk_bf16_f32 %0, %1, %2" : "=v"(r) : "v"(lo), "v"(hi)); return r; }
template <class Epi, class Sched, bool ALIGN_EPI = false, bool SP2 = false>
__device__ __forceinline__ void gemm_phase(PG8_LAS unsigned char* lds, const Gemm g, const Sched& S, const Epi& E) {
    int tid_l = threadIdx.x; asm volatile("" : "+v"(tid_l));
    const int tid = tid_l, wid = __builtin_amdgcn_readfirstlane(tid >> 6), lane = tid & 63, wr = wid >> 2, wc = wid & 3, fr = lane & 15, fq = lane >> 4;
    const int K = g.K, LD = g.ld, nt = K / BK;
    unsigned voffA[2], voffB[2];
#pragma unroll
    for (int i = 0; i < 2; ++i) { int R, C; stage_rc(tid * 16 + i * 8192, R, C); const int Rb = Epi::PERM ? ((R & ~31) + perm32(R & 31)) : R;
        voffA[i] = (unsigned)(R * LD + C) * 2u; voffB[i] = (unsigned)(Rb * LD + C) * 2u; }
    const size_t kstep = (size_t)(BK * 2);
    const size_t hstep = (size_t)HALF * LD * 2;
    const size_t tstep = 2 * hstep;
    const unsigned ldsw = (unsigned)wid * 1024u;
    const int aoff = lds_byte(wr * 64 + fr, fq * 8), boff = lds_byte(wc * 32 + fr, fq * 8);
#define PG8_SA(b, h) (((b) * 2 + (h)) * HTB)
#define PG8_SB(b, h) ((4 + (b) * 2 + (h)) * HTB)
#define PG8_STAGE(bufoff, gbase, voff) do { _Pragma("unroll") for (int _i = 0; _i < 2; ++_i) \
        __builtin_amdgcn_global_load_lds((const unsigned*)((const char*)(gbase) + (voff)[_i]), (PG8_LAS unsigned*)(lds + (bufoff) + ldsw + _i * 8192), 16, 0, 0); } while (0)
#define PG8_LDA(dst, b, h) do { _Pragma("unroll") for (int m = 0; m < 4; ++m) _Pragma("unroll") for (int k = 0; k < 2; ++k) dst[m][k] = *(const PG8_LAS bf16x8*)(lds + PG8_SA(b, h) + aoff + m * 2048 + k * 1024); } while (0)
#define PG8_LDB(dst, b, h) do { _Pragma("unroll") for (int n = 0; n < 2; ++n) _Pragma("unroll") for (int k = 0; k < 2; ++k) dst[n][k] = *(const PG8_LAS bf16x8*)(lds + PG8_SB(b, h) + boff + n * 2048 + k * 1024); } while (0)
#define PG8_MMA(ai, bj, At, Bt) do { __builtin_amdgcn_s_setprio(1); _Pragma("unroll") for (int m = 0; m < 4; ++m) _Pragma("unroll") for (int n = 0; n < 2; ++n) _Pragma("unroll") for (int k = 0; k < 2; ++k) \
        acc[ai][bj][m][n] = __builtin_amdgcn_mfma_f32_16x16x32_bf16(Bt[n][k], At[m][k], acc[ai][bj][m][n], 0, 0, 0); __builtin_amdgcn_s_setprio(0); } while (0)
#define PG8_WAIT_V(n) asm volatile("s_waitcnt vmcnt(" #n ")" ::: "memory")
#define PG8_WAIT_L(n) asm volatile("s_waitcnt lgkmcnt(" #n ")" ::: "memory")
#define PG8_BAR __builtin_amdgcn_s_barrier()
#define PG8_SCHED __builtin_amdgcn_sched_barrier(0)
    Unit cur, nxt; int ui = 0;
    if (!S.next(0, cur)) return;
    f32x4 acc[2][2][4][2];
#pragma unroll
    for (int a = 0; a < 2; ++a)
#pragma unroll
        for (int b = 0; b < 2; ++b)
#pragma unroll
            for (int m = 0; m < 4; ++m)
#pragma unroll
                for (int n = 0; n < 2; ++n) acc[a][b][m][n] = (f32x4){0.f, 0.f, 0.f, 0.f};
    bf16x8 At[4][2], B0[2][2], B1[2][2];
    const char* cA = (const char*)g.A + (size_t)cur.pm * tstep + (size_t)(cur.pn / g.nreal) * g.asl; const char* cB = (const char*)g.Bt + (size_t)(cur.pn % g.nreal) * tstep + (size_t)(cur.pn / g.nreal) * g.bsl;
    S.a_ready(cur);
    if constexpr (SP2) {
        PG8_STAGE(PG8_SB(0, 0), cB, voffB); PG8_STAGE(PG8_SB(0, 1), cB + hstep, voffB); PG8_STAGE(PG8_SA(0, 0), cA, voffA); PG8_STAGE(PG8_SA(0, 1), cA + hstep, voffA);
        if (wr == 1) PG8_BAR;
        PG8_WAIT_V(2); PG8_BAR;
        PG8_STAGE(PG8_SB(1, 0), cB + kstep, voffB); PG8_STAGE(PG8_SA(1, 0), cA + kstep, voffA); PG8_STAGE(PG8_SB(1, 1), cB + hstep + kstep, voffB);
        PG8_WAIT_V(6); PG8_BAR;
    } else {
        PG8_STAGE(PG8_SB(0, 0), cB, voffB); PG8_STAGE(PG8_SA(0, 0), cA, voffA); PG8_STAGE(PG8_SB(0, 1), cB + hstep, voffB); PG8_STAGE(PG8_SA(0, 1), cA + hstep, voffA);
        if (wr == 1) PG8_BAR;
        PG8_WAIT_V(4); PG8_BAR;
        PG8_STAGE(PG8_SB(1, 0), cB + kstep, voffB); PG8_STAGE(PG8_SA(1, 0), cA + kstep, voffA); PG8_STAGE(PG8_SB(1, 1), cB + hstep + kstep, voffB);
        PG8_WAIT_V(6); PG8_BAR;
    }
    for (;;) {
        const bool has_next = S.next(ui + 1, nxt);
        const char* nA = has_next ? (const char*)g.A + (size_t)nxt.pm * tstep + (size_t)(nxt.pn / g.nreal) * g.asl : cA; const char* nB = has_next ? (const char*)g.Bt + (size_t)(nxt.pn % g.nreal) * tstep + (size_t)(nxt.pn / g.nreal) * g.bsl : cB;
        for (int t = 0; t < nt; t += 2) {
            const bool last = (t == nt - 2);
            const char* a1 = cA + (size_t)(t + 1) * kstep;
            const char* a2 = last ? nA : cA + (size_t)(t + 2) * kstep; const char* b2 = last ? nB : cB + (size_t)(t + 2) * kstep;
            const char* a3 = a2 + kstep; const char* b3 = b2 + kstep;
            if (last && has_next) S.a_ready(nxt);
            if constexpr (SP2) {
            PG8_LDB(B0, 0, 0); PG8_LDB(B1, 0, 1); PG8_SCHED; PG8_LDA(At, 0, 0); PG8_STAGE(PG8_SA(1, 1), a1 + hstep, voffA);
            PG8_WAIT_V(8); PG8_WAIT_L(0); PG8_BAR; PG8_MMA(0, 0, At, B0); PG8_MMA(0, 1, At, B1); PG8_BAR; PG8_SCHED;
            PG8_LDA(At, 0, 1); PG8_STAGE(PG8_SB(0, 0), b2, voffB); PG8_STAGE(PG8_SB(0, 1), b2 + hstep, voffB); PG8_STAGE(PG8_SA(0, 0), a2, voffA);
            PG8_WAIT_V(8); PG8_WAIT_L(0); PG8_BAR; PG8_MMA(1, 0, At, B0); PG8_MMA(1, 1, At, B1); PG8_BAR; PG8_SCHED;
            PG8_LDB(B0, 1, 0); PG8_LDB(B1, 1, 1); PG8_SCHED; PG8_LDA(At, 1, 0); PG8_STAGE(PG8_SA(0, 1), a2 + hstep, voffA);
            PG8_WAIT_V(8); PG8_WAIT_L(0); PG8_BAR; PG8_MMA(0, 0, At, B0); PG8_MMA(0, 1, At, B1); PG8_BAR; PG8_SCHED;
            PG8_LDA(At, 1, 1); PG8_STAGE(PG8_SB(1, 0), b3, voffB); PG8_STAGE(PG8_SB(1, 1), b3 + hstep, voffB); PG8_STAGE(PG8_SA(1, 0), a3, voffA);
            PG8_WAIT_V(8); PG8_WAIT_L(0); PG8_BAR; PG8_MMA(1, 0, At, B0); PG8_MMA(1, 1, At, B1); PG8_BAR; PG8_SCHED;
            } else {
            PG8_LDB(B0, 0, 0); PG8_SCHED; PG8_LDA(At, 0, 0); PG8_STAGE(PG8_SA(1, 1), a1 + hstep, voffA);
            PG8_WAIT_L(8); PG8_BAR; PG8_WAIT_L(0); PG8_MMA(0, 0, At, B0); PG8_BAR; PG8_SCHED;
            PG8_LDB(B1, 0, 1); PG8_STAGE(PG8_SB(0, 0), b2, voffB);
            PG8_BAR; PG8_WAIT_L(0); PG8_MMA(0, 1, At, B1); PG8_BAR;
            PG8_LDA(At, 0, 1); PG8_STAGE(PG8_SA(0, 0), a2, voffA);
            PG8_BAR; PG8_WAIT_L(0); PG8_MMA(1, 0, At, B0); PG8_BAR; PG8_SCHED;
            PG8_STAGE(PG8_SB(0, 1), b2 + hstep, voffB);
            PG8_WAIT_V(6); PG8_BAR; PG8_MMA(1, 1, At, B1); PG8_BAR;
            PG8_LDB(B0, 1, 0); PG8_SCHED; PG8_LDA(At, 1, 0); PG8_STAGE(PG8_SA(0, 1), a2 + hstep, voffA);
            PG8_WAIT_L(8); PG8_BAR; PG8_WAIT_L(0); PG8_MMA(0, 0, At, B0); PG8_BAR; PG8_SCHED;
            PG8_LDB(B1, 1, 1); PG8_STAGE(PG8_SB(1, 0), b3, voffB);
            PG8_BAR; PG8_WAIT_L(0); PG8_MMA(0, 1, At, B1); PG8_BAR;
            PG8_LDA(At, 1, 1); PG8_STAGE(PG8_SA(1, 0), a3, voffA);
            PG8_BAR; PG8_WAIT_L(0); PG8_MMA(1, 0, At, B0); PG8_BAR; PG8_SCHED;
            PG8_STAGE(PG8_SB(1, 1), b3 + hstep, voffB);
            PG8_WAIT_V(6); PG8_BAR; PG8_MMA(1, 1, At, B1); PG8_BAR;
            }
        }
        if constexpr (ALIGN_EPI) { if (wr == 0) PG8_BAR; }
        if constexpr (!Epi::AFTER_DRAIN) { E(acc, cur, wr, wc, fr, fq); S.done(cur); }
        if (!has_next) break;
#pragma unroll
        for (int a = 0; a < 2; ++a)
#pragma unroll
            for (int b = 0; b < 2; ++b)
#pragma unroll
                for (int m = 0; m < 4; ++m)
#pragma unroll
                    for (int n = 0; n < 2; ++n) acc[a][b][m][n] = (f32x4){0.f, 0.f, 0.f, 0.f};
        cur = nxt; cA = nA; cB = nB; ++ui;
        if constexpr (ALIGN_EPI) { if (wr == 1) PG8_BAR; }
    }
    PG8_WAIT_V(0);
    if constexpr (!ALIGN_EPI) { if (wr == 0) PG8_BAR; }
    PG8_BAR;
    if constexpr (Epi::AFTER_DRAIN) { E.fused(acc, cur, wr, wc, fr, fq, lds, wid, lane); S.done(cur); }
#undef PG8_SA
#undef PG8_SB
#undef PG8_STAGE
#undef PG8_LDA
#undef PG8_LDB
#undef PG8_MMA
#undef PG8_WAIT_V
#undef PG8_WAIT_L
#undef PG8_BAR
#undef PG8_SCHED
}
}
#define LAS __attribute__((address_space(3)))
#define XB_TMO      128
#define XB_XCNT(j)  (256  + 64 * (j))
#define XB_XSUB(j)  (1280 + 64 * (j))
#define XB_XGEN(j)  (2304 + 64 * (j))
#define XB_TOP      3328
#define XB_TOPGEN   3392
#define XCD_BAR_WORDS 3456
#define XB_SPIN_CAP (1u << 18)

__device__ __forceinline__ unsigned xb_ld(unsigned* p)              { return __hip_atomic_load(p, __ATOMIC_RELAXED, __HIP_MEMORY_SCOPE_AGENT); }
__device__ __forceinline__ unsigned xb_add(unsigned* p, unsigned v) { return __hip_atomic_fetch_add(p, v, __ATOMIC_RELAXED, __HIP_MEMORY_SCOPE_AGENT); }
__device__ __forceinline__ unsigned xb_xcc_id() { return (unsigned)__builtin_amdgcn_s_getreg((3 << 11) | 20) & 0xFu; }
#define XB_SPIN(cond, bar) do { unsigned _sp = 0; while (cond) { __builtin_amdgcn_s_sleep(1); \
    if ((++_sp & 255u) == 0u) { if (xb_ld(&(bar)[XB_TMO])) break; if (_sp > XB_SPIN_CAP) { atomicAdd(&(bar)[XB_TMO], 1u); break; } } } } while (0)

struct XcdBarrier {
    unsigned* bar; unsigned x;
    volatile LAS unsigned* st;
};

__device__ __forceinline__ XcdBarrier xcd_barrier_post(unsigned* bar, volatile LAS unsigned* st) {
    XcdBarrier b; b.bar = bar; b.x = xb_xcc_id(); b.st = st;
    if (threadIdx.x == 0) (void)xb_add(&bar[XB_XCNT(b.x)], 1u);
    return b;
}
__device__ __forceinline__ void xcd_barrier_complete(unsigned* bar, unsigned x, unsigned& nloc, unsigned& nx) {
    const unsigned G = gridDim.x * gridDim.y * gridDim.z;
    unsigned sum, cnt, mine, sp = 0u;
    for (;;) {
        sum = 0u; cnt = 0u; mine = 0u;
#pragma unroll
        for (unsigned j = 0; j < 16; ++j) { const unsigned c = xb_ld(&bar[XB_XCNT(j)]); sum += c; cnt += (c > 0u) ? 1u : 0u; mine = (j == x) ? c : mine; }
        if (sum == G) break;
        __builtin_amdgcn_s_sleep(1);
        if ((++sp & 255u) == 0u) { if (xb_ld(&bar[XB_TMO])) break; if (sp > XB_SPIN_CAP) { atomicAdd(&bar[XB_TMO], 1u); break; } }
    }
    nloc = mine > 0u ? mine : 1u; nx = cnt > 0u ? cnt : 1u;
}

__device__ __forceinline__ void xcd_barrier(const XcdBarrier& b) {
    asm volatile("s_waitcnt vmcnt(0)" ::: "memory");
    __syncthreads();
    if (threadIdx.x == 0) {
        unsigned* bar = b.bar;
        __builtin_amdgcn_s_waitcnt(0);
        unsigned nloc = b.st[0], nx = b.st[1];
        if (nloc == 0u) { xcd_barrier_complete(bar, b.x, nloc, nx); b.st[0] = nloc; b.st[1] = nx; }
        const unsigned old = xb_add(&bar[XB_XSUB(b.x)], 1u);
        const unsigned gen = old / nloc;
        if (old + 1u == (gen + 1u) * nloc) {
            __builtin_amdgcn_fence(__ATOMIC_RELEASE, "agent");
            asm volatile("s_waitcnt vmcnt(0)" ::: "memory");
            const unsigned og = xb_add(&bar[XB_TOP], 1u);
            const unsigned tg = og / nx;
            if (og + 1u == (tg + 1u) * nx) xb_add(&bar[XB_TOPGEN], 1u);
            else XB_SPIN(xb_ld(&bar[XB_TOPGEN]) == tg, bar);
            __builtin_amdgcn_fence(__ATOMIC_ACQUIRE, "agent");
            xb_add(&bar[XB_XGEN(b.x)], 1u);
            asm volatile("s_waitcnt vmcnt(0)" ::: "memory");
        } else {
            XB_SPIN(xb_ld(&bar[XB_XGEN(b.x)]) == gen, bar);
            __builtin_amdgcn_fence(__ATOMIC_ACQUIRE, "agent");
            asm volatile("s_waitcnt vmcnt(0)" ::: "memory");
        }
    }
    __syncthreads();
}

using pg8::bf16_t; using pg8::f32x4; using pg8::u32x4; using pg8::cvt_pk_bf16;
typedef unsigned u32x2 __attribute__((ext_vector_type(2)));

constexpr int T = 8192, D = 1024, DFF = 2816, DMIX = 512, NPROJ = 7936, NIN = 7792, NSM = 2560, KSM = 384, NT = 512, LDS_STAGE = 131072, LDS_BYTES = LDS_STAGE + 16;
constexpr int C_GLA = 1296, C_RW = 2864, C_GATE = 4720;
constexpr size_t WS_ADA = 0;
constexpr size_t WS_WGU = WS_ADA + 2ull * 5 * 9216 * 4;
constexpr size_t WS_WD = WS_WGU + 5632ull * 1024 * 2;
constexpr size_t WS_WIN = WS_WD + 1024ull * 2816 * 2;
constexpr size_t WS_WBO = WS_WIN + (size_t)NPROJ * 1024 * 2;
constexpr size_t WS_WOUT = WS_WBO + 3ull * 1024 * 512 * 2;
constexpr size_t WS_WSM = WS_WOUT + 1024ull * 1024 * 2;
constexpr size_t WS_H = WS_WSM + (size_t)NSM * KSM * 2;
constexpr size_t WS_PROJ = WS_H + (size_t)T * D * 2;
constexpr size_t WS_RW = WS_PROJ + (size_t)T * NPROJ * 2;
constexpr size_t WS_LOWA = WS_RW + 4ull * T * DMIX * 2;
constexpr size_t WS_SMALL = WS_LOWA + (size_t)T * KSM * 2;
constexpr size_t WS_OUT = WS_SMALL + (size_t)T * NSM * 2;
constexpr size_t WS_BAR = WS_OUT + 6ull * T * DMIX * 2;
constexpr size_t WS_END = WS_BAR + XCD_BAR_WORDS * 4;
constexpr size_t WS_XBC = WS_WGU;
constexpr size_t WS_DT = WS_XBC + (size_t)T * 768 * 2;
static_assert(WS_DT + (size_t)T * 16 * 4 <= WS_WIN, "xbc alias");
constexpr size_t OUT_SSD = 8388608, OUT_GLA = OUT_SSD + 2097152, OUT_RWK = OUT_GLA + 2097152;

struct Args { const float* in[39]; float* out; unsigned char* ws; int ph_lo, ph_hi; };

struct Ctx {
    const float* const* in; float* out; unsigned char* ws; LAS unsigned char* lds; int tid, lane, wid, G, bid, gw, NW;
    __device__ __forceinline__ float* X_() const { return out; }
    __device__ __forceinline__ float* ADA_() const { return (float*)(ws + WS_ADA); }
    __device__ __forceinline__ bf16_t* WGU_() const { return (bf16_t*)(ws + WS_WGU); }
    __device__ __forceinline__ bf16_t* WD_() const { return (bf16_t*)(ws + WS_WD); }
    __device__ __forceinline__ bf16_t* WIN_() const { return (bf16_t*)(ws + WS_WIN); }
    __device__ __forceinline__ bf16_t* WBO_() const { return (bf16_t*)(ws + WS_WBO); }
    __device__ __forceinline__ bf16_t* WOUT_() const { return (bf16_t*)(ws + WS_WOUT); }
    __device__ __forceinline__ bf16_t* WSM_() const { return (bf16_t*)(ws + WS_WSM); }
    __device__ __forceinline__ bf16_t* H_() const { return (bf16_t*)(ws + WS_H); }
    __device__ __forceinline__ bf16_t* PROJ_() const { return (bf16_t*)(ws + WS_PROJ); }
    __device__ __forceinline__ bf16_t* RWR_() const { return (bf16_t*)(ws + WS_RW); }
    __device__ __forceinline__ bf16_t* RWK_() const { return (bf16_t*)(ws + WS_RW) + (size_t)T * DMIX; }
    __device__ __forceinline__ bf16_t* RWV_() const { return (bf16_t*)(ws + WS_RW) + (size_t)2 * T * DMIX; }
    __device__ __forceinline__ bf16_t* RWKK_() const { return (bf16_t*)(ws + WS_RW) + (size_t)3 * T * DMIX; }
    __device__ __forceinline__ bf16_t* LOWA_() const { return (bf16_t*)(ws + WS_LOWA); }
    __device__ __forceinline__ bf16_t* SMALL_() const { return (bf16_t*)(ws + WS_SMALL); }
    __device__ __forceinline__ bf16_t* OUTS_() const { return (bf16_t*)(ws + WS_OUT); }
    __device__ __forceinline__ bf16_t* XBC_() const { return (bf16_t*)(ws + WS_XBC); }
    __device__ __forceinline__ float* DT_() const { return (float*)(ws + WS_DT); }
};

__device__ __forceinline__ float bf2f(bf16_t v) { return __uint_as_float((unsigned)v << 16); }
__device__ __forceinline__ float bflo(unsigned v) { return __uint_as_float(v << 16); }
__device__ __forceinline__ float bfhi(unsigned v) { return __uint_as_float(v & 0xffff0000u); }
__device__ __forceinline__ bf16_t f2bf(float f) { return (bf16_t)(cvt_pk_bf16(f, 0.f) & 0xffffu); }
__device__ __forceinline__ float sigmoidf_(float x) { return __builtin_amdgcn_rcpf(1.0f + __expf(-x)); }
__device__ __forceinline__ float siluf_(float x) { return x * __builtin_amdgcn_rcpf(1.0f + __expf(-x)); }
__device__ __forceinline__ float softplusf_(float x) { return fmaxf(x, 0.f) + __logf(1.0f + __expf(-fabsf(x))); }
__device__ __forceinline__ void unpack8(const u32x4 w, float* f) { f[0] = bflo(w.x); f[1] = bfhi(w.x); f[2] = bflo(w.y); f[3] = bfhi(w.y); f[4] = bflo(w.z); f[5] = bfhi(w.z); f[6] = bflo(w.w); f[7] = bfhi(w.w); }
__device__ __forceinline__ u32x4 pack8(const float* f) { u32x4 w; w.x = cvt_pk_bf16(f[0], f[1]); w.y = cvt_pk_bf16(f[2], f[3]); w.z = cvt_pk_bf16(f[4], f[5]); w.w = cvt_pk_bf16(f[6], f[7]); return w; }
__device__ __forceinline__ float shx(float x, int lane, int m) { return __int_as_float(__builtin_amdgcn_ds_bpermute((lane ^ m) << 2, __float_as_int(x))); }
__device__ __forceinline__ float wave_sum(float x, int lane) { x += shx(x, lane, 32); x += shx(x, lane, 16); x += shx(x, lane, 8); x += shx(x, lane, 4); x += shx(x, lane, 2); x += shx(x, lane, 1); return x; }
__device__ __forceinline__ float red8(float x, int lane) { x += shx(x, lane, 1); x += shx(x, lane, 2); x += shx(x, lane, 4); return x; }
template <int CTRL> __device__ __forceinline__ float dppf(float x) { return __int_as_float(__builtin_amdgcn_update_dpp(0, __float_as_int(x), CTRL, 0xF, 0xF, true)); }
__device__ __forceinline__ float dred8(float x) { x += dppf<0xB1>(x); x += dppf<0x4E>(x); x += dppf<0x141>(x); return x; }
__device__ __forceinline__ int cond_of_row(int r) { return r < 4096 ? 0 : 1 + ((r - 4096) >> 10); }

template <class F>
__device__ __forceinline__ int conv_tiles(const Ctx& c, F colptr, int ld, bf16_t* dst, int K, int N, int base) {
    LAS float* tile = (LAS float*)c.lds;
    const int nkt = K / 64, ntl = (N / 256) * nkt;
    int first = (c.bid - (base % c.G) + c.G) % c.G;
    for (int tl = first; tl < ntl; tl += c.G) {
        const int n0 = (tl / nkt) * 256, k0 = (tl % nkt) * 64;
        const int n4 = c.lane * 4;
        const float* p = colptr(n0 + n4);
        f32x4 v[8];
#pragma unroll
        for (int j = 0; j < 8; ++j) { const int k = c.wid + 8 * j; v[j] = p ? *(const f32x4*)(p + (size_t)(k0 + k) * ld) : (f32x4){0.f, 0.f, 0.f, 0.f}; }
#pragma unroll
        for (int j = 0; j < 8; ++j) { const int k = c.wid + 8 * j; LAS float* t = tile + k * 257 + n4; t[0] = v[j][0]; t[1] = v[j][1]; t[2] = v[j][2]; t[3] = v[j][3]; }
        __syncthreads();
        const int kc = c.tid & 7, nn0 = c.tid >> 3;
#pragma unroll
        for (int j = 0; j < 4; ++j) { const int n = nn0 + 64 * j; float f[8];
#pragma unroll
            for (int i = 0; i < 8; ++i) f[i] = tile[(kc * 8 + i) * 257 + n];
            *(u32x4*)(dst + (size_t)(n0 + n) * K + k0 + kc * 8) = pack8(f); }
        __syncthreads();
    }
    return base + ntl;
}
struct ColGU { const float* g; const float* u; __device__ const float* operator()(int n) const { const int pn = n >> 8, bj = (n >> 7) & 1, i = n & 127; return g + (u - g) * (long)bj + pn * 128 + i; } };
struct ColPlain { const float* w; int nvalid; __device__ const float* operator()(int n) const { return n < nvalid ? w + n : nullptr; } };

__device__ __forceinline__ int convert_ffn(const Ctx& c, int l, int f, int base) {
    const size_t o = ((size_t)l * 2 + f) * 1024 * 2816;
    base = conv_tiles(c, ColGU{c.in[10] + o, c.in[11] + o}, DFF, c.WGU_(), 1024, 5632, base);
    return conv_tiles(c, ColPlain{c.in[12] + o, 1024}, 1024, c.WD_(), DFF, 1024, base);
}
__device__ __forceinline__ void convert_mixer(const Ctx& c, int l, int base) {
    base = conv_tiles(c, ColPlain{c.in[13] + (size_t)l * 1024 * NIN, NIN}, NIN, c.WIN_(), 1024, NPROJ, base);
    base = conv_tiles(c, ColPlain{c.in[20] + (size_t)l * 512 * 1024, 1024}, 1024, c.WBO_(), 512, 1024, base);
    base = conv_tiles(c, ColPlain{c.in[24] + (size_t)l * 512 * 1024, 1024}, 1024, c.WBO_() + 1024 * 512, 512, 1024, base);
    base = conv_tiles(c, ColPlain{c.in[36] + (size_t)l * 512 * 1024, 1024}, 1024, c.WBO_() + 2 * 1024 * 512, 512, 1024, base);
    base = conv_tiles(c, ColPlain{c.in[37] + (size_t)l * 1024 * 1024, 1024}, 1024, c.WOUT_(), 1024, 1024, base);
    const float* w2 = c.in[27] + (size_t)l * 2 * 64 * 512; const float* a2 = c.in[29] + (size_t)l * 64 * 512; const float* g2 = c.in[30] + (size_t)l * 128 * 512; const float* gk = c.in[21] + (size_t)l * 2 * 16 * 256;
    for (int i = c.bid * NT + c.tid; i < NSM * KSM; i += c.G * NT) {
        const int n = i / KSM, k = i % KSM; float v = 0.f;
        if (n < 512) { if (k < 64) v = w2[k * 512 + n]; }
        else if (n < 1024) { if (k >= 64 && k < 128) v = w2[64 * 512 + (k - 64) * 512 + (n - 512)]; }
        else if (n < 1536) { if (k >= 128 && k < 192) v = a2[(k - 128) * 512 + (n - 1024)]; }
        else if (n < 2048) { if (k >= 192 && k < 320) v = g2[(k - 192) * 512 + (n - 1536)]; }
        else if (n < 2304) { if (k >= 320 && k < 336) v = gk[(k - 320) * 256 + (n - 2048)]; }
        else { if (k >= 336 && k < 352) v = gk[16 * 256 + (k - 336) * 256 + (n - 2304)]; }
        c.WSM_()[i] = f2bf(v);
    }
}

__device__ void phase_init(const Ctx& c) {
    const float* xp = c.in[0]; const float* xs = c.in[1];
    for (int i = c.bid * NT + c.tid; i < T * D / 4; i += c.G * NT) {
        const int r = i >> 8, c4 = (i & 255) * 4;
        f32x4 v;
        if (r < 4096) v = *(const f32x4*)(xp + (size_t)r * D + c4);
        else {
            v = *(const f32x4*)(xs + (size_t)(r - 4096) * D + c4);
            const int t = (r - 4096) & 1023, gr = t >> 6, gc = t & 63;
#pragma unroll
            for (int j = 0; j < 4; ++j) { const int cc = c4 + j, seg = cc >> 8, ii = cc & 255;
                const float omega = __expf(-(float)ii * (9.210340371976184f / 256.0f)); const float ang = (float)(seg < 2 ? gr : gc) * omega;
                v[j] += (seg & 1) ? __cosf(ang) : __sinf(ang); }
        }
        *(f32x4*)(c.X_() + (size_t)r * D + c4) = v;
    }
    LAS float* sc = (LAS float*)c.lds;
    LAS float* red = sc + 5 * 1024;
    for (int i = c.tid; i < 5 * 1024; i += NT) { const int cd = i >> 10, k = i & 1023; const float x = cd == 0 ? c.in[6][k] : c.in[5][(cd - 1) * 1024 + k]; sc[i] = siluf_(x); }
    __syncthreads();
    for (int it = c.bid; it < 288; it += c.G) {
        const int l = it / 144, n0 = (it % 144) * 64, col = c.tid & 63, kg = c.tid >> 6;
        const float* w = c.in[8] + (size_t)l * 1024 * 9216 + n0 + col;
        float a0 = 0.f, a1 = 0.f, a2 = 0.f, a3 = 0.f, a4 = 0.f;
#pragma unroll 16
        for (int k = kg * 128; k < kg * 128 + 128; ++k) { const float wv = w[(size_t)k * 9216]; a0 += sc[k] * wv; a1 += sc[1024 + k] * wv; a2 += sc[2048 + k] * wv; a3 += sc[3072 + k] * wv; a4 += sc[4096 + k] * wv; }
        red[(kg * 5 + 0) * 64 + col] = a0; red[(kg * 5 + 1) * 64 + col] = a1; red[(kg * 5 + 2) * 64 + col] = a2; red[(kg * 5 + 3) * 64 + col] = a3; red[(kg * 5 + 4) * 64 + col] = a4;
        __syncthreads();
        if (c.tid < 320) { const int cd = c.tid >> 6, cl = c.tid & 63; float s = c.in[9][l * 9216 + n0 + cl];
#pragma unroll
            for (int g = 0; g < 8; ++g) s += red[(g * 5 + cd) * 64 + cl];
            c.ADA_()[(l * 5 + cd) * 9216 + n0 + cl] = s; }
        __syncthreads();
    }
}

__device__ void phase_norm(const Ctx& c, int l, int which, bool addP) {
    const bf16_t* P = c.OUTS_();
    const float* g = c.in[7] + (l * 3 + which) * 1024;
    for (int r = c.gw; r < T; r += c.NW) {
        float* xr = c.X_() + (size_t)r * D; f32x4 v[4]; float ss = 0.f;
#pragma unroll
        for (int j = 0; j < 4; ++j) { v[j] = __builtin_nontemporal_load((const f32x4*)(xr + (c.lane + 64 * j) * 4)); if (addP) { const u32x2 pw = __builtin_nontemporal_load((const u32x2*)(P + (size_t)r * D + (c.lane + 64 * j) * 4)), pv = __builtin_nontemporal_load((const u32x2*)(P + (size_t)T * D + (size_t)r * D + (c.lane + 64 * j) * 4)); v[j] = v[j] + ((f32x4){bflo(pw.x), bfhi(pw.x), bflo(pw.y), bfhi(pw.y)} + (f32x4){bflo(pv.x), bfhi(pv.x), bflo(pv.y), bfhi(pv.y)}); __builtin_nontemporal_store(v[j], (f32x4*)(xr + (c.lane + 64 * j) * 4)); } ss += v[j][0] * v[j][0] + v[j][1] * v[j][1] + v[j][2] * v[j][2] + v[j][3] * v[j][3]; }
        ss = wave_sum(ss, c.lane); const float rs = rsqrtf(ss * (1.0f / 1024.0f) + 1e-6f);
        const float* sh = c.ADA_() + (l * 5 + cond_of_row(r)) * 9216 + (which * 3) * 1024; const float* scl = sh + 1024;
#pragma unroll
        for (int j = 0; j < 4; ++j) { const int cc = (c.lane + 64 * j) * 4; const f32x4 gg = *(const f32x4*)(g + cc), s1 = *(const f32x4*)(scl + cc), s0 = *(const f32x4*)(sh + cc);
            const f32x4 o = v[j] * rs * gg * (s1 + 1.0f) + s0; u32x2 w; w.x = cvt_pk_bf16(o[0], o[1]); w.y = cvt_pk_bf16(o[2], o[3]); *(u32x2*)(c.H_() + (size_t)r * D + cc) = w; }
    }
}
__device__ void phase_final_norm(const Ctx& c) {
    const float* g = c.in[38]; const bf16_t* P = c.OUTS_();
    for (int r = c.gw; r < T; r += c.NW) {
        float* xr = c.X_() + (size_t)r * D; f32x4 v[4]; float ss = 0.f;
#pragma unroll
        for (int j = 0; j < 4; ++j) { const u32x2 pw = *(const u32x2*)(P + (size_t)r * D + (c.lane + 64 * j) * 4), pv = *(const u32x2*)(P + (size_t)T * D + (size_t)r * D + (c.lane + 64 * j) * 4); v[j] = *(const f32x4*)(xr + (c.lane + 64 * j) * 4) + ((f32x4){bflo(pw.x), bfhi(pw.x), bflo(pw.y), bfhi(pw.y)} + (f32x4){bflo(pv.x), bfhi(pv.x), bflo(pv.y), bfhi(pv.y)}); ss += v[j][0] * v[j][0] + v[j][1] * v[j][1] + v[j][2] * v[j][2] + v[j][3] * v[j][3]; }
        ss = wave_sum(ss, c.lane); const float rs = rsqrtf(ss * (1.0f / 1024.0f) + 1e-6f);
#pragma unroll
        for (int j = 0; j < 4; ++j) { const int cc = (c.lane + 64 * j) * 4; *(f32x4*)(xr + cc) = v[j] * rs * *(const f32x4*)(g + cc); }
    }
}

struct EpiGU { static constexpr bool PERM = true, AFTER_DRAIN = false; bf16_t* O;
    __device__ __forceinline__ void operator()(const f32x4 (&acc)[2][2][4][2], const pg8::Unit& u, int wr, int wc, int fr, int fq) const {
        const int row0 = u.pm * 256 + wr * 64 + fr, col0 = u.pn * 128 + wc * 32 + 8 * fq;
#pragma unroll
        for (int ai = 0; ai < 2; ++ai)
#pragma unroll
            for (int m = 0; m < 4; ++m) { float o[8];
#pragma unroll
                for (int n = 0; n < 2; ++n)
#pragma unroll
                    for (int j = 0; j < 4; ++j) o[n * 4 + j] = siluf_(acc[ai][0][m][n][j]) * acc[ai][1][m][n][j];
                *(u32x4*)(O + (size_t)(row0 + ai * 128 + m * 16) * DFF + col0) = pack8(o); }
    } };
struct EpiResid { static constexpr bool PERM = false, AFTER_DRAIN = false; bf16_t* P; const float* gate; float s;
    __device__ __forceinline__ void operator()(const f32x4 (&acc)[2][2][4][2], const pg8::Unit& u, int wr, int wc, int fr, int fq) const {
        const int pn = u.pn & 3, kh = u.pn >> 2;
        const int row0 = u.pm * 256 + wr * 64 + fr, col0 = pn * 256 + wc * 32 + 4 * fq; const int cd = cond_of_row(u.pm * 256);
        f32x4 gv[2][2];
#pragma unroll
        for (int bj = 0; bj < 2; ++bj)
#pragma unroll
            for (int n = 0; n < 2; ++n) gv[bj][n] = *(const f32x4*)(gate + cd * 9216 + col0 + bj * 128 + n * 16) * s;
        bf16_t* base = P + (size_t)kh * T * D;
#pragma unroll
        for (int ai = 0; ai < 2; ++ai)
#pragma unroll
            for (int m = 0; m < 4; ++m) { const size_t off = (size_t)(row0 + ai * 128 + m * 16) * D + col0;
#pragma unroll
                for (int bj = 0; bj < 2; ++bj)
#pragma unroll
                    for (int n = 0; n < 2; ++n) { const f32x4 v = acc[ai][bj][m][n] * gv[bj][n]; u32x2 w; w.x = cvt_pk_bf16(v[0], v[1]); w.y = cvt_pk_bf16(v[2], v[3]); *(u32x2*)(base + off + bj * 128 + n * 16) = w; } }
    } };
struct EpiProj { static constexpr bool PERM = true, AFTER_DRAIN = false; bf16_t* O; int ldc;
    __device__ __forceinline__ void operator()(const f32x4 (&acc)[2][2][4][2], const pg8::Unit& u, int wr, int wc, int fr, int fq) const {
        const int row0 = u.pm * 256 + wr * 64 + fr, col0 = u.pn * 256 + wc * 32 + 8 * fq;
#pragma unroll
        for (int ai = 0; ai < 2; ++ai)
#pragma unroll
            for (int m = 0; m < 4; ++m) { bf16_t* rowp = O + (size_t)(row0 + ai * 128 + m * 16) * ldc + col0;
#pragma unroll
                for (int bj = 0; bj < 2; ++bj) { const f32x4 v0 = acc[ai][bj][m][0], v1 = acc[ai][bj][m][1]; u32x4 w; w.x = cvt_pk_bf16(v0[0], v0[1]); w.y = cvt_pk_bf16(v0[2], v0[3]); w.z = cvt_pk_bf16(v1[0], v1[1]); w.w = cvt_pk_bf16(v1[2], v1[3]);
                    *(u32x4*)(rowp + bj * 128) = w; } }
    } };
struct EpiSmall { static constexpr bool PERM = true, AFTER_DRAIN = false; bf16_t* O; const float* w0; const float* a0; bf16_t* rwk; const bf16_t* rwkk; const float* ka;
    __device__ __forceinline__ void operator()(const f32x4 (&acc)[2][2][4][2], const pg8::Unit& u, int wr, int wc, int fr, int fq) const {
        const int row0 = u.pm * 256 + wr * 64 + fr, col0 = u.pn * 256 + wc * 32 + 8 * fq;
        const int kind = u.pn < 4 ? 0 : (u.pn < 6 ? 2 : 3);
        const float* bias = kind == 0 ? w0 : (kind == 2 ? a0 - 1024 : w0 - 1536);
        const float bsc = kind == 3 ? 0.f : 1.f;
#pragma unroll
        for (int bj = 0; bj < 2; ++bj) { const int cc = col0 + bj * 128; const f32x4 b0 = *(const f32x4*)(bias + cc) * bsc, b1 = *(const f32x4*)(bias + cc + 4) * bsc;
#pragma unroll
            for (int ai = 0; ai < 2; ++ai)
#pragma unroll
                for (int m = 0; m < 4; ++m) { const size_t row = row0 + ai * 128 + m * 16; const f32x4 x0 = acc[ai][bj][m][0] + b0, x1 = acc[ai][bj][m][1] + b1; float o[8];
#pragma unroll
                    for (int j = 0; j < 8; ++j) { const float x = j < 4 ? x0[j & 3] : x1[j & 3];
                        const float sg = __builtin_amdgcn_rcpf(1.0f + __expf(-x));
                        const float y01 = 1.0f - __expf(-sg * 0.60653066f);
                        o[j] = kind == 0 ? y01 : (kind == 2 ? sg : x); }
                    if (kind == 2) { float kv[8], kkv[8]; bf16_t* kp = rwk + row * 512 + (cc - 1024); unpack8(*(const u32x4*)kp, kv); unpack8(*(const u32x4*)(rwkk + row * 512 + (cc - 1024)), kkv);
                        const f32x4 ka0 = *(const f32x4*)(ka + cc - 1024), ka1 = *(const f32x4*)(ka + cc - 1024 + 4);
#pragma unroll
                        for (int j = 0; j < 8; ++j) { const float av = o[j], kaj = j < 4 ? ka0[j & 3] : ka1[j & 3]; kv[j] = kv[j] * (1.0f + (av - 1.0f) * kaj); o[j] = kkv[j] * av; }
                        *(u32x4*)kp = pack8(kv); }
                    *(u32x4*)(O + row * NSM + cc) = pack8(o); }
            asm volatile("" ::: "memory"); }
    } };
struct EpiBranch { static constexpr bool PERM = true, AFTER_DRAIN = false; bf16_t* M; const bf16_t* gates;
    __device__ __forceinline__ void operator()(const f32x4 (&acc)[2][2][4][2], const pg8::Unit& u, int wr, int wc, int fr, int fq) const {
        int upm = u.pm, upn = u.pn; asm volatile("" : "+s"(upm), "+s"(upn));
        const int b = upn >> 2, pn = upn & 3; const float keep = b ? 1.0f : 0.0f;
        const int row0 = upm * 256 + wr * 64 + fr, col0 = pn * 256 + wc * 32 + 8 * fq; const bf16_t* gb = gates + b * 1024;
#pragma unroll
        for (int ai = 0; ai < 2; ++ai)
#pragma unroll
            for (int m = 0; m < 4; ++m) { const int row = row0 + ai * 128 + m * 16;
#pragma unroll
                for (int bj = 0; bj < 2; ++bj) { const int cc = col0 + bj * 128; float gt[8], o[8];
                    unpack8(*(const u32x4*)(gb + (size_t)row * NPROJ + cc), gt);
                    bf16_t* mp = M + (size_t)row * D + cc;
                    unpack8(*(const u32x4*)mp, o);
#pragma unroll
                    for (int j = 0; j < 8; ++j) o[j] = o[j] * keep + sigmoidf_(gt[j]) * acc[ai][bj][m][j >> 2][j & 3];
                    *(u32x4*)mp = pack8(o); }
                asm volatile("" ::: "memory"); }
    } };

#ifndef GP_ALIGN
#define GP_ALIGN true
#endif
#ifndef GP_SP2
#define GP_SP2 true
#endif
template <class Epi>
__device__ __forceinline__ void run_gemm(const Ctx& c, const bf16_t* A, const bf16_t* Bt, int N, int K, const Epi& E, int ksplit = 1) {
    int Kl = K / ksplit; asm volatile("" : "+s"(Kl));
    pg8::Gemm g{A, Bt, T, N * ksplit, Kl, K, N / 256, (size_t)Kl * 2, (size_t)Kl * 2}; pg8::StaticOrder S; S.init(T, N * ksplit, c.G, c.bid);
    pg8::gemm_phase<Epi, pg8::StaticOrder, GP_ALIGN, GP_SP2>(c.lds, g, S, E);
}

struct BranchOrder { int c;
    __device__ bool next(int i, pg8::Unit& u) const { if (c >= 128 || i >= 3) return false; u.pm = c >> 2; u.pn = (c & 3) + 4 * i; return true; }
    __device__ __forceinline__ void a_ready(const pg8::Unit&) const {}
    __device__ __forceinline__ void done(const pg8::Unit&) const {}
};
__device__ __forceinline__ void ldf8(const float* p, float* f) { const f32x4 a = *(const f32x4*)p, b = *(const f32x4*)(p + 4); f[0] = a[0]; f[1] = a[1]; f[2] = a[2]; f[3] = a[3]; f[4] = b[0]; f[5] = b[1]; f[6] = b[2]; f[7] = b[3]; }
__device__ void phase_prepass(const Ctx& c, int l) {
    const float* cw = c.in[14] + l * 3 * 768; const float* cb = c.in[15] + l * 768; const float* dtb = c.in[16] + l * 16;
    const float* mu = c.in[25] + l * 1856; const float* rkk = c.in[31] + l * 512; const float* gkw = c.in[21] + l * 2 * 16 * 256; const float* gkb = c.in[22] + l * 512;
    const int lane = c.lane;
    for (int r = c.gw; r < T; r += c.NW) {
        int t, L; if (r < 4096) { t = r & 255; L = 256; } else { t = (r - 4096) & 1023; L = 1024; }
        const bool hp = t > 0, hn = t < L - 1;
        const bf16_t* p0 = c.PROJ_() + (size_t)r * NPROJ; const bf16_t* pm = hp ? p0 - NPROJ : p0; const bf16_t* pn = hn ? p0 + NPROJ : p0;
        const float fp = hp ? 1.f : 0.f, fn = hn ? 1.f : 0.f;
#pragma unroll
        for (int it = 0; it < 2; ++it) { const int g = lane + 64 * it; if (g < 96) { const int cc = g * 8; float x0[8], xm[8], xn[8], w0[8], w1[8], w2[8], bb[8], o[8];
            unpack8(*(const u32x4*)(p0 + 512 + cc), x0); unpack8(*(const u32x4*)(pm + 512 + cc), xm); unpack8(*(const u32x4*)(pn + 512 + cc), xn);
            ldf8(cw + cc, w0); ldf8(cw + 768 + cc, w1); ldf8(cw + 1536 + cc, w2); ldf8(cb + cc, bb);
#pragma unroll
            for (int j = 0; j < 8; ++j) o[j] = siluf_(bb[j] + w0[j] * xm[j] * fp + w1[j] * x0[j] + w2[j] * xn[j] * fn);
            *(u32x4*)(c.XBC_() + (size_t)r * 768 + cc) = pack8(o); } }
        if (lane < 16) c.DT_()[r * 16 + lane] = softplusf_(bf2f(p0[1280 + lane]) + dtb[lane]);
#pragma unroll
        for (int it = 0; it < 4; ++it) { const int g = lane + 64 * it; if (g < 232) { const int cc = g * 8; float x0[8], xm[8], xn[8], m8[8], o[8];
            unpack8(*(const u32x4*)(p0 + C_RW + cc), x0); unpack8(*(const u32x4*)(pm + C_RW + cc), xm); unpack8(*(const u32x4*)(pn + C_RW + cc), xn); ldf8(mu + cc, m8);
#pragma unroll
            for (int j = 0; j < 8; ++j) o[j] = x0[j] + (0.5f * (xm[j] * fp + xn[j] * fn) - x0[j]) * m8[j];
            if (it == 0) *(u32x4*)(c.RWR_() + (size_t)r * 512 + cc) = pack8(o);
            else if (it == 1) { const int ck = cc - 512; *(u32x4*)(c.RWK_() + (size_t)r * 512 + ck) = pack8(o); float kw[8], kq[8]; ldf8(rkk + ck, kw); float ss = 0.f;
#pragma unroll
                for (int j = 0; j < 8; ++j) { kq[j] = o[j] * kw[j]; ss += kq[j] * kq[j]; }
                ss = dred8(ss); const float inv = 1.0f / fmaxf(sqrtf(ss), 1e-12f);
#pragma unroll
                for (int j = 0; j < 8; ++j) kq[j] *= inv;
                *(u32x4*)(c.RWKK_() + (size_t)r * 512 + ck) = pack8(kq); }
            else if (it == 2) *(u32x4*)(c.RWV_() + (size_t)r * 512 + (cc - 1024)) = pack8(o);
            else { const int cl = cc - 1536;
#pragma unroll
                for (int j = 0; j < 8; ++j) { const float e2 = __expf(2.0f * o[j]); const float th = 1.0f - 2.0f / (1.0f + e2); const float sg = sigmoidf_(o[j]); o[j] = cl < 128 ? th : (cl < 192 ? o[j] : sg); }
                *(u32x4*)(c.LOWA_() + (size_t)r * KSM + cl) = pack8(o); } } }
        if (lane < 8) { unsigned z = 0u; asm volatile("" : "+v"(z)); *(u32x4*)(c.LOWA_() + (size_t)r * KSM + 320 + lane * 8) = (u32x4){z, z, z, z}; }
        {
            const int d = lane >> 5, cg = lane & 31; const float* gwp = gkw + d * 16 * 256 + cg * 8; float lr[16], acc[8];
            unpack8(*(const u32x4*)(p0 + C_GLA + 1536 + d * 16), lr); unpack8(*(const u32x4*)(p0 + C_GLA + 1536 + d * 16 + 8), lr + 8); ldf8(gkb + d * 256 + cg * 8, acc);
#pragma unroll
            for (int i = 0; i < 16; ++i) { float w[8]; ldf8(gwp + i * 256, w);
#pragma unroll
                for (int j = 0; j < 8; ++j) acc[j] += lr[i] * w[j]; }
#pragma unroll
            for (int j = 0; j < 8; ++j) acc[j] = 1.0f - __expf(softplusf_(-acc[j]) * (-1.0f / 16.0f));
            *(u32x4*)(c.SMALL_() + (size_t)r * NSM + 2048 + d * 256 + cg * 8) = pack8(acc); }
    }
}

struct SeqInfo { int L, row0, b, ctx; };
__device__ __forceinline__ SeqInfo seq_info(int s) { SeqInfo q; if (s < 16) { q.L = 256; q.row0 = s * 256; q.b = s; q.ctx = 1; } else { q.L = 1024; q.row0 = 4096 + (s - 16) * 1024; q.b = s - 16; q.ctx = 0; } return q; }

#ifndef PF_SSD
#define PF_SSD 8
#endif
#ifndef PF_GLA
#define PF_GLA 4
#endif
#ifndef PF_RW
#define PF_RW 2
#endif
__device__ __forceinline__ u32x4 ldu16(const bf16_t* ub, unsigned lo) { return *(const u32x4*)((const char*)ub + lo); }
__device__ __forceinline__ bf16_t ldu2(const bf16_t* ub, unsigned lo) { return *(const bf16_t*)((const char*)ub + lo); }
__device__ __forceinline__ float sel8(const float (&y)[8], int k) { float v = y[0]; v = k == 1 ? y[1] : v; v = k == 2 ? y[2] : v; v = k == 3 ? y[3] : v; v = k == 4 ? y[4] : v; v = k == 5 ? y[5] : v; v = k == 6 ? y[6] : v; v = k == 7 ? y[7] : v; return v; }

constexpr int REC = 336;
__device__ __forceinline__ void st8(LAS float* p, const u32x4 w) { float f[8]; unpack8(w, f); *(LAS f32x4*)p = (f32x4){f[0], f[1], f[2], f[3]}; *(LAS f32x4*)(p + 4) = (f32x4){f[4], f[5], f[6], f[7]}; }
__device__ __forceinline__ void ld8(const LAS float* p, float* f) { const f32x4 a = *(const LAS f32x4*)p, b = *(const LAS f32x4*)(p + 4); f[0] = a[0]; f[1] = a[1]; f[2] = a[2]; f[3] = a[3]; f[4] = b[0]; f[5] = b[1]; f[6] = b[2]; f[7] = b[3]; }

__device__ void scan_ssd(const Ctx& c, int l, int s, int dir, int hp) {
    const SeqInfo q = seq_info(s); const int h = hp * 2 + (c.wid >> 2), w4 = c.wid & 3, lane = c.lane, r = lane >> 3, p0 = w4 * 16 + r, np = lane & 7, g = h >> 2;
    float S[2][8];
#pragma unroll
    for (int e = 0; e < 2; ++e) {
        if (!q.ctx) { const float* st = c.in[2] + ((((size_t)q.b * 2 + l) * 2 + dir) * 8 + h) * 4096 + (p0 + 8 * e) * 64 + np * 8; const f32x4 a = *(const f32x4*)st, b = *(const f32x4*)(st + 4);
            S[e][0] = a[0]; S[e][1] = a[1]; S[e][2] = a[2]; S[e][3] = a[3]; S[e][4] = b[0]; S[e][5] = b[1]; S[e][6] = b[2]; S[e][7] = b[3]; }
        else {
#pragma unroll
            for (int j = 0; j < 8; ++j) S[e][j] = 0.f; } }
    const float adh = -__expf(c.in[17][l * 16 + dir * 8 + h]) * 1.44269504f;
    const long sgn = dir ? -1 : 1; const size_t rbase = (size_t)q.row0 + (dir ? q.L - 1 : 0);
    LAS float* lb = (LAS float*)c.lds + c.wid * (8 * REC); LAS float* wr = lb + r * REC + np * 8; const LAS float* rd = lb + np * 8;
    const char* gX = (const char*)(c.XBC_() + (rbase + sgn * r) * 768); const float* gD = c.DT_() + (rbase + sgn * r) * 16 + dir * 8 + h; const long cX = sgn * 8 * 768 * 2, cD = sgn * 8 * 16;
    const unsigned loB = (512 + g * 64 + np * 8) * 2, loX = (h * 64 + w4 * 16 + np) * 2;
    bf16_t* O = c.OUTS_() + (size_t)(0 * 2 + dir) * T * DMIX + (rbase + sgn * np) * DMIX + h * 64 + p0;
    u32x4 nB, nC; bf16_t nx0, nx1; float ndt;
#define SSD_LOAD() { nB = *(const u32x4*)(gX + loB); nC = *(const u32x4*)(gX + loB + 256); nx0 = *(const bf16_t*)(gX + loX); nx1 = *(const bf16_t*)(gX + loX + 16); ndt = *gD; gX += cX; gD += cD; }
#define SSD_STORE() { st8(wr, nB); st8(wr + 64, nC); lb[r * REC + 128 + np] = bf2f(nx0); lb[r * REC + 136 + np] = bf2f(nx1); lb[r * REC + 144] = ndt; }
    SSD_LOAD(); SSD_STORE();
    for (int i0 = 0; i0 < q.L; i0 += 8) {
        SSD_LOAD();
        float out0 = 0.f, out1 = 0.f;
#pragma unroll
        for (int j = 0; j < 8; ++j) {
            float B[8], C[8]; ld8(rd + j * REC, B); ld8(rd + j * REC + 64, C); const float x0 = lb[j * REC + 128 + r], x1 = lb[j * REC + 136 + r], dtv = lb[j * REC + 144];
            const float da = __builtin_amdgcn_exp2f(dtv * adh), xd0 = x0 * dtv, xd1 = x1 * dtv; float ya = 0.f, yb = 0.f, za = 0.f, zb = 0.f;
#pragma unroll
            for (int k = 0; k < 8; k += 2) {
                S[0][k] = da * S[0][k] + xd0 * B[k]; S[0][k + 1] = da * S[0][k + 1] + xd0 * B[k + 1]; ya += S[0][k] * C[k]; yb += S[0][k + 1] * C[k + 1];
                S[1][k] = da * S[1][k] + xd1 * B[k]; S[1][k + 1] = da * S[1][k + 1] + xd1 * B[k + 1]; za += S[1][k] * C[k]; zb += S[1][k + 1] * C[k + 1]; }
            { const float yv = dred8(ya + yb), zv = dred8(za + zb); out0 = (np == j) ? yv : out0; out1 = (np == j) ? zv : out1; }
        }
        O[0] = f2bf(out0); O[8] = f2bf(out1); O += sgn * 8 * DMIX;
        SSD_STORE();
    }
    if (q.ctx) {
#pragma unroll
        for (int e = 0; e < 2; ++e) { int ln = lane; asm volatile("" : "+v"(ln)); float* o = c.out + OUT_SSD + ((((size_t)q.b * 2 + l) * 2 + dir) * 8 + h) * 4096 + (w4 * 16 + (ln >> 3) + 8 * e) * 64 + (ln & 7) * 8; *(f32x4*)o = (f32x4){S[e][0], S[e][1], S[e][2], S[e][3]}; *(f32x4*)(o + 4) = (f32x4){S[e][4], S[e][5], S[e][6], S[e][7]}; } }
}

__device__ void scan_gla(const Ctx& c, int l, int s, int dir, int h) {
    const SeqInfo q = seq_info(s); const int lane = c.lane, r = lane >> 3, v0 = c.wid * 16 + r, kp = lane & 7;
    float S[2][8];
#pragma unroll
    for (int e = 0; e < 2; ++e) {
        if (!q.ctx) { const float* st = c.in[3] + (((((size_t)q.b * 2 + l) * 2 + dir) * 4 + h) * 64 + kp * 8) * 128 + v0 + 8 * e;
#pragma unroll
            for (int j = 0; j < 8; ++j) S[e][j] = st[j * 128]; }
        else {
#pragma unroll
            for (int j = 0; j < 8; ++j) S[e][j] = 0.f; } }
    const long sgn = dir ? -1 : 1; const size_t rbase = (size_t)q.row0 + (dir ? q.L - 1 : 0);
    LAS float* lb = (LAS float*)c.lds + c.wid * (8 * REC); LAS float* wr = lb + r * REC + kp * 8; const LAS float* rd = lb + kp * 8;
    const char* gP = (const char*)(c.PROJ_() + (rbase + sgn * r) * NPROJ); const char* gS = (const char*)(c.SMALL_() + (rbase + sgn * r) * NSM); const long cP = sgn * 8 * NPROJ * 2, cS = sgn * 8 * NSM * 2;
    const unsigned loQ = (C_GLA + h * 64 + kp * 8) * 2, loV = (C_GLA + 512 + h * 128 + c.wid * 16 + kp) * 2, loG = (2048 + dir * 256 + h * 64 + kp * 8) * 2;
    bf16_t* O = c.OUTS_() + (size_t)(1 * 2 + dir) * T * DMIX + (rbase + sgn * kp) * DMIX + h * 128 + v0;
    u32x4 nQ, nK, nG; bf16_t nv0, nv1;
#define GLA_LOAD() { nQ = *(const u32x4*)(gP + loQ); nK = *(const u32x4*)(gP + loQ + 512); nG = *(const u32x4*)(gS + loG); nv0 = *(const bf16_t*)(gP + loV); nv1 = *(const bf16_t*)(gP + loV + 16); gP += cP; gS += cS; }
#define GLA_STORE() { st8(wr, nQ); st8(wr + 64, nK); st8(wr + 128, nG); lb[r * REC + 192 + kp] = bf2f(nv0); lb[r * REC + 200 + kp] = bf2f(nv1); }
    GLA_LOAD(); GLA_STORE();
    for (int i0 = 0; i0 < q.L; i0 += 8) {
        GLA_LOAD();
        float out0 = 0.f, out1 = 0.f;
#pragma unroll 4
        for (int j = 0; j < 8; ++j) {
            float Q[8], K[8], G[8]; ld8(rd + j * REC, Q); ld8(rd + j * REC + 64, K); ld8(rd + j * REC + 128, G); const float va = lb[j * REC + 192 + r], vb = lb[j * REC + 200 + r];
            float oa = 0.f, ob = 0.f, pa = 0.f, pb = 0.f;
#pragma unroll
            for (int k = 0; k < 8; k += 2) {
                S[0][k] = (S[0][k] - S[0][k] * G[k]) + K[k] * va; S[0][k + 1] = (S[0][k + 1] - S[0][k + 1] * G[k + 1]) + K[k + 1] * va; oa += Q[k] * S[0][k]; ob += Q[k + 1] * S[0][k + 1];
                S[1][k] = (S[1][k] - S[1][k] * G[k]) + K[k] * vb; S[1][k + 1] = (S[1][k + 1] - S[1][k + 1] * G[k + 1]) + K[k + 1] * vb; pa += Q[k] * S[1][k]; pb += Q[k + 1] * S[1][k + 1]; }
            { const float yv = dred8(oa + ob), zv = dred8(pa + pb); out0 = (kp == j) ? yv : out0; out1 = (kp == j) ? zv : out1; }
        }
        O[0] = f2bf(out0 * 0.125f); O[8] = f2bf(out1 * 0.125f); O += sgn * 8 * DMIX;
        GLA_STORE();
    }
    if (q.ctx) {
#pragma unroll
        for (int e = 0; e < 2; ++e) { int ln = lane; asm volatile("" : "+v"(ln)); float* o = c.out + OUT_GLA + (((((size_t)q.b * 2 + l) * 2 + dir) * 4 + h) * 64 + (ln & 7) * 8) * 128 + c.wid * 16 + (ln >> 3) + 8 * e;
#pragma unroll
            for (int j = 0; j < 8; ++j) o[j * 128] = S[e][j]; } }
}

__device__ void scan_rwkv(const Ctx& c, int l, int s, int dir, int hs) {
    const SeqInfo q = seq_info(s); const int h = hs >> 3, rg = hs & 7, lane = c.lane, r = lane >> 3, vr = rg * 8 + r, kp = lane & 7;
    float S[8];
    if (!q.ctx) { const float* st = c.in[4] + ((((size_t)q.b * 2 + l) * 2 + dir) * 8 + h) * 4096 + vr * 64 + kp * 8; const f32x4 a = *(const f32x4*)st, b = *(const f32x4*)(st + 4);
        S[0] = a[0]; S[1] = a[1]; S[2] = a[2]; S[3] = a[3]; S[4] = b[0]; S[5] = b[1]; S[6] = b[2]; S[7] = b[3]; }
    else {
#pragma unroll
        for (int j = 0; j < 8; ++j) S[j] = 0.f; }
    const long sgn = dir ? -1 : 1; const size_t rbase = (size_t)q.row0 + (dir ? q.L - 1 : 0);
    constexpr size_t AS2 = (size_t)T * DMIX * 2;
    LAS float* lb = (LAS float*)c.lds + c.wid * (8 * REC); LAS float* wr = lb + r * REC + kp * 8; const LAS float* rd = lb + kp * 8;
    const char* gR = (const char*)(c.RWR_() + (rbase + sgn * r) * 512 + h * 64 + kp * 8); const char* gS = (const char*)(c.SMALL_() + (rbase + sgn * r) * NSM + h * 64 + kp * 8);
    const char* gV = (const char*)(c.RWV_() + (rbase + sgn * r) * 512 + h * 64 + rg * 8 + kp); const long cR = sgn * 8 * 512 * 2, cS = sgn * 8 * NSM * 2;
    const unsigned loW = dir * 1024;
    bf16_t* O = c.OUTS_() + (size_t)(2 * 2 + dir) * T * DMIX + (rbase + sgn * kp) * DMIX + h * 64 + vr;
    u32x4 nR, nK, nKK, nA, nW; bf16_t nv;
#define RW_LOAD() { nR = *(const u32x4*)gR; nK = *(const u32x4*)(gR + AS2); nKK = *(const u32x4*)(gR + 3 * AS2); nA = *(const u32x4*)(gS + 2048); nW = *(const u32x4*)(gS + loW); nv = *(const bf16_t*)gV; gR += cR; gS += cS; gV += cR; }
#define RW_STORE() { st8(wr, nR); st8(wr + 64, nK); st8(wr + 128, nKK); st8(wr + 192, nA); st8(wr + 256, nW); lb[r * REC + 320 + kp] = bf2f(nv); }
    RW_LOAD(); RW_STORE();
    for (int i0 = 0; i0 < q.L; i0 += 8) {
        RW_LOAD();
        float outv = 0.f;
#pragma unroll 4
        for (int j = 0; j < 8; ++j) {
            float R[8], K[8], KK[8], A[8], W[8]; ld8(rd + j * REC, R); ld8(rd + j * REC + 64, K); ld8(rd + j * REC + 128, KK); ld8(rd + j * REC + 192, A); ld8(rd + j * REC + 256, W); const float vv = lb[j * REC + 320 + r];
            float s0 = 0.f, s1 = 0.f;
#pragma unroll
            for (int k = 0; k < 8; k += 2) { s0 += S[k] * KK[k]; s1 += S[k + 1] * KK[k + 1]; }
            const float skk = dred8(s0 + s1); float o0 = 0.f, o1 = 0.f;
#pragma unroll
            for (int k = 0; k < 8; k += 2) {
                S[k] = (S[k] - S[k] * W[k]) - skk * A[k] + vv * K[k]; S[k + 1] = (S[k + 1] - S[k + 1] * W[k + 1]) - skk * A[k + 1] + vv * K[k + 1];
                o0 += S[k] * R[k]; o1 += S[k + 1] * R[k + 1]; }
            { const float yv = dred8(o0 + o1); outv = (kp == j) ? yv : outv; }
        }
        *O = f2bf(outv); O += sgn * 8 * DMIX;
        RW_STORE();
    }
    if (q.ctx) { float* o = c.out + OUT_RWK + ((((size_t)q.b * 2 + l) * 2 + dir) * 8 + h) * 4096 + vr * 64 + kp * 8; *(f32x4*)o = (f32x4){S[0], S[1], S[2], S[3]}; *(f32x4*)(o + 4) = (f32x4){S[4], S[5], S[6], S[7]}; }
}

__device__ __forceinline__ void scan_item(const Ctx& c, int l, int id) {
    if (id < 320) { int n = id, s; if (n < 64) s = 16 + (n >> 4); else { n -= 64; s = n >> 4; }
        const int sub = n & 15; scan_rwkv(c, l, s, sub >> 3, (sub & 7) * 8 + c.wid); }
    else { const bool gla = id < 480; int m = gla ? id - 320 : id - 480, s; if (m < 32) s = 16 + (m >> 3); else { m -= 32; s = m >> 3; }
        const int sub = m & 7; if (gla) scan_gla(c, l, s, sub >> 2, sub & 3); else scan_ssd(c, l, s, sub >> 2, sub & 3); }
}
#define RW_L(n) (n)
#define RW_S(n) (64 + (n))
#define GLA_L(m) (320 + (m))
#define GLA_S(m) (320 + 32 + (m))
#define SSD_L(m) (480 + (m))
#define SSD_S(m) (480 + 32 + (m))
__device__ void phase_scan(const Ctx& c, int l) {
    const bool bal = c.G == 256; const int n = bal ? ((c.bid & 7) < 4 ? 1 : 4) : (640 - c.bid + c.G - 1) / c.G;
    for (int k = 0; k < n; ++k) {
        int bl = c.bid; asm volatile("" : "+s"(bl));
        const int cl = bl & 7, ix = bl >> 3, j = (cl - 4) * 32 + ix;
        const int id = !bal ? bl + k * c.G : (cl < 2 ? RW_L(ix * 2 + cl) : (cl == 2 ? GLA_L(ix) : (cl == 3 ? SSD_L(ix) : (k == 0 ? RW_S(2 * j) : (k == 1 ? RW_S(2 * j + 1) : (k == 2 ? GLA_S(j) : SSD_S(j)))))));
        scan_item(c, l, id);
    }
}

#ifndef PPT
#define PPT 1
#endif
__device__ void phase_postpass(const Ctx& c, int l) {
    const int lane = c.lane, c0 = lane * 8;
    const float* Dp = c.in[18] + l * 16; const float* snorm = c.in[19] + l * 512; const float* gnorm = c.in[23] + l * 128;
    const float* rk = c.in[33] + l * 512; const float* lnw = c.in[34] + l * 512; const float* lnb = c.in[35] + l * 512;
    constexpr size_t SL = (size_t)T * DMIX;
    for (int r0 = c.gw; r0 < T; r0 += PPT * c.NW) {
        u32x4 q[PPT][13];
#pragma unroll
        for (int e = 0; e < PPT; ++e) { const int r = min(r0 + e * c.NW, T - 1); const bf16_t* p0 = c.PROJ_() + (size_t)r * NPROJ; const bf16_t* of = c.OUTS_() + (size_t)r * DMIX + c0;
            q[e][0] = *(const u32x4*)of; q[e][1] = *(const u32x4*)(of + SL); q[e][2] = *(const u32x4*)(c.XBC_() + (size_t)r * 768 + c0); q[e][3] = *(const u32x4*)(p0 + c0);
            q[e][4] = *(const u32x4*)(of + 2 * SL); q[e][5] = *(const u32x4*)(of + 3 * SL); q[e][6] = *(const u32x4*)(p0 + C_GLA + 1024 + c0);
            q[e][7] = *(const u32x4*)(of + 4 * SL); q[e][8] = *(const u32x4*)(of + 5 * SL); q[e][9] = *(const u32x4*)(c.RWR_() + (size_t)r * 512 + c0); q[e][10] = *(const u32x4*)(c.RWK_() + (size_t)r * 512 + c0);
            q[e][11] = *(const u32x4*)(c.RWV_() + (size_t)r * 512 + c0); q[e][12] = *(const u32x4*)(c.SMALL_() + (size_t)r * NSM + 1536 + c0); }
#pragma unroll
        for (int e = 0; e < PPT; ++e) { const int r = r0 + e * c.NW; if (r >= T) break;
            bf16_t* of = c.OUTS_() + (size_t)r * DMIX + c0;
            {
                float a[8], b[8], x[8], z[8], y[8]; unpack8(q[e][0], a); unpack8(q[e][1], b); unpack8(q[e][2], x); unpack8(q[e][3], z);
                const int h = lane >> 3; const float dsum = Dp[h] + Dp[8 + h]; float ss = 0.f;
#pragma unroll
                for (int j = 0; j < 8; ++j) { y[j] = (x[j] * dsum + a[j] + b[j]) * siluf_(z[j]); ss += y[j] * y[j]; }
                ss = wave_sum(ss, c.lane); const float rs = rsqrtf(ss * (1.0f / 512.0f) + 1e-6f);
#pragma unroll
                for (int j = 0; j < 8; ++j) y[j] = y[j] * rs * snorm[c0 + j];
                *(u32x4*)of = pack8(y);
            }
            {
                float a[8], b[8], g[8], y[8]; unpack8(q[e][4], a); unpack8(q[e][5], b); unpack8(q[e][6], g);
                float ss = 0.f;
#pragma unroll
                for (int j = 0; j < 8; ++j) { y[j] = a[j] + b[j]; ss += y[j] * y[j]; }
                ss = dred8(ss); ss += shx(ss, c.lane, 8);
                const float rs = rsqrtf(ss * (1.0f / 128.0f) + 1e-6f);
#pragma unroll
                for (int j = 0; j < 8; ++j) y[j] = y[j] * rs * gnorm[(c0 + j) & 127] * siluf_(g[j]);
                *(u32x4*)(of + 2 * SL) = pack8(y);
            }
            {
                float a[8], b[8], rr[8], kk[8], vv[8], gg[8], y[8];
                unpack8(q[e][7], a); unpack8(q[e][8], b); unpack8(q[e][9], rr); unpack8(q[e][10], kk); unpack8(q[e][11], vv); unpack8(q[e][12], gg);
                float sm = 0.f, bon = 0.f;
#pragma unroll
                for (int j = 0; j < 8; ++j) { y[j] = a[j] + b[j]; sm += y[j]; bon += rr[j] * kk[j] * rk[c0 + j]; }
                sm = dred8(sm); bon = dred8(bon); const float mean = sm * (1.0f / 64.0f); float vs = 0.f;
#pragma unroll
                for (int j = 0; j < 8; ++j) { y[j] -= mean; vs += y[j] * y[j]; }
                vs = dred8(vs); const float rs = rsqrtf(vs * (1.0f / 64.0f) + 64e-5f);
#pragma unroll
                for (int j = 0; j < 8; ++j) y[j] = (y[j] * rs * lnw[c0 + j] + lnb[c0 + j] + bon * vv[j]) * gg[j];
                *(u32x4*)(of + 4 * SL) = pack8(y);
            }
        }
    }
}

#ifndef RMASK
#define RMASK 0
#endif
#ifndef RMASK3
#define RMASK3 0
#endif
constexpr int N_PHASES = 2 + 2 * (14 + __builtin_popcount(RMASK) + 2 * __builtin_popcount(RMASK3));
__global__ void __launch_bounds__(NT, 2) fwd_kernel(Args a) {
    extern __shared__ __attribute__((aligned(16))) unsigned char lds_raw[];
    Ctx c; c.in = a.in; c.out = a.out; c.ws = a.ws; c.lds = (LAS unsigned char*)lds_raw;
    cg::grid_group grid = cg::this_grid();
    volatile LAS unsigned* st = (volatile LAS unsigned*)(c.lds + LDS_STAGE);
    if (threadIdx.x < 4) st[threadIdx.x] = 0u;
    __syncthreads();
    const XcdBarrier bar = xcd_barrier_post((unsigned*)(a.ws + WS_BAR), st);
    if (a.ph_hi < 0) grid.sync();
    for (int ph = a.ph_lo; ph < a.ph_hi; ++ph) {
#ifndef EXTRA_SYNC
#define EXTRA_SYNC 0
#endif
        if (ph > a.ph_lo) { xcd_barrier(bar); for (int e = 0; e < EXTRA_SYNC; ++e) xcd_barrier(bar); }
        { int tl = threadIdx.x, bl = blockIdx.x, gl = gridDim.x; asm volatile("" : "+v"(tl), "+s"(bl), "+s"(gl)); c.G = gl; c.NW = gl * 8;
          c.tid = tl; c.lane = tl & 63; c.wid = __builtin_amdgcn_readfirstlane(tl >> 6); c.bid = bl; c.gw = bl * 8 + c.wid; }
        if (ph == 0) { phase_init(c); __syncthreads(); const int base = convert_ffn(c, 0, 0, 0); convert_mixer(c, 0, base); continue; }
        if (ph == N_PHASES - 1) { phase_final_norm(c); continue; }
#ifndef RMASK
#define RMASK 0
#endif
        constexpr int LAYER_LEN = 14 + __builtin_popcount(RMASK) + 2 * __builtin_popcount(RMASK3);
        const int l = (ph - 1) / LAYER_LEN; int sp = 0; float sgn = 1.0f;
        if (RMASK | RMASK3) { int k = (ph - 1) % LAYER_LEN; for (sp = 0; sp < 14; ++sp) { const int reps = 1 + ((RMASK >> sp) & 1) + 2 * ((RMASK3 >> sp) & 1); if (k < reps) break; k -= reps; } sgn = (k & 1) ? -1.0f : 1.0f; }
        else sp = (ph - 1) % 14;
        const float* ada_l = c.ADA_() + l * 5 * 9216;
#ifndef PMASK
#define PMASK 0xFFFF
#endif
#define PON(k) ((PMASK >> (k)) & 1)
        switch (sp) {
            case 0: if (PON(0)) { phase_norm(c, l, 0, l > 0); if (l > 0) { __syncthreads(); int base = convert_ffn(c, l, 0, 0); convert_mixer(c, l, base); } } break;
            case 1: case 12: if (PON(1)) run_gemm(c, c.H_(), c.WGU_(), 5632, 1024, EpiGU{c.PROJ_()}); break;
            case 2: if (PON(2)) run_gemm(c, c.PROJ_(), c.WD_(), 1024, DFF, EpiResid{c.OUTS_(), ada_l + 2 * 1024, 0.5f * sgn}, 2); break;
            case 13: if (PON(2)) run_gemm(c, c.PROJ_(), c.WD_(), 1024, DFF, EpiResid{c.OUTS_(), ada_l + 8 * 1024, 0.5f * sgn}, 2); break;
            case 3: if (PON(3)) phase_norm(c, l, 1, true); break;
            case 4: if (PON(4)) run_gemm(c, c.H_(), c.WIN_(), NPROJ, 1024, EpiProj{c.PROJ_(), NPROJ}); break;
            case 5: if (PON(5)) phase_prepass(c, l); break;
            case 6: if (PON(6)) run_gemm(c, c.LOWA_(), c.WSM_(), 2048, KSM, EpiSmall{c.SMALL_(), c.in[26] + l * 1024, c.in[28] + l * 512, c.RWK_(), c.RWKK_(), c.in[32] + l * 512}); break;
            case 7: if (PON(7)) phase_scan(c, l); break;
            case 8: if (PON(8)) phase_postpass(c, l); break;
            case 9: if (PON(9)) { int Kl = 512; asm volatile("" : "+s"(Kl));
                pg8::Gemm g{c.OUTS_(), c.WBO_(), T, 3072, Kl, 512, 4, (size_t)2 * T * DMIX * 2, (size_t)1024 * 512 * 2}; BranchOrder S{c.bid};
                pg8::gemm_phase<EpiBranch, BranchOrder, GP_ALIGN, GP_SP2>(c.lds, g, S, EpiBranch{c.H_(), c.PROJ_() + C_GATE});
                if (c.G > 128 && c.bid >= 128) { Ctx c2 = c; c2.bid = c.bid - 128; c2.G = c.G - 128; (void)convert_ffn(c2, l, 1, 0); } } break;
            case 10: if (PON(10)) run_gemm(c, c.H_(), c.WOUT_(), 1024, 1024, EpiResid{c.OUTS_(), ada_l + 5 * 1024, 1.0f * sgn}, 2); break;
            case 11: if (PON(11)) { phase_norm(c, l, 2, true); if (c.G <= 128) { __syncthreads(); (void)convert_ffn(c, l, 1, 0); } } break;
        }
    }
}

#ifndef N_LAUNCH_MODE
#define N_LAUNCH_MODE 1
#endif
extern "C" void kernel_launch(void* const* d_in, const int* in_sizes, int n_in, void* d_out, int out_size, void* d_ws, size_t ws_size, hipStream_t stream) {
    static int grid = 0;
    if (grid == 0) {
        if (n_in != 39 || ws_size < WS_END) { fprintf(stderr, "kernel_launch: need 39 inputs and %zu bytes of workspace; got %d, %zu\n", (size_t)WS_END, n_in, ws_size); grid = -1; return; }
        if (hipFuncSetAttribute((const void*)fwd_kernel, hipFuncAttributeMaxDynamicSharedMemorySize, LDS_BYTES) != hipSuccess) { fprintf(stderr, "kernel_launch: hipFuncSetAttribute failed\n"); grid = -1; return; }
        int dev = 0, cus = 0, per_cu = 0;
        hipGetDevice(&dev); hipDeviceGetAttribute(&cus, hipDeviceAttributeMultiprocessorCount, dev);
        hipOccupancyMaxActiveBlocksPerMultiprocessor(&per_cu, (const void*)fwd_kernel, NT, LDS_BYTES);
        if (per_cu < 1) { fprintf(stderr, "kernel_launch: occupancy query says %d blocks per CU\n", per_cu); per_cu = 1; }
        (void)hipGetLastError();
        grid = cus;
    }
    if (grid < 0) return;
    Args a{};
    for (int i = 0; i < 39; ++i) a.in[i] = (const float*)d_in[i];
    a.out = (float*)d_out; a.ws = (unsigned char*)d_ws;
#if N_LAUNCH_MODE == 0
    for (int ph = 0; ph < N_PHASES; ++ph) { a.ph_lo = ph; a.ph_hi = ph + 1; hipLaunchKernelGGL(fwd_kernel, dim3(grid), dim3(NT), LDS_BYTES, stream, a); }
#else
    if (hipMemsetAsync((unsigned char*)d_ws + WS_BAR, 0, XCD_BAR_WORDS * 4, stream) != hipSuccess) { fprintf(stderr, "kernel_launch: memset of the barrier words failed\n"); return; }
    a.ph_lo = 0; a.ph_hi = N_PHASES;
    void* args[] = {&a};
    hipError_t e = hipLaunchCooperativeKernel((const void*)fwd_kernel, dim3(grid), dim3(NT), args, LDS_BYTES, stream);
    if (e != hipSuccess) fprintf(stderr, "cooperative launch failed: %s (grid %d)\n", hipGetErrorString(e), grid);
#endif
}
```

```cpp
#include <hip/hip_runtime.h>
#include <hip/hip_cooperative_groups.h>
#include <cstdio>
namespace cg = cooperative_groups;
namespace pg8 {
#define PG8_LAS __attribute__((address_space(3)))
typedef unsigned short bf16_t;
typedef short bf16x8 __attribute__((ext_vector_type(8)));
typedef float f32x4 __attribute__((ext_vector_type(4)));
typedef unsigned u32x4 __attribute__((ext_vector_type(4)));
constexpr int BM = 256, BK = 64, HALF = 128, HTB = HALF * BK * 2  , STAGE_BYTES = 8 * HTB, NXCD = 8, WGM = 8;

__host__ __device__ __forceinline__ int lds_byte(int r, int c) { const int st = (r >> 4) * 2 + (c >> 5), rr = r & 15, cc = c & 31, ob = rr * 64 + cc * 2; return st * 1024 + (ob ^ (((ob >> 9) & 1) << 5)); }
__host__ __device__ __forceinline__ void stage_rc(int b, int& R, int& C) { const int st = b / 1024, sb = b % 1024, swz = sb ^ (((sb >> 9) & 1) << 5); R = (st >> 1) * 16 + swz / 64; C = (st & 1) * 32 + (swz % 64) / 2; }
__host__ __device__ __forceinline__ int perm32(int rho) { const int n = rho >> 4, i = rho & 15; return 8 * (i >> 2) + 4 * n + (i & 3); }

struct Unit { int pm, pn; };
struct Gemm { const bf16_t* A; const bf16_t* Bt; int M, N, K, ld, nreal; size_t asl, bsl; };

struct StaticOrder {
    int nM, nN, nwg, G, c;
    __host__ __device__ void init(int M, int N, int G_, int c_) { nM = M / BM; nN = N / BM; nwg = nM * nN; G = G_; c = c_; }
    __host__ __device__ bool next(int i, Unit& u) const {
        const long L = (long)i * G + c; if (L >= nwg) return false;
        int wgid = (int)L; { const int q = nwg / NXCD, r = nwg % NXCD, xcd = wgid % NXCD, off = wgid / NXCD; wgid = (xcd < r ? xcd * (q + 1) : r * (q + 1) + (xcd - r) * q) + off; }
        const int nig = WGM * nN, gid = wgid / nig, fm = gid * WGM, gsz = (nM - fm) < WGM ? (nM - fm) : WGM;
        u.pm = fm + ((wgid % nig) % gsz); u.pn = (wgid % nig) / gsz; return true;
    }
    __device__ __forceinline__ void a_ready(const Unit&) const {}
    __device__ __forceinline__ void done(const Unit&) const {}
};
__device__ __forceinline__ unsigned cvt_pk_bf16(float lo, float hi) { unsigned r; asm volatile("v_cvt_pk_bf16_f32 %0, %1, %2" : "=v"(r) : "v"(lo), "v"(hi)); return r; }
template <class Epi, class Sched, bool ALIGN_EPI = false, bool SP2 = false>
__device__ __forceinline__ void gemm_phase(PG8_LAS unsigned char* lds, const Gemm g, const Sched& S, const Epi& E) {
    int tid_l = threadIdx.x; asm volatile("" : "+v"(tid_l));
    const int tid = tid_l, wid = __builtin_amdgcn_readfirstlane(tid >> 6), lane = tid & 63, wr = wid >> 2, wc = wid & 3, fr = lane & 15, fq = lane >> 4;
    const int K = g.K, LD = g.ld, nt = K / BK;
    unsigned voffA[2], voffB[2];
#pragma unroll
    for (int i = 0; i < 2; ++i) { int R, C; stage_rc(tid * 16 + i * 8192, R, C); const int Rb = Epi::PERM ? ((R & ~31) + perm32(R & 31)) : R;
        voffA[i] = (unsigned)(R * LD + C) * 2u; voffB[i] = (unsigned)(Rb * LD + C) * 2u; }
    const size_t kstep = (size_t)(BK * 2);
    const size_t hstep = (size_t)HALF * LD * 2;
    const size_t tstep = 2 * hstep;
    const unsigned ldsw = (unsigned)wid * 1024u;
    const int aoff = lds_byte(wr * 64 + fr, fq * 8), boff = lds_byte(wc * 32 + fr, fq * 8);
#define PG8_SA(b, h) (((b) * 2 + (h)) * HTB)
#define PG8_SB(b, h) ((4 + (b) * 2 + (h)) * HTB)
#define PG8_STAGE(bufoff, gbase, voff) do { _Pragma("unroll") for (int _i = 0; _i < 2; ++_i) \
        __builtin_amdgcn_global_load_lds((const unsigned*)((const char*)(gbase) + (voff)[_i]), (PG8_LAS unsigned*)(lds + (bufoff) + ldsw + _i * 8192), 16, 0, 0); } while (0)
#define PG8_LDA(dst, b, h) do { _Pragma("unroll") for (int m = 0; m < 4; ++m) _Pragma("unroll") for (int k = 0; k < 2; ++k) dst[m][k] = *(const PG8_LAS bf16x8*)(lds + PG8_SA(b, h) + aoff + m * 2048 + k * 1024); } while (0)
#define PG8_LDB(dst, b, h) do { _Pragma("unroll") for (int n = 0; n < 2; ++n) _Pragma("unroll") for (int k = 0; k < 2; ++k) dst[n][k] = *(const PG8_LAS bf16x8*)(lds + PG8_SB(b, h) + boff + n * 2048 + k * 1024); } while (0)
#define PG8_MMA(ai, bj, At, Bt) do { __builtin_amdgcn_s_setprio(1); _Pragma("unroll") for (int m = 0; m < 4; ++m) _Pragma("unroll") for (int n = 0; n < 2; ++n) _Pragma("unroll") for (int k = 0; k < 2; ++k) \
        acc[ai][bj][m][n] = __builtin_amdgcn_mfma_f32_16x16x32_bf16(Bt[n][k], At[m][k], acc[ai][bj][m][n], 0, 0, 0); __builtin_amdgcn_s_setprio(0); } while (0)
#define PG8_WAIT_V(n) asm volatile("s_waitcnt vmcnt(" #n ")" ::: "memory")
#define PG8_WAIT_L(n) asm volatile("s_waitcnt lgkmcnt(" #n ")" ::: "memory")
#define PG8_BAR __builtin_amdgcn_s_barrier()
#define PG8_SCHED __builtin_amdgcn_sched_barrier(0)
    Unit cur, nxt; int ui = 0;
    if (!S.next(0, cur)) return;
    f32x4 acc[2][2][4][2];
#pragma unroll
    for (int a = 0; a < 2; ++a)
#pragma unroll
        for (int b = 0; b < 2; ++b)
#pragma unroll
            for (int m = 0; m < 4; ++m)
#pragma unroll
                for (int n = 0; n < 2; ++n) acc[a][b][m][n] = (f32x4){0.f, 0.f, 0.f, 0.f};
    bf16x8 At[4][2], B0[2][2], B1[2][2];
    const char* cA = (const char*)g.A + (size_t)cur.pm * tstep + (size_t)(cur.pn / g.nreal) * g.asl; const char* cB = (const char*)g.Bt + (size_t)(cur.pn % g.nreal) * tstep + (size_t)(cur.pn / g.nreal) * g.bsl;
    S.a_ready(cur);
    if constexpr (SP2) {
        PG8_STAGE(PG8_SB(0, 0), cB, voffB); PG8_STAGE(PG8_SB(0, 1), cB + hstep, voffB); PG8_STAGE(PG8_SA(0, 0), cA, voffA); PG8_STAGE(PG8_SA(0, 1), cA + hstep, voffA);
        if (wr == 1) PG8_BAR;
        PG8_WAIT_V(2); PG8_BAR;
        PG8_STAGE(PG8_SB(1, 0), cB + kstep, voffB); PG8_STAGE(PG8_SA(1, 0), cA + kstep, voffA); PG8_STAGE(PG8_SB(1, 1), cB + hstep + kstep, voffB);
        PG8_WAIT_V(6); PG8_BAR;
    } else {
        PG8_STAGE(PG8_SB(0, 0), cB, voffB); PG8_STAGE(PG8_SA(0, 0), cA, voffA); PG8_STAGE(PG8_SB(0, 1), cB + hstep, voffB); PG8_STAGE(PG8_SA(0, 1), cA + hstep, voffA);
        if (wr == 1) PG8_BAR;
        PG8_WAIT_V(4); PG8_BAR;
        PG8_STAGE(PG8_SB(1, 0), cB + kstep, voffB); PG8_STAGE(PG8_SA(1, 0), cA + kstep, voffA); PG8_STAGE(PG8_SB(1, 1), cB + hstep + kstep, voffB);
        PG8_WAIT_V(6); PG8_BAR;
    }
    for (;;) {
        const bool has_next = S.next(ui + 1, nxt);
        const char* nA = has_next ? (const char*)g.A + (size_t)nxt.pm * tstep + (size_t)(nxt.pn / g.nreal) * g.asl : cA; const char* nB = has_next ? (const char*)g.Bt + (size_t)(nxt.pn % g.nreal) * tstep + (size_t)(nxt.pn / g.nreal) * g.bsl : cB;
        for (int t = 0; t < nt; t += 2) {
            const bool last = (t == nt - 2);
            const char* a1 = cA + (size_t)(t + 1) * kstep;
            const char* a2 = last ? nA : cA + (size_t)(t + 2) * kstep; const char* b2 = last ? nB : cB + (size_t)(t + 2) * kstep;
            const char* a3 = a2 + kstep; const char* b3 = b2 + kstep;
            if (last && has_next) S.a_ready(nxt);
            if constexpr (SP2) {
            PG8_LDB(B0, 0, 0); PG8_LDB(B1, 0, 1); PG8_SCHED; PG8_LDA(At, 0, 0); PG8_STAGE(PG8_SA(1, 1), a1 + hstep, voffA);
            PG8_WAIT_V(8); PG8_WAIT_L(0); PG8_BAR; PG8_MMA(0, 0, At, B0); PG8_MMA(0, 1, At, B1); PG8_BAR; PG8_SCHED;
            PG8_LDA(At, 0, 1); PG8_STAGE(PG8_SB(0, 0), b2, voffB); PG8_STAGE(PG8_SB(0, 1), b2 + hstep, voffB); PG8_STAGE(PG8_SA(0, 0), a2, voffA);
            PG8_WAIT_V(8); PG8_WAIT_L(0); PG8_BAR; PG8_MMA(1, 0, At, B0); PG8_MMA(1, 1, At, B1); PG8_BAR; PG8_SCHED;
            PG8_LDB(B0, 1, 0); PG8_LDB(B1, 1, 1); PG8_SCHED; PG8_LDA(At, 1, 0); PG8_STAGE(PG8_SA(0, 1), a2 + hstep, voffA);
            PG8_WAIT_V(8); PG8_WAIT_L(0); PG8_BAR; PG8_MMA(0, 0, At, B0); PG8_MMA(0, 1, At, B1); PG8_BAR; PG8_SCHED;
            PG8_LDA(At, 1, 1); PG8_STAGE(PG8_SB(1, 0), b3, voffB); PG8_STAGE(PG8_SB(1, 1), b3 + hstep, voffB); PG8_STAGE(PG8_SA(1, 0), a3, voffA);
            PG8_WAIT_V(8); PG8_WAIT_L(0); PG8_BAR; PG8_MMA(1, 0, At, B0); PG8_MMA(1, 1, At, B1); PG8_BAR; PG8_SCHED;
            } else {
            PG8_LDB(B0, 0, 0); PG8_SCHED; PG8_LDA(At, 0, 0); PG8_STAGE(PG8_SA(1, 1), a1 + hstep, voffA);
            PG8_WAIT_L(8); PG8_BAR; PG8_WAIT_L(0); PG8_MMA(0, 0, At, B0); PG8_BAR; PG8_SCHED;
            PG8_LDB(B1, 0, 1); PG8_STAGE(PG8_SB(0, 0), b2, voffB);
            PG8_BAR; PG8_WAIT_L(0); PG8_MMA(0, 1, At, B1); PG8_BAR;
            PG8_LDA(At, 0, 1); PG8_STAGE(PG8_SA(0, 0), a2, voffA);
            PG8_BAR; PG8_WAIT_L(0); PG8_MMA(1, 0, At, B0); PG8_BAR; PG8_SCHED;
            PG8_STAGE(PG8_SB(0, 1), b2 + hstep, voffB);
            PG8_WAIT_V(6); PG8_BAR; PG8_MMA(1, 1, At, B1); PG8_BAR;
            PG8_LDB(B0, 1, 0); PG8_SCHED; PG8_LDA(At, 1, 0); PG8_STAGE(PG8_SA(0, 1), a2 + hstep, voffA);
            PG8_WAIT_L(8); PG8_BAR; PG8_WAIT_L(0); PG8_MMA(0, 0, At, B0); PG8_BAR; PG8_SCHED;
            PG8_LDB(B1, 1, 1); PG8_STAGE(PG8_SB(1, 0), b3, voffB);
            PG8_BAR; PG8_WAIT_L(0); PG8_MMA(0, 1, At, B1); PG8_BAR;
            PG8_LDA(At, 1, 1); PG8_STAGE(PG8_SA(1, 0), a3, voffA);
            PG8_BAR; PG8_WAIT_L(0); PG8_MMA(1, 0, At, B0); PG8_BAR; PG8_SCHED;
            PG8_STAGE(PG8_SB(1, 1), b3 + hstep, voffB);
            PG8_WAIT_V(6); PG8_BAR; PG8_MMA(1, 1, At, B1); PG8_BAR;
            }
        }
        if constexpr (ALIGN_EPI) { if (wr == 0) PG8_BAR; }
        if constexpr (!Epi::AFTER_DRAIN) { E(acc, cur, wr, wc, fr, fq); S.done(cur); }
        if (!has_next) break;
#pragma unroll
        for (int a = 0; a < 2; ++a)
#pragma unroll
            for (int b = 0; b < 2; ++b)
#pragma unroll
                for (int m = 0; m < 4; ++m)
#pragma unroll
                    for (int n = 0; n < 2; ++n) acc[a][b][m][n] = (f32x4){0.f, 0.f, 0.f, 0.f};
        cur = nxt; cA = nA; cB = nB; ++ui;
        if constexpr (ALIGN_EPI) { if (wr == 1) PG8_BAR; }
    }
    PG8_WAIT_V(0);
    if constexpr (!ALIGN_EPI) { if (wr == 0) PG8_BAR; }
    PG8_BAR;
    if constexpr (Epi::AFTER_DRAIN) { E.fused(acc, cur, wr, wc, fr, fq, lds, wid, lane); S.done(cur); }
#undef PG8_SA
#undef PG8_SB
#undef PG8_STAGE
#undef PG8_LDA
#undef PG8_LDB
#undef PG8_MMA
#undef PG8_WAIT_V
#undef PG8_WAIT_L
#undef PG8_BAR
#undef PG8_SCHED
}
}
#define LAS __attribute__((address_space(3)))
#define XB_TMO      128
#define XB_XCNT(j)  (256  + 64 * (j))
#define XB_XSUB(j)  (1280 + 64 * (j))
#define XB_XGEN(j)  (2304 + 64 * (j))
#define XB_TOP      3328
#define XB_TOPGEN   3392
#define XCD_BAR_WORDS 3456
#define XB_SPIN_CAP (1u << 18)

__device__ __forceinline__ unsigned xb_ld(unsigned* p)              { return __hip_atomic_load(p, __ATOMIC_RELAXED, __HIP_MEMORY_SCOPE_AGENT); }
__device__ __forceinline__ unsigned xb_add(unsigned* p, unsigned v) { return __hip_atomic_fetch_add(p, v, __ATOMIC_RELAXED, __HIP_MEMORY_SCOPE_AGENT); }
__device__ __forceinline__ unsigned xb_xcc_id() { return (unsigned)__builtin_amdgcn_s_getreg((3 << 11) | 20) & 0xFu; }
#define XB_SPIN(cond, bar) do { unsigned _sp = 0; while (cond) { __builtin_amdgcn_s_sleep(1); \
    if ((++_sp & 255u) == 0u) { if (xb_ld(&(bar)[XB_TMO])) break; if (_sp > XB_SPIN_CAP) { atomicAdd(&(bar)[XB_TMO], 1u); break; } } } } while (0)

struct XcdBarrier {
    unsigned* bar; unsigned x;
    volatile LAS unsigned* st;
};

__device__ __forceinline__ XcdBarrier xcd_barrier_post(unsigned* bar, volatile LAS unsigned* st) {
    XcdBarrier b; b.bar = bar; b.x = xb_xcc_id(); b.st = st;
    if (threadIdx.x == 0) (void)xb_add(&bar[XB_XCNT(b.x)], 1u);
    return b;
}
__device__ __forceinline__ void xcd_barrier_complete(unsigned* bar, unsigned x, unsigned& nloc, unsigned& nx) {
    const unsigned G = gridDim.x * gridDim.y * gridDim.z;
    unsigned sum, cnt, mine, sp = 0u;
    for (;;) {
        sum = 0u; cnt = 0u; mine = 0u;
#pragma unroll
        for (unsigned j = 0; j < 16; ++j) { const unsigned c = xb_ld(&bar[XB_XCNT(j)]); sum += c; cnt += (c > 0u) ? 1u : 0u; mine = (j == x) ? c : mine; }
        if (sum == G) break;
        __builtin_amdgcn_s_sleep(1);
        if ((++sp & 255u) == 0u) { if (xb_ld(&bar[XB_TMO])) break; if (sp > XB_SPIN_CAP) { atomicAdd(&bar[XB_TMO], 1u); break; } }
    }
    nloc = mine > 0u ? mine : 1u; nx = cnt > 0u ? cnt : 1u;
}

__device__ __forceinline__ void xcd_barrier(const XcdBarrier& b) {
    asm volatile("s_waitcnt vmcnt(0)" ::: "memory");
    __syncthreads();
    if (threadIdx.x == 0) {
        unsigned* bar = b.bar;
        __builtin_amdgcn_s_waitcnt(0);
        unsigned nloc = b.st[0], nx = b.st[1];
        if (nloc == 0u) { xcd_barrier_complete(bar, b.x, nloc, nx); b.st[0] = nloc; b.st[1] = nx; }
        const unsigned old = xb_add(&bar[XB_XSUB(b.x)], 1u);
        const unsigned gen = old / nloc;
        if (old + 1u == (gen + 1u) * nloc) {
            __builtin_amdgcn_fence(__ATOMIC_RELEASE, "agent");
            asm volatile("s_waitcnt vmcnt(0)" ::: "memory");
            const unsigned og = xb_add(&bar[XB_TOP], 1u);
            const unsigned tg = og / nx;
            if (og + 1u == (tg + 1u) * nx) xb_add(&bar[XB_TOPGEN], 1u);
            else XB_SPIN(xb_ld(&bar[XB_TOPGEN]) == tg, bar);
            __builtin_amdgcn_fence(__ATOMIC_ACQUIRE, "agent");
            xb_add(&bar[XB_XGEN(b.x)], 1u);
            asm volatile("s_waitcnt vmcnt(0)" ::: "memory");
        } else {
            XB_SPIN(xb_ld(&bar[XB_XGEN(b.x)]) == gen, bar);
            __builtin_amdgcn_fence(__ATOMIC_ACQUIRE, "agent");
            asm volatile("s_waitcnt vmcnt(0)" ::: "memory");
        }
    }
    __syncthreads();
}

using pg8::bf16_t; using pg8::f32x4; using pg8::u32x4; using pg8::cvt_pk_bf16;
typedef unsigned u32x2 __attribute__((ext_vector_type(2)));

constexpr int T = 8192, D = 1024, DFF = 2816, DMIX = 512, NPROJ = 7936, NIN = 7792, NSM = 2560, KSM = 384, NT = 512, LDS_STAGE = 131072, LDS_BYTES = LDS_STAGE + 16;
constexpr int C_GLA = 1296, C_RW = 2864, C_GATE = 4720;
constexpr size_t WS_ADA = 0;
constexpr size_t WS_WGU = WS_ADA + 2ull * 5 * 9216 * 4;
constexpr size_t WS_WD = WS_WGU + 5632ull * 1024 * 2;
constexpr size_t WS_WIN = WS_WD + 1024ull * 2816 * 2;
constexpr size_t WS_WBO = WS_WIN + (size_t)NPROJ * 1024 * 2;
constexpr size_t WS_WOUT = WS_WBO + 3ull * 1024 * 512 * 2;
constexpr size_t WS_WSM = WS_WOUT + 1024ull * 1024 * 2;
constexpr size_t WS_H = WS_WSM + (size_t)NSM * KSM * 2;
constexpr size_t WS_PROJ = WS_H + (size_t)T * D * 2;
constexpr size_t WS_RW = WS_PROJ + (size_t)T * NPROJ * 2;
constexpr size_t WS_LOWA = WS_RW + 4ull * T * DMIX * 2;
constexpr size_t WS_SMALL = WS_LOWA + (size_t)T * KSM * 2;
constexpr size_t WS_OUT = WS_SMALL + (size_t)T * NSM * 2;
constexpr size_t WS_BAR = WS_OUT + 6ull * T * DMIX * 2;
constexpr size_t WS_END = WS_BAR + XCD_BAR_WORDS * 4;
constexpr size_t WS_XBC = WS_WGU;
constexpr size_t WS_DT = WS_XBC + (size_t)T * 768 * 2;
static_assert(WS_DT + (size_t)T * 16 * 4 <= WS_WIN, "xbc alias");
constexpr size_t OUT_SSD = 8388608, OUT_GLA = OUT_SSD + 2097152, OUT_RWK = OUT_GLA + 2097152;

struct Args { const float* in[39]; float* out; unsigned char* ws; int ph_lo, ph_hi; };

struct Ctx {
    const float* const* in; float* out; unsigned char* ws; LAS unsigned char* lds; int tid, lane, wid, G, bid, gw, NW;
    __device__ __forceinline__ float* X_() const { return out; }
    __device__ __forceinline__ float* ADA_() const { return (float*)(ws + WS_ADA); }
    __device__ __forceinline__ bf16_t* WGU_() const { return (bf16_t*)(ws + WS_WGU); }
    __device__ __forceinline__ bf16_t* WD_() const { return (bf16_t*)(ws + WS_WD); }
    __device__ __forceinline__ bf16_t* WIN_() const { return (bf16_t*)(ws + WS_WIN); }
    __device__ __forceinline__ bf16_t* WBO_() const { return (bf16_t*)(ws + WS_WBO); }
    __device__ __forceinline__ bf16_t* WOUT_() const { return (bf16_t*)(ws + WS_WOUT); }
    __device__ __forceinline__ bf16_t* WSM_() const { return (bf16_t*)(ws + WS_WSM); }
    __device__ __forceinline__ bf16_t* H_() const { return (bf16_t*)(ws + WS_H); }
    __device__ __forceinline__ bf16_t* PROJ_() const { return (bf16_t*)(ws + WS_PROJ); }
    __device__ __forceinline__ bf16_t* RWR_() const { return (bf16_t*)(ws + WS_RW); }
    __device__ __forceinline__ bf16_t* RWK_() const { return (bf16_t*)(ws + WS_RW) + (size_t)T * DMIX; }
    __device__ __forceinline__ bf16_t* RWV_() const { return (bf16_t*)(ws + WS_RW) + (size_t)2 * T * DMIX; }
    __device__ __forceinline__ bf16_t* RWKK_() const { return (bf16_t*)(ws + WS_RW) + (size_t)3 * T * DMIX; }
    __device__ __forceinline__ bf16_t* LOWA_() const { return (bf16_t*)(ws + WS_LOWA); }
    __device__ __forceinline__ bf16_t* SMALL_() const { return (bf16_t*)(ws + WS_SMALL); }
    __device__ __forceinline__ bf16_t* OUTS_() const { return (bf16_t*)(ws + WS_OUT); }
    __device__ __forceinline__ bf16_t* XBC_() const { return (bf16_t*)(ws + WS_XBC); }
    __device__ __forceinline__ float* DT_() const { return (float*)(ws + WS_DT); }
};

__device__ __forceinline__ float bf2f(bf16_t v) { return __uint_as_float((unsigned)v << 16); }
__device__ __forceinline__ float bflo(unsigned v) { return __uint_as_float(v << 16); }
__device__ __forceinline__ float bfhi(unsigned v) { return __uint_as_float(v & 0xffff0000u); }
__device__ __forceinline__ bf16_t f2bf(float f) { return (bf16_t)(cvt_pk_bf16(f, 0.f) & 0xffffu); }
__device__ __forceinline__ float sigmoidf_(float x) { return __builtin_amdgcn_rcpf(1.0f + __expf(-x)); }
__device__ __forceinline__ float siluf_(float x) { return x * __builtin_amdgcn_rcpf(1.0f + __expf(-x)); }
__device__ __forceinline__ float softplusf_(float x) { return fmaxf(x, 0.f) + __logf(1.0f + __expf(-fabsf(x))); }
__device__ __forceinline__ void unpack8(const u32x4 w, float* f) { f[0] = bflo(w.x); f[1] = bfhi(w.x); f[2] = bflo(w.y); f[3] = bfhi(w.y); f[4] = bflo(w.z); f[5] = bfhi(w.z); f[6] = bflo(w.w); f[7] = bfhi(w.w); }
__device__ __forceinline__ u32x4 pack8(const float* f) { u32x4 w; w.x = cvt_pk_bf16(f[0], f[1]); w.y = cvt_pk_bf16(f[2], f[3]); w.z = cvt_pk_bf16(f[4], f[5]); w.w = cvt_pk_bf16(f[6], f[7]); return w; }
__device__ __forceinline__ float shx(float x, int lane, int m) { return __int_as_float(__builtin_amdgcn_ds_bpermute((lane ^ m) << 2, __float_as_int(x))); }
__device__ __forceinline__ float wave_sum(float x, int lane) { x += shx(x, lane, 32); x += shx(x, lane, 16); x += shx(x, lane, 8); x += shx(x, lane, 4); x += shx(x, lane, 2); x += shx(x, lane, 1); return x; }
__device__ __forceinline__ float red8(float x, int lane) { x += shx(x, lane, 1); x += shx(x, lane, 2); x += shx(x, lane, 4); return x; }
template <int CTRL> __device__ __forceinline__ float dppf(float x) { return __int_as_float(__builtin_amdgcn_update_dpp(0, __float_as_int(x), CTRL, 0xF, 0xF, true)); }
__device__ __forceinline__ float dred8(float x) { x += dppf<0xB1>(x); x += dppf<0x4E>(x); x += dppf<0x141>(x); return x; }
__device__ __forceinline__ int cond_of_row(int r) { return r < 4096 ? 0 : 1 + ((r - 4096) >> 10); }

template <class F>
__device__ __forceinline__ int conv_tiles(const Ctx& c, F colptr, int ld, bf16_t* dst, int K, int N, int base) {
    LAS float* tile = (LAS float*)c.lds;
    const int nkt = K / 64, ntl = (N / 256) * nkt;
    int first = (c.bid - (base % c.G) + c.G) % c.G;
    for (int tl = first; tl < ntl; tl += c.G) {
        const int n0 = (tl / nkt) * 256, k0 = (tl % nkt) * 64;
        const int n4 = c.lane * 4;
        const float* p = colptr(n0 + n4);
        f32x4 v[8];
#pragma unroll
        for (int j = 0; j < 8; ++j) { const int k = c.wid + 8 * j; v[j] = p ? __builtin_nontemporal_load((const f32x4*)(p + (size_t)(k0 + k) * ld)) : (f32x4){0.f, 0.f, 0.f, 0.f}; }
#pragma unroll
        for (int j = 0; j < 8; ++j) { const int k = c.wid + 8 * j; LAS float* t = tile + k * 257 + n4; t[0] = v[j][0]; t[1] = v[j][1]; t[2] = v[j][2]; t[3] = v[j][3]; }
        __syncthreads();
        const int kc = c.tid & 7, nn0 = c.tid >> 3;
#pragma unroll
        for (int j = 0; j < 4; ++j) { const int n = nn0 + 64 * j; float f[8];
#pragma unroll
            for (int i = 0; i < 8; ++i) f[i] = tile[(kc * 8 + i) * 257 + n];
            *(u32x4*)(dst + (size_t)(n0 + n) * K + k0 + kc * 8) = pack8(f); }
        __syncthreads();
    }
    return base + ntl;
}
struct ColGU { const float* g; const float* u; __device__ const float* operator()(int n) const { const int pn = n >> 8, bj = (n >> 7) & 1, i = n & 127; return g + (u - g) * (long)bj + pn * 128 + i; } };
struct ColPlain { const float* w; int nvalid; __device__ const float* operator()(int n) const { return n < nvalid ? w + n : nullptr; } };

__device__ __forceinline__ int convert_ffn(const Ctx& c, int l, int f, int base) {
    const size_t o = ((size_t)l * 2 + f) * 1024 * 2816;
    base = conv_tiles(c, ColGU{c.in[10] + o, c.in[11] + o}, DFF, c.WGU_(), 1024, 5632, base);
    return conv_tiles(c, ColPlain{c.in[12] + o, 1024}, 1024, c.WD_(), DFF, 1024, base);
}
__device__ __forceinline__ void convert_mixer(const Ctx& c, int l, int base) {
    base = conv_tiles(c, ColPlain{c.in[13] + (size_t)l * 1024 * NIN, NIN}, NIN, c.WIN_(), 1024, NPROJ, base);
    base = conv_tiles(c, ColPlain{c.in[20] + (size_t)l * 512 * 1024, 1024}, 1024, c.WBO_(), 512, 1024, base);
    base = conv_tiles(c, ColPlain{c.in[24] + (size_t)l * 512 * 1024, 1024}, 1024, c.WBO_() + 1024 * 512, 512, 1024, base);
    base = conv_tiles(c, ColPlain{c.in[36] + (size_t)l * 512 * 1024, 1024}, 1024, c.WBO_() + 2 * 1024 * 512, 512, 1024, base);
    base = conv_tiles(c, ColPlain{c.in[37] + (size_t)l * 1024 * 1024, 1024}, 1024, c.WOUT_(), 1024, 1024, base);
    const float* w2 = c.in[27] + (size_t)l * 2 * 64 * 512; const float* a2 = c.in[29] + (size_t)l * 64 * 512; const float* g2 = c.in[30] + (size_t)l * 128 * 512; const float* gk = c.in[21] + (size_t)l * 2 * 16 * 256;
    for (int i = c.bid * NT + c.tid; i < NSM * KSM; i += c.G * NT) {
        const int n = i / KSM, k = i % KSM; float v = 0.f;
        if (n < 512) { if (k < 64) v = w2[k * 512 + n]; }
        else if (n < 1024) { if (k >= 64 && k < 128) v = w2[64 * 512 + (k - 64) * 512 + (n - 512)]; }
        else if (n < 1536) { if (k >= 128 && k < 192) v = a2[(k - 128) * 512 + (n - 1024)]; }
        else if (n < 2048) { if (k >= 192 && k < 320) v = g2[(k - 192) * 512 + (n - 1536)]; }
        else if (n < 2304) { if (k >= 320 && k < 336) v = gk[(k - 320) * 256 + (n - 2048)]; }
        else { if (k >= 336 && k < 352) v = gk[16 * 256 + (k - 336) * 256 + (n - 2304)]; }
        c.WSM_()[i] = f2bf(v);
    }
}

__device__ void phase_init(const Ctx& c) {
    const float* xp = c.in[0]; const float* xs = c.in[1];
    for (int i = c.bid * NT + c.tid; i < T * D / 4; i += c.G * NT) {
        const int r = i >> 8, c4 = (i & 255) * 4;
        f32x4 v;
        if (r < 4096) v = *(const f32x4*)(xp + (size_t)r * D + c4);
        else {
            v = *(const f32x4*)(xs + (size_t)(r - 4096) * D + c4);
            const int t = (r - 4096) & 1023, gr = t >> 6, gc = t & 63;
#pragma unroll
            for (int j = 0; j < 4; ++j) { const int cc = c4 + j, seg = cc >> 8, ii = cc & 255;
                const float omega = __expf(-(float)ii * (9.210340371976184f / 256.0f)); const float ang = (float)(seg < 2 ? gr : gc) * omega;
                v[j] += (seg & 1) ? __cosf(ang) : __sinf(ang); }
        }
        *(f32x4*)(c.X_() + (size_t)r * D + c4) = v;
    }
    LAS float* sc = (LAS float*)c.lds;
    LAS float* red = sc + 5 * 1024;
    for (int i = c.tid; i < 5 * 1024; i += NT) { const int cd = i >> 10, k = i & 1023; const float x = cd == 0 ? c.in[6][k] : c.in[5][(cd - 1) * 1024 + k]; sc[i] = siluf_(x); }
    __syncthreads();
    for (int it = c.bid; it < 288; it += c.G) {
        const int l = it / 144, n0 = (it % 144) * 64, col = c.tid & 63, kg = c.tid >> 6;
        const float* w = c.in[8] + (size_t)l * 1024 * 9216 + n0 + col;
        float a0 = 0.f, a1 = 0.f, a2 = 0.f, a3 = 0.f, a4 = 0.f;
#pragma unroll 16
        for (int k = kg * 128; k < kg * 128 + 128; ++k) { const float wv = w[(size_t)k * 9216]; a0 += sc[k] * wv; a1 += sc[1024 + k] * wv; a2 += sc[2048 + k] * wv; a3 += sc[3072 + k] * wv; a4 += sc[4096 + k] * wv; }
        red[(kg * 5 + 0) * 64 + col] = a0; red[(kg * 5 + 1) * 64 + col] = a1; red[(kg * 5 + 2) * 64 + col] = a2; red[(kg * 5 + 3) * 64 + col] = a3; red[(kg * 5 + 4) * 64 + col] = a4;
        __syncthreads();
        if (c.tid < 320) { const int cd = c.tid >> 6, cl = c.tid & 63; float s = c.in[9][l * 9216 + n0 + cl];
#pragma unroll
            for (int g = 0; g < 8; ++g) s += red[(g * 5 + cd) * 64 + cl];
            c.ADA_()[(l * 5 + cd) * 9216 + n0 + cl] = s; }
        __syncthreads();
    }
}

__device__ void phase_norm(const Ctx& c, int l, int which, bool addP) {
    const bf16_t* P = c.OUTS_();
    const float* g = c.in[7] + (l * 3 + which) * 1024;
    for (int r = c.gw; r < T; r += c.NW) {
        float* xr = c.X_() + (size_t)r * D; f32x4 v[4]; float ss = 0.f;
#pragma unroll
        for (int j = 0; j < 4; ++j) { v[j] = __builtin_nontemporal_load((const f32x4*)(xr + (c.lane + 64 * j) * 4)); if (addP) { const u32x2 pw = __builtin_nontemporal_load((const u32x2*)(P + (size_t)r * D + (c.lane + 64 * j) * 4)), pv = __builtin_nontemporal_load((const u32x2*)(P + (size_t)T * D + (size_t)r * D + (c.lane + 64 * j) * 4)); v[j] = v[j] + ((f32x4){bflo(pw.x), bfhi(pw.x), bflo(pw.y), bfhi(pw.y)} + (f32x4){bflo(pv.x), bfhi(pv.x), bflo(pv.y), bfhi(pv.y)}); __builtin_nontemporal_store(v[j], (f32x4*)(xr + (c.lane + 64 * j) * 4)); } ss += v[j][0] * v[j][0] + v[j][1] * v[j][1] + v[j][2] * v[j][2] + v[j][3] * v[j][3]; }
        ss = wave_sum(ss, c.lane); const float rs = rsqrtf(ss * (1.0f / 1024.0f) + 1e-6f);
        const float* sh = c.ADA_() + (l * 5 + cond_of_row(r)) * 9216 + (which * 3) * 1024; const float* scl = sh + 1024;
#pragma unroll
        for (int j = 0; j < 4; ++j) { const int cc = (c.lane + 64 * j) * 4; const f32x4 gg = *(const f32x4*)(g + cc), s1 = *(const f32x4*)(scl + cc), s0 = *(const f32x4*)(sh + cc);
            const f32x4 o = v[j] * rs * gg * (s1 + 1.0f) + s0; u32x2 w; w.x = cvt_pk_bf16(o[0], o[1]); w.y = cvt_pk_bf16(o[2], o[3]); *(u32x2*)(c.H_() + (size_t)r * D + cc) = w; }
    }
}
__device__ void phase_final_norm(const Ctx& c) {
    const float* g = c.in[38]; const bf16_t* P = c.OUTS_();
    for (int r = c.gw; r < T; r += c.NW) {
        float* xr = c.X_() + (size_t)r * D; f32x4 v[4]; float ss = 0.f;
#pragma unroll
        for (int j = 0; j < 4; ++j) { const u32x2 pw = *(const u32x2*)(P + (size_t)r * D + (c.lane + 64 * j) * 4), pv = *(const u32x2*)(P + (size_t)T * D + (size_t)r * D + (c.lane + 64 * j) * 4); v[j] = *(const f32x4*)(xr + (c.lane + 64 * j) * 4) + ((f32x4){bflo(pw.x), bfhi(pw.x), bflo(pw.y), bfhi(pw.y)} + (f32x4){bflo(pv.x), bfhi(pv.x), bflo(pv.y), bfhi(pv.y)}); ss += v[j][0] * v[j][0] + v[j][1] * v[j][1] + v[j][2] * v[j][2] + v[j][3] * v[j][3]; }
        ss = wave_sum(ss, c.lane); const float rs = rsqrtf(ss * (1.0f / 1024.0f) + 1e-6f);
#pragma unroll
        for (int j = 0; j < 4; ++j) { const int cc = (c.lane + 64 * j) * 4; *(f32x4*)(xr + cc) = v[j] * rs * *(const f32x4*)(g + cc); }
    }
}

struct EpiGU { static constexpr bool PERM = true, AFTER_DRAIN = false; bf16_t* O;
    __device__ __forceinline__ void operator()(const f32x4 (&acc)[2][2][4][2], const pg8::Unit& u, int wr, int wc, int fr, int fq) const {
        const int row0 = u.pm * 256 + wr * 64 + fr, col0 = u.pn * 128 + wc * 32 + 8 * fq;
#pragma unroll
        for (int ai = 0; ai < 2; ++ai)
#pragma unroll
            for (int m = 0; m < 4; ++m) { float o[8];
#pragma unroll
                for (int n = 0; n < 2; ++n)
#pragma unroll
                    for (int j = 0; j < 4; ++j) o[n * 4 + j] = siluf_(acc[ai][0][m][n][j]) * acc[ai][1][m][n][j];
                *(u32x4*)(O + (size_t)(row0 + ai * 128 + m * 16) * DFF + col0) = pack8(o); }
    } };
struct EpiResid { static constexpr bool PERM = false, AFTER_DRAIN = false; bf16_t* P; const float* gate; float s;
    __device__ __forceinline__ void operator()(const f32x4 (&acc)[2][2][4][2], const pg8::Unit& u, int wr, int wc, int fr, int fq) const {
        const int pn = u.pn & 3, kh = u.pn >> 2;
        const int row0 = u.pm * 256 + wr * 64 + fr, col0 = pn * 256 + wc * 32 + 4 * fq; const int cd = cond_of_row(u.pm * 256);
        f32x4 gv[2][2];
#pragma unroll
        for (int bj = 0; bj < 2; ++bj)
#pragma unroll
            for (int n = 0; n < 2; ++n) gv[bj][n] = *(const f32x4*)(gate + cd * 9216 + col0 + bj * 128 + n * 16) * s;
        bf16_t* base = P + (size_t)kh * T * D;
#pragma unroll
        for (int ai = 0; ai < 2; ++ai)
#pragma unroll
            for (int m = 0; m < 4; ++m) { const size_t off = (size_t)(row0 + ai * 128 + m * 16) * D + col0;
#pragma unroll
                for (int bj = 0; bj < 2; ++bj)
#pragma unroll
                    for (int n = 0; n < 2; ++n) { const f32x4 v = acc[ai][bj][m][n] * gv[bj][n]; u32x2 w; w.x = cvt_pk_bf16(v[0], v[1]); w.y = cvt_pk_bf16(v[2], v[3]); *(u32x2*)(base + off + bj * 128 + n * 16) = w; } }
    } };
struct EpiProj { static constexpr bool PERM = true, AFTER_DRAIN = false; bf16_t* O; int ldc;
    __device__ __forceinline__ void operator()(const f32x4 (&acc)[2][2][4][2], const pg8::Unit& u, int wr, int wc, int fr, int fq) const {
        const int row0 = u.pm * 256 + wr * 64 + fr, col0 = u.pn * 256 + wc * 32 + 8 * fq;
#pragma unroll
        for (int ai = 0; ai < 2; ++ai)
#pragma unroll
            for (int m = 0; m < 4; ++m) { bf16_t* rowp = O + (size_t)(row0 + ai * 128 + m * 16) * ldc + col0;
#pragma unroll
                for (int bj = 0; bj < 2; ++bj) { const f32x4 v0 = acc[ai][bj][m][0], v1 = acc[ai][bj][m][1]; u32x4 w; w.x = cvt_pk_bf16(v0[0], v0[1]); w.y = cvt_pk_bf16(v0[2], v0[3]); w.z = cvt_pk_bf16(v1[0], v1[1]); w.w = cvt_pk_bf16(v1[2], v1[3]);
                    *(u32x4*)(rowp + bj * 128) = w; } }
    } };
struct EpiSmall { static constexpr bool PERM = true, AFTER_DRAIN = false; bf16_t* O; const float* w0; const float* a0; bf16_t* rwk; const bf16_t* rwkk; const float* ka;
    __device__ __forceinline__ void operator()(const f32x4 (&acc)[2][2][4][2], const pg8::Unit& u, int wr, int wc, int fr, int fq) const {
        const int row0 = u.pm * 256 + wr * 64 + fr, col0 = u.pn * 256 + wc * 32 + 8 * fq;
        const int kind = u.pn < 4 ? 0 : (u.pn < 6 ? 2 : 3);
        const float* bias = kind == 0 ? w0 : (kind == 2 ? a0 - 1024 : w0 - 1536);
        const float bsc = kind == 3 ? 0.f : 1.f;
#pragma unroll
        for (int bj = 0; bj < 2; ++bj) { const int cc = col0 + bj * 128; const f32x4 b0 = *(const f32x4*)(bias + cc) * bsc, b1 = *(const f32x4*)(bias + cc + 4) * bsc;
#pragma unroll
            for (int ai = 0; ai < 2; ++ai)
#pragma unroll
                for (int m = 0; m < 4; ++m) { const size_t row = row0 + ai * 128 + m * 16; const f32x4 x0 = acc[ai][bj][m][0] + b0, x1 = acc[ai][bj][m][1] + b1; float o[8];
#pragma unroll
                    for (int j = 0; j < 8; ++j) { const float x = j < 4 ? x0[j & 3] : x1[j & 3];
                        const float sg = __builtin_amdgcn_rcpf(1.0f + __expf(-x));
                        const float y01 = 1.0f - __expf(-sg * 0.60653066f);
                        o[j] = kind == 0 ? y01 : (kind == 2 ? sg : x); }
                    if (kind == 2) { float kv[8], kkv[8]; bf16_t* kp = rwk + row * 512 + (cc - 1024); unpack8(*(const u32x4*)kp, kv); unpack8(*(const u32x4*)(rwkk + row * 512 + (cc - 1024)), kkv);
                        const f32x4 ka0 = *(const f32x4*)(ka + cc - 1024), ka1 = *(const f32x4*)(ka + cc - 1024 + 4);
#pragma unroll
                        for (int j = 0; j < 8; ++j) { const float av = o[j], kaj = j < 4 ? ka0[j & 3] : ka1[j & 3]; kv[j] = kv[j] * (1.0f + (av - 1.0f) * kaj); o[j] = kkv[j] * av; }
                        *(u32x4*)kp = pack8(kv); }
                    *(u32x4*)(O + row * NSM + cc) = pack8(o); }
            asm volatile("" ::: "memory"); }
    } };
struct EpiBranch { static constexpr bool PERM = true, AFTER_DRAIN = false; bf16_t* M; const bf16_t* gates;
    __device__ __forceinline__ void operator()(const f32x4 (&acc)[2][2][4][2], const pg8::Unit& u, int wr, int wc, int fr, int fq) const {
        int upm = u.pm, upn = u.pn; asm volatile("" : "+s"(upm), "+s"(upn));
        const int b = upn >> 2, pn = upn & 3; const float keep = b ? 1.0f : 0.0f;
        const int row0 = upm * 256 + wr * 64 + fr, col0 = pn * 256 + wc * 32 + 8 * fq; const bf16_t* gb = gates + b * 1024;
#pragma unroll
        for (int ai = 0; ai < 2; ++ai)
#pragma unroll
            for (int m = 0; m < 4; ++m) { const int row = row0 + ai * 128 + m * 16;
#pragma unroll
                for (int bj = 0; bj < 2; ++bj) { const int cc = col0 + bj * 128; float gt[8], o[8];
                    unpack8(*(const u32x4*)(gb + (size_t)row * NPROJ + cc), gt);
                    bf16_t* mp = M + (size_t)row * D + cc;
                    unpack8(*(const u32x4*)mp, o);
#pragma unroll
                    for (int j = 0; j < 8; ++j) o[j] = o[j] * keep + sigmoidf_(gt[j]) * acc[ai][bj][m][j >> 2][j & 3];
                    *(u32x4*)mp = pack8(o); }
                asm volatile("" ::: "memory"); }
    } };

#ifndef GP_ALIGN
#define GP_ALIGN true
#endif
#ifndef GP_SP2
#define GP_SP2 true
#endif
template <class Epi>
__device__ __forceinline__ void run_gemm(const Ctx& c, const bf16_t* A, const bf16_t* Bt, int N, int K, const Epi& E, int ksplit = 1) {
    int Kl = K / ksplit; asm volatile("" : "+s"(Kl));
    pg8::Gemm g{A, Bt, T, N * ksplit, Kl, K, N / 256, (size_t)Kl * 2, (size_t)Kl * 2}; pg8::StaticOrder S; S.init(T, N * ksplit, c.G, c.bid);
    pg8::gemm_phase<Epi, pg8::StaticOrder, GP_ALIGN, GP_SP2>(c.lds, g, S, E);
}

struct BranchOrder { int c;
    __device__ bool next(int i, pg8::Unit& u) const { if (c >= 128 || i >= 3) return false; u.pm = c >> 2; u.pn = (c & 3) + 4 * i; return true; }
    __device__ __forceinline__ void a_ready(const pg8::Unit&) const {}
    __device__ __forceinline__ void done(const pg8::Unit&) const {}
};
__device__ __forceinline__ void ldf8(const float* p, float* f) { const f32x4 a = *(const f32x4*)p, b = *(const f32x4*)(p + 4); f[0] = a[0]; f[1] = a[1]; f[2] = a[2]; f[3] = a[3]; f[4] = b[0]; f[5] = b[1]; f[6] = b[2]; f[7] = b[3]; }
__device__ void phase_prepass(const Ctx& c, int l) {
    const float* cw = c.in[14] + l * 3 * 768; const float* cb = c.in[15] + l * 768; const float* dtb = c.in[16] + l * 16;
    const float* mu = c.in[25] + l * 1856; const float* rkk = c.in[31] + l * 512; const float* gkw = c.in[21] + l * 2 * 16 * 256; const float* gkb = c.in[22] + l * 512;
    const int lane = c.lane;
    for (int r = c.gw; r < T; r += c.NW) {
        int t, L; if (r < 4096) { t = r & 255; L = 256; } else { t = (r - 4096) & 1023; L = 1024; }
        const bool hp = t > 0, hn = t < L - 1;
        const bf16_t* p0 = c.PROJ_() + (size_t)r * NPROJ; const bf16_t* pm = hp ? p0 - NPROJ : p0; const bf16_t* pn = hn ? p0 + NPROJ : p0;
        const float fp = hp ? 1.f : 0.f, fn = hn ? 1.f : 0.f;
#pragma unroll
        for (int it = 0; it < 2; ++it) { const int g = lane + 64 * it; if (g < 96) { const int cc = g * 8; float x0[8], xm[8], xn[8], w0[8], w1[8], w2[8], bb[8], o[8];
            unpack8(*(const u32x4*)(p0 + 512 + cc), x0); unpack8(*(const u32x4*)(pm + 512 + cc), xm); unpack8(*(const u32x4*)(pn + 512 + cc), xn);
            ldf8(cw + cc, w0); ldf8(cw + 768 + cc, w1); ldf8(cw + 1536 + cc, w2); ldf8(cb + cc, bb);
#pragma unroll
            for (int j = 0; j < 8; ++j) o[j] = siluf_(bb[j] + w0[j] * xm[j] * fp + w1[j] * x0[j] + w2[j] * xn[j] * fn);
            *(u32x4*)(c.XBC_() + (size_t)r * 768 + cc) = pack8(o); } }
        if (lane < 16) c.DT_()[r * 16 + lane] = softplusf_(bf2f(p0[1280 + lane]) + dtb[lane]);
#pragma unroll
        for (int it = 0; it < 4; ++it) { const int g = lane + 64 * it; if (g < 232) { const int cc = g * 8; float x0[8], xm[8], xn[8], m8[8], o[8];
            unpack8(*(const u32x4*)(p0 + C_RW + cc), x0); unpack8(*(const u32x4*)(pm + C_RW + cc), xm); unpack8(*(const u32x4*)(pn + C_RW + cc), xn); ldf8(mu + cc, m8);
#pragma unroll
            for (int j = 0; j < 8; ++j) o[j] = x0[j] + (0.5f * (xm[j] * fp + xn[j] * fn) - x0[j]) * m8[j];
            if (it == 0) *(u32x4*)(c.RWR_() + (size_t)r * 512 + cc) = pack8(o);
            else if (it == 1) { const int ck = cc - 512; *(u32x4*)(c.RWK_() + (size_t)r * 512 + ck) = pack8(o); float kw[8], kq[8]; ldf8(rkk + ck, kw); float ss = 0.f;
#pragma unroll
                for (int j = 0; j < 8; ++j) { kq[j] = o[j] * kw[j]; ss += kq[j] * kq[j]; }
                ss = dred8(ss); const float inv = 1.0f / fmaxf(sqrtf(ss), 1e-12f);
#pragma unroll
                for (int j = 0; j < 8; ++j) kq[j] *= inv;
                *(u32x4*)(c.RWKK_() + (size_t)r * 512 + ck) = pack8(kq); }
            else if (it == 2) *(u32x4*)(c.RWV_() + (size_t)r * 512 + (cc - 1024)) = pack8(o);
            else { const int cl = cc - 1536;
#pragma unroll
                for (int j = 0; j < 8; ++j) { const float e2 = __expf(2.0f * o[j]); const float th = 1.0f - 2.0f / (1.0f + e2); const float sg = sigmoidf_(o[j]); o[j] = cl < 128 ? th : (cl < 192 ? o[j] : sg); }
                *(u32x4*)(c.LOWA_() + (size_t)r * KSM + cl) = pack8(o); } } }
        if (lane < 8) { unsigned z = 0u; asm volatile("" : "+v"(z)); *(u32x4*)(c.LOWA_() + (size_t)r * KSM + 320 + lane * 8) = (u32x4){z, z, z, z}; }
        {
            const int d = lane >> 5, cg = lane & 31; const float* gwp = gkw + d * 16 * 256 + cg * 8; float lr[16], acc[8];
            unpack8(*(const u32x4*)(p0 + C_GLA + 1536 + d * 16), lr); unpack8(*(const u32x4*)(p0 + C_GLA + 1536 + d * 16 + 8), lr + 8); ldf8(gkb + d * 256 + cg * 8, acc);
#pragma unroll
            for (int i = 0; i < 16; ++i) { float w[8]; ldf8(gwp + i * 256, w);
#pragma unroll
                for (int j = 0; j < 8; ++j) acc[j] += lr[i] * w[j]; }
#pragma unroll
            for (int j = 0; j < 8; ++j) acc[j] = 1.0f - __expf(softplusf_(-acc[j]) * (-1.0f / 16.0f));
            *(u32x4*)(c.SMALL_() + (size_t)r * NSM + 2048 + d * 256 + cg * 8) = pack8(acc); }
    }
}

struct SeqInfo { int L, row0, b, ctx; };
__device__ __forceinline__ SeqInfo seq_info(int s) { SeqInfo q; if (s < 16) { q.L = 256; q.row0 = s * 256; q.b = s; q.ctx = 1; } else { q.L = 1024; q.row0 = 4096 + (s - 16) * 1024; q.b = s - 16; q.ctx = 0; } return q; }

#ifndef PF_SSD
#define PF_SSD 8
#endif
#ifndef PF_GLA
#define PF_GLA 4
#endif
#ifndef PF_RW
#define PF_RW 2
#endif
__device__ __forceinline__ u32x4 ldu16(const bf16_t* ub, unsigned lo) { return *(const u32x4*)((const char*)ub + lo); }
__device__ __forceinline__ bf16_t ldu2(const bf16_t* ub, unsigned lo) { return *(const bf16_t*)((const char*)ub + lo); }
__device__ __forceinline__ float sel8(const float (&y)[8], int k) { float v = y[0]; v = k == 1 ? y[1] : v; v = k == 2 ? y[2] : v; v = k == 3 ? y[3] : v; v = k == 4 ? y[4] : v; v = k == 5 ? y[5] : v; v = k == 6 ? y[6] : v; v = k == 7 ? y[7] : v; return v; }

constexpr int REC = 336;
__device__ __forceinline__ void st8(LAS float* p, const u32x4 w) { float f[8]; unpack8(w, f); *(LAS f32x4*)p = (f32x4){f[0], f[1], f[2], f[3]}; *(LAS f32x4*)(p + 4) = (f32x4){f[4], f[5], f[6], f[7]}; }
__device__ __forceinline__ void ld8(const LAS float* p, float* f) { const f32x4 a = *(const LAS f32x4*)p, b = *(const LAS f32x4*)(p + 4); f[0] = a[0]; f[1] = a[1]; f[2] = a[2]; f[3] = a[3]; f[4] = b[0]; f[5] = b[1]; f[6] = b[2]; f[7] = b[3]; }

__device__ void scan_ssd(const Ctx& c, int l, int s, int dir, int hp) {
    const SeqInfo q = seq_info(s); const int h = hp * 2 + (c.wid >> 2), w4 = c.wid & 3, lane = c.lane, r = lane >> 3, p0 = w4 * 16 + r, np = lane & 7, g = h >> 2;
    float S[2][8];
#pragma unroll
    for (int e = 0; e < 2; ++e) {
        if (!q.ctx) { const float* st = c.in[2] + ((((size_t)q.b * 2 + l) * 2 + dir) * 8 + h) * 4096 + (p0 + 8 * e) * 64 + np * 8; const f32x4 a = *(const f32x4*)st, b = *(const f32x4*)(st + 4);
            S[e][0] = a[0]; S[e][1] = a[1]; S[e][2] = a[2]; S[e][3] = a[3]; S[e][4] = b[0]; S[e][5] = b[1]; S[e][6] = b[2]; S[e][7] = b[3]; }
        else {
#pragma unroll
            for (int j = 0; j < 8; ++j) S[e][j] = 0.f; } }
    const float adh = -__expf(c.in[17][l * 16 + dir * 8 + h]) * 1.44269504f;
    const long sgn = dir ? -1 : 1; const size_t rbase = (size_t)q.row0 + (dir ? q.L - 1 : 0);
    LAS float* lb = (LAS float*)c.lds + c.wid * (8 * REC); LAS float* wr = lb + r * REC + np * 8; const LAS float* rd = lb + np * 8;
    const char* gX = (const char*)(c.XBC_() + (rbase + sgn * r) * 768); const float* gD = c.DT_() + (rbase + sgn * r) * 16 + dir * 8 + h; const long cX = sgn * 8 * 768 * 2, cD = sgn * 8 * 16;
    const unsigned loB = (512 + g * 64 + np * 8) * 2, loX = (h * 64 + w4 * 16 + np) * 2;
    bf16_t* O = c.OUTS_() + (size_t)(0 * 2 + dir) * T * DMIX + (rbase + sgn * np) * DMIX + h * 64 + p0;
    u32x4 nB, nC; bf16_t nx0, nx1; float ndt;
#define SSD_LOAD() { nB = *(const u32x4*)(gX + loB); nC = *(const u32x4*)(gX + loB + 256); nx0 = *(const bf16_t*)(gX + loX); nx1 = *(const bf16_t*)(gX + loX + 16); ndt = *gD; gX += cX; gD += cD; }
#define SSD_STORE() { st8(wr, nB); st8(wr + 64, nC); lb[r * REC + 128 + np] = bf2f(nx0); lb[r * REC + 136 + np] = bf2f(nx1); lb[r * REC + 144] = ndt; }
    SSD_LOAD(); SSD_STORE();
    for (int i0 = 0; i0 < q.L; i0 += 8) {
        SSD_LOAD();
        float out0 = 0.f, out1 = 0.f;
#pragma unroll
        for (int j = 0; j < 8; ++j) {
            float B[8], C[8]; ld8(rd + j * REC, B); ld8(rd + j * REC + 64, C); const float x0 = lb[j * REC + 128 + r], x1 = lb[j * REC + 136 + r], dtv = lb[j * REC + 144];
            const float da = __builtin_amdgcn_exp2f(dtv * adh), xd0 = x0 * dtv, xd1 = x1 * dtv; float ya = 0.f, yb = 0.f, za = 0.f, zb = 0.f;
#pragma unroll
            for (int k = 0; k < 8; k += 2) {
                S[0][k] = da * S[0][k] + xd0 * B[k]; S[0][k + 1] = da * S[0][k + 1] + xd0 * B[k + 1]; ya += S[0][k] * C[k]; yb += S[0][k + 1] * C[k + 1];
                S[1][k] = da * S[1][k] + xd1 * B[k]; S[1][k + 1] = da * S[1][k + 1] + xd1 * B[k + 1]; za += S[1][k] * C[k]; zb += S[1][k + 1] * C[k + 1]; }
            { const float yv = dred8(ya + yb), zv = dred8(za + zb); out0 = (np == j) ? yv : out0; out1 = (np == j) ? zv : out1; }
        }
        O[0] = f2bf(out0); O[8] = f2bf(out1); O += sgn * 8 * DMIX;
        SSD_STORE();
    }
    if (q.ctx) {
#pragma unroll
        for (int e = 0; e < 2; ++e) { int ln = lane; asm volatile("" : "+v"(ln)); float* o = c.out + OUT_SSD + ((((size_t)q.b * 2 + l) * 2 + dir) * 8 + h) * 4096 + (w4 * 16 + (ln >> 3) + 8 * e) * 64 + (ln & 7) * 8; *(f32x4*)o = (f32x4){S[e][0], S[e][1], S[e][2], S[e][3]}; *(f32x4*)(o + 4) = (f32x4){S[e][4], S[e][5], S[e][6], S[e][7]}; } }
}

__device__ void scan_gla(const Ctx& c, int l, int s, int dir, int h) {
    const SeqInfo q = seq_info(s); const int lane = c.lane, r = lane >> 3, v0 = c.wid * 16 + r, kp = lane & 7;
    float S[2][8];
#pragma unroll
    for (int e = 0; e < 2; ++e) {
        if (!q.ctx) { const float* st = c.in[3] + (((((size_t)q.b * 2 + l) * 2 + dir) * 4 + h) * 64 + kp * 8) * 128 + v0 + 8 * e;
#pragma unroll
            for (int j = 0; j < 8; ++j) S[e][j] = st[j * 128]; }
        else {
#pragma unroll
            for (int j = 0; j < 8; ++j) S[e][j] = 0.f; } }
    const long sgn = dir ? -1 : 1; const size_t rbase = (size_t)q.row0 + (dir ? q.L - 1 : 0);
    LAS float* lb = (LAS float*)c.lds + c.wid * (8 * REC); LAS float* wr = lb + r * REC + kp * 8; const LAS float* rd = lb + kp * 8;
    const char* gP = (const char*)(c.PROJ_() + (rbase + sgn * r) * NPROJ); const char* gS = (const char*)(c.SMALL_() + (rbase + sgn * r) * NSM); const long cP = sgn * 8 * NPROJ * 2, cS = sgn * 8 * NSM * 2;
    const unsigned loQ = (C_GLA + h * 64 + kp * 8) * 2, loV = (C_GLA + 512 + h * 128 + c.wid * 16 + kp) * 2, loG = (2048 + dir * 256 + h * 64 + kp * 8) * 2;
    bf16_t* O = c.OUTS_() + (size_t)(1 * 2 + dir) * T * DMIX + (rbase + sgn * kp) * DMIX + h * 128 + v0;
    u32x4 nQ, nK, nG; bf16_t nv0, nv1;
#define GLA_LOAD() { nQ = *(const u32x4*)(gP + loQ); nK = *(const u32x4*)(gP + loQ + 512); nG = *(const u32x4*)(gS + loG); nv0 = *(const bf16_t*)(gP + loV); nv1 = *(const bf16_t*)(gP + loV + 16); gP += cP; gS += cS; }
#define GLA_STORE() { st8(wr, nQ); st8(wr + 64, nK); st8(wr + 128, nG); lb[r * REC + 192 + kp] = bf2f(nv0); lb[r * REC + 200 + kp] = bf2f(nv1); }
    GLA_LOAD(); GLA_STORE();
    for (int i0 = 0; i0 < q.L; i0 += 8) {
        GLA_LOAD();
        float out0 = 0.f, out1 = 0.f;
#pragma unroll 4
        for (int j = 0; j < 8; ++j) {
            float Q[8], K[8], G[8]; ld8(rd + j * REC, Q); ld8(rd + j * REC + 64, K); ld8(rd + j * REC + 128, G); const float va = lb[j * REC + 192 + r], vb = lb[j * REC + 200 + r];
            float oa = 0.f, ob = 0.f, pa = 0.f, pb = 0.f;
#pragma unroll
            for (int k = 0; k < 8; k += 2) {
                S[0][k] = (S[0][k] - S[0][k] * G[k]) + K[k] * va; S[0][k + 1] = (S[0][k + 1] - S[0][k + 1] * G[k + 1]) + K[k + 1] * va; oa += Q[k] * S[0][k]; ob += Q[k + 1] * S[0][k + 1];
                S[1][k] = (S[1][k] - S[1][k] * G[k]) + K[k] * vb; S[1][k + 1] = (S[1][k + 1] - S[1][k + 1] * G[k + 1]) + K[k + 1] * vb; pa += Q[k] * S[1][k]; pb += Q[k + 1] * S[1][k + 1]; }
            { const float yv = dred8(oa + ob), zv = dred8(pa + pb); out0 = (kp == j) ? yv : out0; out1 = (kp == j) ? zv : out1; }
        }
        O[0] = f2bf(out0 * 0.125f); O[8] = f2bf(out1 * 0.125f); O += sgn * 8 * DMIX;
        GLA_STORE();
    }
    if (q.ctx) {
#pragma unroll
        for (int e = 0; e < 2; ++e) { int ln = lane; asm volatile("" : "+v"(ln)); float* o = c.out + OUT_GLA + (((((size_t)q.b * 2 + l) * 2 + dir) * 4 + h) * 64 + (ln & 7) * 8) * 128 + c.wid * 16 + (ln >> 3) + 8 * e;
#pragma unroll
            for (int j = 0; j < 8; ++j) o[j * 128] = S[e][j]; } }
}

__device__ void scan_rwkv(const Ctx& c, int l, int s, int dir, int hs) {
    const SeqInfo q = seq_info(s); const int h = hs >> 3, rg = hs & 7, lane = c.lane, r = lane >> 3, vr = rg * 8 + r, kp = lane & 7;
    float S[8];
    if (!q.ctx) { const float* st = c.in[4] + ((((size_t)q.b * 2 + l) * 2 + dir) * 8 + h) * 4096 + vr * 64 + kp * 8; const f32x4 a = *(const f32x4*)st, b = *(const f32x4*)(st + 4);
        S[0] = a[0]; S[1] = a[1]; S[2] = a[2]; S[3] = a[3]; S[4] = b[0]; S[5] = b[1]; S[6] = b[2]; S[7] = b[3]; }
    else {
#pragma unroll
        for (int j = 0; j < 8; ++j) S[j] = 0.f; }
    const long sgn = dir ? -1 : 1; const size_t rbase = (size_t)q.row0 + (dir ? q.L - 1 : 0);
    constexpr size_t AS2 = (size_t)T * DMIX * 2;
    LAS float* lb = (LAS float*)c.lds + c.wid * (8 * REC); LAS float* wr = lb + r * REC + kp * 8; const LAS float* rd = lb + kp * 8;
    const char* gR = (const char*)(c.RWR_() + (rbase + sgn * r) * 512 + h * 64 + kp * 8); const char* gS = (const char*)(c.SMALL_() + (rbase + sgn * r) * NSM + h * 64 + kp * 8);
    const char* gV = (const char*)(c.RWV_() + (rbase + sgn * r) * 512 + h * 64 + rg * 8 + kp); const long cR = sgn * 8 * 512 * 2, cS = sgn * 8 * NSM * 2;
    const unsigned loW = dir * 1024;
    bf16_t* O = c.OUTS_() + (size_t)(2 * 2 + dir) * T * DMIX + (rbase + sgn * kp) * DMIX + h * 64 + vr;
    u32x4 nR, nK, nKK, nA, nW; bf16_t nv;
#define RW_LOAD() { nR = *(const u32x4*)gR; nK = *(const u32x4*)(gR + AS2); nKK = *(const u32x4*)(gR + 3 * AS2); nA = *(const u32x4*)(gS + 2048); nW = *(const u32x4*)(gS + loW); nv = *(const bf16_t*)gV; gR += cR; gS += cS; gV += cR; }
#define RW_STORE() { st8(wr, nR); st8(wr + 64, nK); st8(wr + 128, nKK); st8(wr + 192, nA); st8(wr + 256, nW); lb[r * REC + 320 + kp] = bf2f(nv); }
    RW_LOAD(); RW_STORE();
    for (int i0 = 0; i0 < q.L; i0 += 8) {
        RW_LOAD();
        float outv = 0.f;
#pragma unroll 4
        for (int j = 0; j < 8; ++j) {
            float R[8], K[8], KK[8], A[8], W[8]; ld8(rd + j * REC, R); ld8(rd + j * REC + 64, K); ld8(rd + j * REC + 128, KK); ld8(rd + j * REC + 192, A); ld8(rd + j * REC + 256, W); const float vv = lb[j * REC + 320 + r];
            float s0 = 0.f, s1 = 0.f;
#pragma unroll
            for (int k = 0; k < 8; k += 2) { s0 += S[k] * KK[k]; s1 += S[k + 1] * KK[k + 1]; }
            const float skk = dred8(s0 + s1); float o0 = 0.f, o1 = 0.f;
#pragma unroll
            for (int k = 0; k < 8; k += 2) {
                S[k] = (S[k] - S[k] * W[k]) - skk * A[k] + vv * K[k]; S[k + 1] = (S[k + 1] - S[k + 1] * W[k + 1]) - skk * A[k + 1] + vv * K[k + 1];
                o0 += S[k] * R[k]; o1 += S[k + 1] * R[k + 1]; }
            { const float yv = dred8(o0 + o1); outv = (kp == j) ? yv : outv; }
        }
        *O = f2bf(outv); O += sgn * 8 * DMIX;
        RW_STORE();
    }
    if (q.ctx) { float* o = c.out + OUT_RWK + ((((size_t)q.b * 2 + l) * 2 + dir) * 8 + h) * 4096 + vr * 64 + kp * 8; *(f32x4*)o = (f32x4){S[0], S[1], S[2], S[3]}; *(f32x4*)(o + 4) = (f32x4){S[4], S[5], S[6], S[7]}; }
}

__device__ __forceinline__ void scan_item(const Ctx& c, int l, int id) {
    if (id < 320) { int n = id, s; if (n < 64) s = 16 + (n >> 4); else { n -= 64; s = n >> 4; }
        const int sub = n & 15; scan_rwkv(c, l, s, sub >> 3, (sub & 7) * 8 + c.wid); }
    else { const bool gla = id < 480; int m = gla ? id - 320 : id - 480, s; if (m < 32) s = 16 + (m >> 3); else { m -= 32; s = m >> 3; }
        const int sub = m & 7; if (gla) scan_gla(c, l, s, sub >> 2, sub & 3); else scan_ssd(c, l, s, sub >> 2, sub & 3); }
}
#define RW_L(n) (n)
#define RW_S(n) (64 + (n))
#define GLA_L(m) (320 + (m))
#define GLA_S(m) (320 + 32 + (m))
#define SSD_L(m) (480 + (m))
#define SSD_S(m) (480 + 32 + (m))
__device__ void phase_scan(const Ctx& c, int l) {
    const bool bal = c.G == 256; const int n = bal ? ((c.bid & 7) < 4 ? 1 : 4) : (640 - c.bid + c.G - 1) / c.G;
    for (int k = 0; k < n; ++k) {
        int bl = c.bid; asm volatile("" : "+s"(bl));
        const int cl = bl & 7, ix = bl >> 3, j = (cl - 4) * 32 + ix;
        const int id = !bal ? bl + k * c.G : (cl < 2 ? RW_L(ix * 2 + cl) : (cl == 2 ? GLA_L(ix) : (cl == 3 ? SSD_L(ix) : (k == 0 ? RW_S(2 * j) : (k == 1 ? RW_S(2 * j + 1) : (k == 2 ? GLA_S(j) : SSD_S(j)))))));
        scan_item(c, l, id);
    }
}

#ifndef PPT
#define PPT 1
#endif
__device__ void phase_postpass(const Ctx& c, int l) {
    const int lane = c.lane, c0 = lane * 8;
    const float* Dp = c.in[18] + l * 16; const float* snorm = c.in[19] + l * 512; const float* gnorm = c.in[23] + l * 128;
    const float* rk = c.in[33] + l * 512; const float* lnw = c.in[34] + l * 512; const float* lnb = c.in[35] + l * 512;
    constexpr size_t SL = (size_t)T * DMIX;
    for (int r0 = c.gw; r0 < T; r0 += PPT * c.NW) {
        u32x4 q[PPT][13];
#pragma unroll
        for (int e = 0; e < PPT; ++e) { const int r = min(r0 + e * c.NW, T - 1); const bf16_t* p0 = c.PROJ_() + (size_t)r * NPROJ; const bf16_t* of = c.OUTS_() + (size_t)r * DMIX + c0;
            q[e][0] = *(const u32x4*)of; q[e][1] = __builtin_nontemporal_load((const u32x4*)(of + SL)); q[e][2] = __builtin_nontemporal_load((const u32x4*)(c.XBC_() + (size_t)r * 768 + c0)); q[e][3] = __builtin_nontemporal_load((const u32x4*)(p0 + c0));
            q[e][4] = __builtin_nontemporal_load((const u32x4*)(of + 2 * SL)); q[e][5] = __builtin_nontemporal_load((const u32x4*)(of + 3 * SL)); q[e][6] = __builtin_nontemporal_load((const u32x4*)(p0 + C_GLA + 1024 + c0));
            q[e][7] = __builtin_nontemporal_load((const u32x4*)(of + 4 * SL)); q[e][8] = __builtin_nontemporal_load((const u32x4*)(of + 5 * SL)); q[e][9] = __builtin_nontemporal_load((const u32x4*)(c.RWR_() + (size_t)r * 512 + c0)); q[e][10] = __builtin_nontemporal_load((const u32x4*)(c.RWK_() + (size_t)r * 512 + c0));
            q[e][11] = __builtin_nontemporal_load((const u32x4*)(c.RWV_() + (size_t)r * 512 + c0)); q[e][12] = __builtin_nontemporal_load((const u32x4*)(c.SMALL_() + (size_t)r * NSM + 1536 + c0)); }
#pragma unroll
        for (int e = 0; e < PPT; ++e) { const int r = r0 + e * c.NW; if (r >= T) break;
            bf16_t* of = c.OUTS_() + (size_t)r * DMIX + c0;
            {
                float a[8], b[8], x[8], z[8], y[8]; unpack8(q[e][0], a); unpack8(q[e][1], b); unpack8(q[e][2], x); unpack8(q[e][3], z);
                const int h = lane >> 3; const float dsum = Dp[h] + Dp[8 + h]; float ss = 0.f;
#pragma unroll
                for (int j = 0; j < 8; ++j) { y[j] = (x[j] * dsum + a[j] + b[j]) * siluf_(z[j]); ss += y[j] * y[j]; }
                ss = wave_sum(ss, c.lane); const float rs = rsqrtf(ss * (1.0f / 512.0f) + 1e-6f);
#pragma unroll
                for (int j = 0; j < 8; ++j) y[j] = y[j] * rs * snorm[c0 + j];
                *(u32x4*)of = pack8(y);
            }
            {
                float a[8], b[8], g[8], y[8]; unpack8(q[e][4], a); unpack8(q[e][5], b); unpack8(q[e][6], g);
                float ss = 0.f;
#pragma unroll
                for (int j = 0; j < 8; ++j) { y[j] = a[j] + b[j]; ss += y[j] * y[j]; }
                ss = dred8(ss); ss += shx(ss, c.lane, 8);
                const float rs = rsqrtf(ss * (1.0f / 128.0f) + 1e-6f);
#pragma unroll
                for (int j = 0; j < 8; ++j) y[j] = y[j] * rs * gnorm[(c0 + j) & 127] * siluf_(g[j]);
                *(u32x4*)(of + 2 * SL) = pack8(y);
            }
            {
                float a[8], b[8], rr[8], kk[8], vv[8], gg[8], y[8];
                unpack8(q[e][7], a); unpack8(q[e][8], b); unpack8(q[e][9], rr); unpack8(q[e][10], kk); unpack8(q[e][11], vv); unpack8(q[e][12], gg);
                float sm = 0.f, bon = 0.f;
#pragma unroll
                for (int j = 0; j < 8; ++j) { y[j] = a[j] + b[j]; sm += y[j]; bon += rr[j] * kk[j] * rk[c0 + j]; }
                sm = dred8(sm); bon = dred8(bon); const float mean = sm * (1.0f / 64.0f); float vs = 0.f;
#pragma unroll
                for (int j = 0; j < 8; ++j) { y[j] -= mean; vs += y[j] * y[j]; }
                vs = dred8(vs); const float rs = rsqrtf(vs * (1.0f / 64.0f) + 64e-5f);
#pragma unroll
                for (int j = 0; j < 8; ++j) y[j] = (y[j] * rs * lnw[c0 + j] + lnb[c0 + j] + bon * vv[j]) * gg[j];
                *(u32x4*)(of + 4 * SL) = pack8(y);
            }
        }
    }
}

#ifndef RMASK
#define RMASK 0
#endif
#ifndef RMASK3
#define RMASK3 0
#endif
constexpr int N_PHASES = 2 + 2 * (14 + __builtin_popcount(RMASK) + 2 * __builtin_popcount(RMASK3));
__global__ void __launch_bounds__(NT, 2) fwd_kernel(Args a) {
    extern __shared__ __attribute__((aligned(16))) unsigned char lds_raw[];
    Ctx c; c.in = a.in; c.out = a.out; c.ws = a.ws; c.lds = (LAS unsigned char*)lds_raw;
    cg::grid_group grid = cg::this_grid();
    volatile LAS unsigned* st = (volatile LAS unsigned*)(c.lds + LDS_STAGE);
    if (threadIdx.x < 4) st[threadIdx.x] = 0u;
    __syncthreads();
    const XcdBarrier bar = xcd_barrier_post((unsigned*)(a.ws + WS_BAR), st);
    if (a.ph_hi < 0) grid.sync();
    for (int ph = a.ph_lo; ph < a.ph_hi; ++ph) {
#ifndef EXTRA_SYNC
#define EXTRA_SYNC 0
#endif
        if (ph > a.ph_lo) { xcd_barrier(bar); for (int e = 0; e < EXTRA_SYNC; ++e) xcd_barrier(bar); }
        { int tl = threadIdx.x, bl = blockIdx.x, gl = gridDim.x; asm volatile("" : "+v"(tl), "+s"(bl), "+s"(gl)); c.G = gl; c.NW = gl * 8;
          c.tid = tl; c.lane = tl & 63; c.wid = __builtin_amdgcn_readfirstlane(tl >> 6); c.bid = bl; c.gw = bl * 8 + c.wid; }
        if (ph == 0) { phase_init(c); __syncthreads(); const int base = convert_ffn(c, 0, 0, 0); convert_mixer(c, 0, base); continue; }
        if (ph == N_PHASES - 1) { phase_final_norm(c); continue; }
#ifndef RMASK
#define RMASK 0
#endif
        constexpr int LAYER_LEN = 14 + __builtin_popcount(RMASK) + 2 * __builtin_popcount(RMASK3);
        const int l = (ph - 1) / LAYER_LEN; int sp = 0; float sgn = 1.0f;
        if (RMASK | RMASK3) { int k = (ph - 1) % LAYER_LEN; for (sp = 0; sp < 14; ++sp) { const int reps = 1 + ((RMASK >> sp) & 1) + 2 * ((RMASK3 >> sp) & 1); if (k < reps) break; k -= reps; } sgn = (k & 1) ? -1.0f : 1.0f; }
        else sp = (ph - 1) % 14;
        const float* ada_l = c.ADA_() + l * 5 * 9216;
#ifndef PMASK
#define PMASK 0xFFFF
#endif
#define PON(k) ((PMASK >> (k)) & 1)
        switch (sp) {
            case 0: if (PON(0)) { phase_norm(c, l, 0, l > 0); if (l > 0) { __syncthreads(); int base = convert_ffn(c, l, 0, 0); convert_mixer(c, l, base); } } break;
            case 1: case 12: if (PON(1)) run_gemm(c, c.H_(), c.WGU_(), 5632, 1024, EpiGU{c.PROJ_()}); break;
            case 2: if (PON(2)) run_gemm(c, c.PROJ_(), c.WD_(), 1024, DFF, EpiResid{c.OUTS_(), ada_l + 2 * 1024, 0.5f * sgn}, 2); break;
            case 13: if (PON(2)) run_gemm(c, c.PROJ_(), c.WD_(), 1024, DFF, EpiResid{c.OUTS_(), ada_l + 8 * 1024, 0.5f * sgn}, 2); break;
            case 3: if (PON(3)) phase_norm(c, l, 1, true); break;
            case 4: if (PON(4)) run_gemm(c, c.H_(), c.WIN_(), NPROJ, 1024, EpiProj{c.PROJ_(), NPROJ}); break;
            case 5: if (PON(5)) phase_prepass(c, l); break;
            case 6: if (PON(6)) run_gemm(c, c.LOWA_(), c.WSM_(), 2048, KSM, EpiSmall{c.SMALL_(), c.in[26] + l * 1024, c.in[28] + l * 512, c.RWK_(), c.RWKK_(), c.in[32] + l * 512}); break;
            case 7: if (PON(7)) phase_scan(c, l); break;
            case 8: if (PON(8)) phase_postpass(c, l); break;
            case 9: if (PON(9)) { int Kl = 512; asm volatile("" : "+s"(Kl));
                pg8::Gemm g{c.OUTS_(), c.WBO_(), T, 3072, Kl, 512, 4, (size_t)2 * T * DMIX * 2, (size_t)1024 * 512 * 2}; BranchOrder S{c.bid};
                pg8::gemm_phase<EpiBranch, BranchOrder, GP_ALIGN, GP_SP2>(c.lds, g, S, EpiBranch{c.H_(), c.PROJ_() + C_GATE});
                if (c.G > 128 && c.bid >= 128) { Ctx c2 = c; c2.bid = c.bid - 128; c2.G = c.G - 128; (void)convert_ffn(c2, l, 1, 0); } } break;
            case 10: if (PON(10)) run_gemm(c, c.H_(), c.WOUT_(), 1024, 1024, EpiResid{c.OUTS_(), ada_l + 5 * 1024, 1.0f * sgn}, 2); break;
            case 11: if (PON(11)) { phase_norm(c, l, 2, true); if (c.G <= 128) { __syncthreads(); (void)convert_ffn(c, l, 1, 0); } } break;
        }
    }
}

#ifndef N_LAUNCH_MODE
#define N_LAUNCH_MODE 1
#endif
extern "C" void kernel_launch(void* const* d_in, const int* in_sizes, int n_in, void* d_out, int out_size, void* d_ws, size_t ws_size, hipStream_t stream) {
    static int grid = 0;
    if (grid == 0) {
        if (n_in != 39 || ws_size < WS_END) { fprintf(stderr, "kernel_launch: need 39 inputs and %zu bytes of workspace; got %d, %zu\n", (size_t)WS_END, n_in, ws_size); grid = -1; return; }
        if (hipFuncSetAttribute((const void*)fwd_kernel, hipFuncAttributeMaxDynamicSharedMemorySize, LDS_BYTES) != hipSuccess) { fprintf(stderr, "kernel_launch: hipFuncSetAttribute failed\n"); grid = -1; return; }
        int dev = 0, cus = 0, per_cu = 0;
        hipGetDevice(&dev); hipDeviceGetAttribute(&cus, hipDeviceAttributeMultiprocessorCount, dev);
        hipOccupancyMaxActiveBlocksPerMultiprocessor(&per_cu, (const void*)fwd_kernel, NT, LDS_BYTES);
        if (per_cu < 1) { fprintf(stderr, "kernel_launch: occupancy query says %d blocks per CU\n", per_cu); per_cu = 1; }
        (void)hipGetLastError();
        grid = cus;
    }
    if (grid < 0) return;
    Args a{};
    for (int i = 0; i < 39; ++i) a.in[i] = (const float*)d_in[i];
    a.out = (float*)d_out; a.ws = (unsigned char*)d_ws;
#if N_LAUNCH_MODE == 0
    for (int ph = 0; ph < N_PHASES; ++ph) { a.ph_lo = ph; a.ph_hi = ph + 1; hipLaunchKernelGGL(fwd_kernel, dim3(grid), dim3(NT), LDS_BYTES, stream, a); }
#else
    if (hipMemsetAsync((unsigned char*)d_ws + WS_BAR, 0, XCD_BAR_WORDS * 4, stream) != hipSuccess) { fprintf(stderr, "kernel_launch: memset of the barrier words failed\n"); return; }
    a.ph_lo = 0; a.ph_hi = N_PHASES;
    void* args[] = {&a};
    hipError_t e = hipLaunchCooperativeKernel((const void*)fwd_kernel, dim3(grid), dim3(NT), args, LDS_BYTES, stream);
    if (e != hipSuccess) fprintf(stderr, "cooperative launch failed: %s (grid %d)\n", hipGetErrorString(e), grid);
#endif
}
```

```cpp
#include <hip/hip_runtime.h>
#include <hip/hip_cooperative_groups.h>
#include <cstdio>
namespace cg = cooperative_groups;
namespace pg8 {
#define PG8_LAS __attribute__((address_space(3)))
typedef unsigned short bf16_t;
typedef short bf16x8 __attribute__((ext_vector_type(8)));
typedef float f32x4 __attribute__((ext_vector_type(4)));
typedef unsigned u32x4 __attribute__((ext_vector_type(4)));
constexpr int BM = 256, BK = 64, HALF = 128, HTB = HALF * BK * 2  , STAGE_BYTES = 8 * HTB, NXCD = 8, WGM = 8;

__host__ __device__ __forceinline__ int lds_byte(int r, int c) { const int st = (r >> 4) * 2 + (c >> 5), rr = r & 15, cc = c & 31, ob = rr * 64 + cc * 2; return st * 1024 + (ob ^ (((ob >> 9) & 1) << 5)); }
__host__ __device__ __forceinline__ void stage_rc(int b, int& R, int& C) { const int st = b / 1024, sb = b % 1024, swz = sb ^ (((sb >> 9) & 1) << 5); R = (st >> 1) * 16 + swz / 64; C = (st & 1) * 32 + (swz % 64) / 2; }
__host__ __device__ __forceinline__ int perm32(int rho) { const int n = rho >> 4, i = rho & 15; return 8 * (i >> 2) + 4 * n + (i & 3); }

struct Unit { int pm, pn; };
struct Gemm { const bf16_t* A; const bf16_t* Bt; int M, N, K, ld, nreal; size_t asl, bsl; };

struct StaticOrder {
    int nM, nN, nwg, G, c;
    __host__ __device__ void init(int M, int N, int G_, int c_) { nM = M / BM; nN = N / BM; nwg = nM * nN; G = G_; c = c_; }
    __host__ __device__ bool next(int i, Unit& u) const {
        const long L = (long)i * G + c; if (L >= nwg) return false;
        int wgid = (int)L; { const int q = nwg / NXCD, r = nwg % NXCD, xcd = wgid % NXCD, off = wgid / NXCD; wgid = (xcd < r ? xcd * (q + 1) : r * (q + 1) + (xcd - r) * q) + off; }
        const int nig = WGM * nN, gid = wgid / nig, fm = gid * WGM, gsz = (nM - fm) < WGM ? (nM - fm) : WGM;
        u.pm = fm + ((wgid % nig) % gsz); u.pn = (wgid % nig) / gsz; return true;
    }
    __device__ __forceinline__ void a_ready(const Unit&) const {}
    __device__ __forceinline__ void done(const Unit&) const {}
};
__device__ __forceinline__ unsigned cvt_pk_bf16(float lo, float hi) { unsigned r; asm volatile("v_cvt_pk_bf16_f32 %0, %1, %2" : "=v"(r) : "v"(lo), "v"(hi)); return r; }
template <class Epi, class Sched, bool ALIGN_EPI = false, bool SP2 = false>
__device__ __forceinline__ void gemm_phase(PG8_LAS unsigned char* lds, const Gemm g, const Sched& S, const Epi& E) {
    int tid_l = threadIdx.x; asm volatile("" : "+v"(tid_l));
    const int tid = tid_l, wid = __builtin_amdgcn_readfirstlane(tid >> 6), lane = tid & 63, wr = wid >> 2, wc = wid & 3, fr = lane & 15, fq = lane >> 4;
    const int K = g.K, LD = g.ld, nt = K / BK;
    unsigned voffA[2], voffB[2];
#pragma unroll
    for (int i = 0; i < 2; ++i) { int R, C; stage_rc(tid * 16 + i * 8192, R, C); const int Rb = Epi::PERM ? ((R & ~31) + perm32(R & 31)) : R;
        voffA[i] = (unsigned)(R * LD + C) * 2u; voffB[i] = (unsigned)(Rb * LD + C) * 2u; }
    const size_t kstep = (size_t)(BK * 2);
    const size_t hstep = (size_t)HALF * LD * 2;
    const size_t tstep = 2 * hstep;
    const unsigned ldsw = (unsigned)wid * 1024u;
    const int aoff = lds_byte(wr * 64 + fr, fq * 8), boff = lds_byte(wc * 32 + fr, fq * 8);
#define PG8_SA(b, h) (((b) * 2 + (h)) * HTB)
#define PG8_SB(b, h) ((4 + (b) * 2 + (h)) * HTB)
#define PG8_STAGE(bufoff, gbase, voff) do { _Pragma("unroll") for (int _i = 0; _i < 2; ++_i) \
        __builtin_amdgcn_global_load_lds((const unsigned*)((const char*)(gbase) + (voff)[_i]), (PG8_LAS unsigned*)(lds + (bufoff) + ldsw + _i * 8192), 16, 0, 0); } while (0)
#define PG8_LDA(dst, b, h) do { _Pragma("unroll") for (int m = 0; m < 4; ++m) _Pragma("unroll") for (int k = 0; k < 2; ++k) dst[m][k] = *(const PG8_LAS bf16x8*)(lds + PG8_SA(b, h) + aoff + m * 2048 + k * 1024); } while (0)
#define PG8_LDB(dst, b, h) do { _Pragma("unroll") for (int n = 0; n < 2; ++n) _Pragma("unroll") for (int k = 0; k < 2; ++k) dst[n][k] = *(const PG8_LAS bf16x8*)(lds + PG8_SB(b, h) + boff + n * 2048 + k * 1024); } while (0)
#define PG8_MMA(ai, bj, At, Bt) do { __builtin_amdgcn_s_setprio(1); _Pragma("unroll") for (int m = 0; m < 4; ++m) _Pragma("unroll") for (int n = 0; n < 2; ++n) _Pragma("unroll") for (int k = 0; k < 2; ++k) \
        acc[ai][bj][m][n] = __builtin_amdgcn_mfma_f32_16x16x32_bf16(Bt[n][k], At[m][k], acc[ai][bj][m][n], 0, 0, 0); __builtin_amdgcn_s_setprio(0); } while (0)
#define PG8_WAIT_V(n) asm volatile("s_waitcnt vmcnt(" #n ")" ::: "memory")
#define PG8_WAIT_L(n) asm volatile("s_waitcnt lgkmcnt(" #n ")" ::: "memory")
#define PG8_BAR __builtin_amdgcn_s_barrier()
#define PG8_SCHED __builtin_amdgcn_sched_barrier(0)
    Unit cur, nxt; int ui = 0;
    if (!S.next(0, cur)) return;
    f32x4 acc[2][2][4][2];
#pragma unroll
    for (int a = 0; a < 2; ++a)
#pragma unroll
        for (int b = 0; b < 2; ++b)
#pragma unroll
            for (int m = 0; m < 4; ++m)
#pragma unroll
                for (int n = 0; n < 2; ++n) acc[a][b][m][n] = (f32x4){0.f, 0.f, 0.f, 0.f};
    bf16x8 At[4][2], B0[2][2], B1[2][2];
    const char* cA = (const char*)g.A + (size_t)cur.pm * tstep + (size_t)(cur.pn / g.nreal) * g.asl; const char* cB = (const char*)g.Bt + (size_t)(cur.pn % g.nreal) * tstep + (size_t)(cur.pn / g.nreal) * g.bsl;
    S.a_ready(cur);
    if constexpr (SP2) {
        PG8_STAGE(PG8_SB(0, 0), cB, voffB); PG8_STAGE(PG8_SB(0, 1), cB + hstep, voffB); PG8_STAGE(PG8_SA(0, 0), cA, voffA); PG8_STAGE(PG8_SA(0, 1), cA + hstep, voffA);
        if (wr == 1) PG8_BAR;
        PG8_WAIT_V(2); PG8_BAR;
        PG8_STAGE(PG8_SB(1, 0), cB + kstep, voffB); PG8_STAGE(PG8_SA(1, 0), cA + kstep, voffA); PG8_STAGE(PG8_SB(1, 1), cB + hstep + kstep, voffB);
        PG8_WAIT_V(6); PG8_BAR;
    } else {
        PG8_STAGE(PG8_SB(0, 0), cB, voffB); PG8_STAGE(PG8_SA(0, 0), cA, voffA); PG8_STAGE(PG8_SB(0, 1), cB + hstep, voffB); PG8_STAGE(PG8_SA(0, 1), cA + hstep, voffA);
        if (wr == 1) PG8_BAR;
        PG8_WAIT_V(4); PG8_BAR;
        PG8_STAGE(PG8_SB(1, 0), cB + kstep, voffB); PG8_STAGE(PG8_SA(1, 0), cA + kstep, voffA); PG8_STAGE(PG8_SB(1, 1), cB + hstep + kstep, voffB);
        PG8_WAIT_V(6); PG8_BAR;
    }
    for (;;) {
        const bool has_next = S.next(ui + 1, nxt);
        const char* nA = has_next ? (const char*)g.A + (size_t)nxt.pm * tstep + (size_t)(nxt.pn / g.nreal) * g.asl : cA; const char* nB = has_next ? (const char*)g.Bt + (size_t)(nxt.pn % g.nreal) * tstep + (size_t)(nxt.pn / g.nreal) * g.bsl : cB;
        for (int t = 0; t < nt; t += 2) {
            const bool last = (t == nt - 2);
            const char* a1 = cA + (size_t)(t + 1) * kstep;
            const char* a2 = last ? nA : cA + (size_t)(t + 2) * kstep; const char* b2 = last ? nB : cB + (size_t)(t + 2) * kstep;
            const char* a3 = a2 + kstep; const char* b3 = b2 + kstep;
            if (last && has_next) S.a_ready(nxt);
            if constexpr (SP2) {
            PG8_LDB(B0, 0, 0); PG8_LDB(B1, 0, 1); PG8_SCHED; PG8_LDA(At, 0, 0); PG8_STAGE(PG8_SA(1, 1), a1 + hstep, voffA);
            PG8_WAIT_V(8); PG8_WAIT_L(0); PG8_BAR; PG8_MMA(0, 0, At, B0); PG8_MMA(0, 1, At, B1); PG8_BAR; PG8_SCHED;
            PG8_LDA(At, 0, 1); PG8_STAGE(PG8_SB(0, 0), b2, voffB); PG8_STAGE(PG8_SB(0, 1), b2 + hstep, voffB); PG8_STAGE(PG8_SA(0, 0), a2, voffA);
            PG8_WAIT_V(8); PG8_WAIT_L(0); PG8_BAR; PG8_MMA(1, 0, At, B0); PG8_MMA(1, 1, At, B1); PG8_BAR; PG8_SCHED;
            PG8_LDB(B0, 1, 0); PG8_LDB(B1, 1, 1); PG8_SCHED; PG8_LDA(At, 1, 0); PG8_STAGE(PG8_SA(0, 1), a2 + hstep, voffA);
            PG8_WAIT_V(8); PG8_WAIT_L(0); PG8_BAR; PG8_MMA(0, 0, At, B0); PG8_MMA(0, 1, At, B1); PG8_BAR; PG8_SCHED;
            PG8_LDA(At, 1, 1); PG8_STAGE(PG8_SB(1, 0), b3, voffB); PG8_STAGE(PG8_SB(1, 1), b3 + hstep, voffB); PG8_STAGE(PG8_SA(1, 0), a3, voffA);
            PG8_WAIT_V(8); PG8_WAIT_L(0); PG8_BAR; PG8_MMA(1, 0, At, B0); PG8_MMA(1, 1, At, B1); PG8_BAR; PG8_SCHED;
            } else {
            PG8_LDB(B0, 0, 0); PG8_SCHED; PG8_LDA(At, 0, 0); PG8_STAGE(PG8_SA(1, 1), a1 + hstep, voffA);
            PG8_WAIT_L(8); PG8_BAR; PG8_WAIT_L(0); PG8_MMA(0, 0, At, B0); PG8_BAR; PG8_SCHED;
            PG8_LDB(B1, 0, 1); PG8_STAGE(PG8_SB(0, 0), b2, voffB);
            PG8_BAR; PG8_WAIT_L(0); PG8_MMA(0, 1, At, B1); PG8_BAR;
            PG8_LDA(At, 0, 1); PG8_STAGE(PG8_SA(0, 0), a2, voffA);
            PG8_BAR; PG8_WAIT_L(0); PG8_MMA(1, 0, At, B0); PG8_BAR; PG8_SCHED;
            PG8_STAGE(PG8_SB(0, 1), b2 + hstep, voffB);
            PG8_WAIT_V(6); PG8_BAR; PG8_MMA(1, 1, At, B1); PG8_BAR;
            PG8_LDB(B0, 1, 0); PG8_SCHED; PG8_LDA(At, 1, 0); PG8_STAGE(PG8_SA(0, 1), a2 + hstep, voffA);
            PG8_WAIT_L(8); PG8_BAR; PG8_WAIT_L(0); PG8_MMA(0, 0, At, B0); PG8_BAR; PG8_SCHED;
            PG8_LDB(B1, 1, 1); PG8_STAGE(PG8_SB(1, 0), b3, voffB);
            PG8_BAR; PG8_WAIT_L(0); PG8_MMA(0, 1, At, B1); PG8_BAR;
            PG8_LDA(At, 1, 1); PG8_STAGE(PG8_SA(1, 0), a3, voffA);
            PG8_BAR; PG8_WAIT_L(0); PG8_MMA(1, 0, At, B0); PG8_BAR; PG8_SCHED;
            PG8_STAGE(PG8_SB(1, 1), b3 + hstep, voffB);
            PG8_WAIT_V(6); PG8_BAR; PG8_MMA(1, 1, At, B1); PG8_BAR;
            }
        }
        if constexpr (ALIGN_EPI) { if (wr == 0) PG8_BAR; }
        if constexpr (!Epi::AFTER_DRAIN) { E(acc, cur, wr, wc, fr, fq); S.done(cur); }
        if (!has_next) break;
#pragma unroll
        for (int a = 0; a < 2; ++a)
#pragma unroll
            for (int b = 0; b < 2; ++b)
#pragma unroll
                for (int m = 0; m < 4; ++m)
#pragma unroll
                    for (int n = 0; n < 2; ++n) acc[a][b][m][n] = (f32x4){0.f, 0.f, 0.f, 0.f};
        cur = nxt; cA = nA; cB = nB; ++ui;
        if constexpr (ALIGN_EPI) { if (wr == 1) PG8_BAR; }
    }
    PG8_WAIT_V(0);
    if constexpr (!ALIGN_EPI) { if (wr == 0) PG8_BAR; }
    PG8_BAR;
    if constexpr (Epi::AFTER_DRAIN) { E.fused(acc, cur, wr, wc, fr, fq, lds, wid, lane); S.done(cur); }
#undef PG8_SA
#undef PG8_SB
#undef PG8_STAGE
#undef PG8_LDA
#undef PG8_LDB
#undef PG8_MMA
#undef PG8_WAIT_V
#undef PG8_WAIT_L
#undef PG8_BAR
#undef PG8_SCHED
}
}
#define LAS __attribute__((address_space(3)))
#define XB_TMO      128
#define XB_XCNT(j)  (256  + 64 * (j))
#define XB_XSUB(j)  (1280 + 64 * (j))
#define XB_XGEN(j)  (2304 + 64 * (j))
#define XB_TOP      3328
#define XB_TOPGEN   3392
#define XCD_BAR_WORDS 3456
#define XB_SPIN_CAP (1u << 18)

__device__ __forceinline__ unsigned xb_ld(unsigned* p)              { return __hip_atomic_load(p, __ATOMIC_RELAXED, __HIP_MEMORY_SCOPE_AGENT); }
__device__ __forceinline__ unsigned xb_add(unsigned* p, unsigned v) { return __hip_atomic_fetch_add(p, v, __ATOMIC_RELAXED, __HIP_MEMORY_SCOPE_AGENT); }
__device__ __forceinline__ unsigned xb_xcc_id() { return (unsigned)__builtin_amdgcn_s_getreg((3 << 11) | 20) & 0xFu; }
#define XB_SPIN(cond, bar) do { unsigned _sp = 0; while (cond) { __builtin_amdgcn_s_sleep(1); \
    if ((++_sp & 255u) == 0u) { if (xb_ld(&(bar)[XB_TMO])) break; if (_sp > XB_SPIN_CAP) { atomicAdd(&(bar)[XB_TMO], 1u); break; } } } } while (0)

struct XcdBarrier {
    unsigned* bar; unsigned x;
    volatile LAS unsigned* st;
};

__device__ __forceinline__ XcdBarrier xcd_barrier_post(unsigned* bar, volatile LAS unsigned* st) {
    XcdBarrier b; b.bar = bar; b.x = xb_xcc_id(); b.st = st;
    if (threadIdx.x == 0) (void)xb_add(&bar[XB_XCNT(b.x)], 1u);
    return b;
}
__device__ __forceinline__ void xcd_barrier_complete(unsigned* bar, unsigned x, unsigned& nloc, unsigned& nx) {
    const unsigned G = gridDim.x * gridDim.y * gridDim.z;
    unsigned sum, cnt, mine, sp = 0u;
    for (;;) {
        sum = 0u; cnt = 0u; mine = 0u;
#pragma unroll
        for (unsigned j = 0; j < 16; ++j) { const unsigned c = xb_ld(&bar[XB_XCNT(j)]); sum += c; cnt += (c > 0u) ? 1u : 0u; mine = (j == x) ? c : mine; }
        if (sum == G) break;
        __builtin_amdgcn_s_sleep(1);
        if ((++sp & 255u) == 0u) { if (xb_ld(&bar[XB_TMO])) break; if (sp > XB_SPIN_CAP) { atomicAdd(&bar[XB_TMO], 1u); break; } }
    }
    nloc = mine > 0u ? mine : 1u; nx = cnt > 0u ? cnt : 1u;
}

__device__ __forceinline__ void xcd_barrier(const XcdBarrier& b) {
    asm volatile("s_waitcnt vmcnt(0)" ::: "memory");
    __syncthreads();
    if (threadIdx.x == 0) {
        unsigned* bar = b.bar;
        __builtin_amdgcn_s_waitcnt(0);
        unsigned nloc = b.st[0], nx = b.st[1];
        if (nloc == 0u) { xcd_barrier_complete(bar, b.x, nloc, nx); b.st[0] = nloc; b.st[1] = nx; }
        const unsigned old = xb_add(&bar[XB_XSUB(b.x)], 1u);
        const unsigned gen = old / nloc;
        if (old + 1u == (gen + 1u) * nloc) {
            __builtin_amdgcn_fence(__ATOMIC_RELEASE, "agent");
            asm volatile("s_waitcnt vmcnt(0)" ::: "memory");
            const unsigned og = xb_add(&bar[XB_TOP], 1u);
            const unsigned tg = og / nx;
            if (og + 1u == (tg + 1u) * nx) xb_add(&bar[XB_TOPGEN], 1u);
            else XB_SPIN(xb_ld(&bar[XB_TOPGEN]) == tg, bar);
            __builtin_amdgcn_fence(__ATOMIC_ACQUIRE, "agent");
            xb_add(&bar[XB_XGEN(b.x)], 1u);
            asm volatile("s_waitcnt vmcnt(0)" ::: "memory");
        } else {
            XB_SPIN(xb_ld(&bar[XB_XGEN(b.x)]) == gen, bar);
            __builtin_amdgcn_fence(__ATOMIC_ACQUIRE, "agent");
            asm volatile("s_waitcnt vmcnt(0)" ::: "memory");
        }
    }
    __syncthreads();
}

using pg8::bf16_t; using pg8::f32x4; using pg8::u32x4; using pg8::cvt_pk_bf16;
typedef unsigned u32x2 __attribute__((ext_vector_type(2)));

constexpr int T = 8192, D = 1024, DFF = 2816, DMIX = 512, NPROJ = 7936, NIN = 7792, NSM = 2560, KSM = 384, NT = 512, LDS_STAGE = 131072, LDS_BYTES = LDS_STAGE + 16;
constexpr int C_GLA = 1296, C_RW = 2864, C_GATE = 4720;
constexpr size_t WS_ADA = 0;
constexpr size_t WS_WGU = WS_ADA + 2ull * 5 * 9216 * 4;
constexpr size_t WS_WD = WS_WGU + 5632ull * 1024 * 2;
constexpr size_t WS_WIN = WS_WD + 1024ull * 2816 * 2;
constexpr size_t WS_WBO = WS_WIN + (size_t)NPROJ * 1024 * 2;
constexpr size_t WS_WOUT = WS_WBO + 3ull * 1024 * 512 * 2;
constexpr size_t WS_WSM = WS_WOUT + 1024ull * 1024 * 2;
constexpr size_t WS_H = WS_WSM + (size_t)NSM * KSM * 2;
constexpr size_t WS_PROJ = WS_H + (size_t)T * D * 2;
constexpr size_t WS_RW = WS_PROJ + (size_t)T * NPROJ * 2;
constexpr size_t WS_LOWA = WS_RW + 4ull * T * DMIX * 2;
constexpr size_t WS_SMALL = WS_LOWA + (size_t)T * KSM * 2;
constexpr size_t WS_OUT = WS_SMALL + (size_t)T * NSM * 2;
constexpr size_t WS_BAR = WS_OUT + 6ull * T * DMIX * 2;
constexpr size_t WS_END = WS_BAR + XCD_BAR_WORDS * 4;
constexpr size_t WS_XBC = WS_WGU;
constexpr size_t WS_DT = WS_XBC + (size_t)T * 768 * 2;
static_assert(WS_DT + (size_t)T * 16 * 4 <= WS_WIN, "xbc alias");
constexpr size_t OUT_SSD = 8388608, OUT_GLA = OUT_SSD + 2097152, OUT_RWK = OUT_GLA + 2097152;

struct Args { const float* in[39]; float* out; unsigned char* ws; int ph_lo, ph_hi; };

struct Ctx {
    const float* const* in; float* out; unsigned char* ws; LAS unsigned char* lds; int tid, lane, wid, G, bid, gw, NW;
    __device__ __forceinline__ float* X_() const { return out; }
    __device__ __forceinline__ float* ADA_() const { return (float*)(ws + WS_ADA); }
    __device__ __forceinline__ bf16_t* WGU_() const { return (bf16_t*)(ws + WS_WGU); }
    __device__ __forceinline__ bf16_t* WD_() const { return (bf16_t*)(ws + WS_WD); }
    __device__ __forceinline__ bf16_t* WIN_() const { return (bf16_t*)(ws + WS_WIN); }
    __device__ __forceinline__ bf16_t* WBO_() const { return (bf16_t*)(ws + WS_WBO); }
    __device__ __forceinline__ bf16_t* WOUT_() const { return (bf16_t*)(ws + WS_WOUT); }
    __device__ __forceinline__ bf16_t* WSM_() const { return (bf16_t*)(ws + WS_WSM); }
    __device__ __forceinline__ bf16_t* H_() const { return (bf16_t*)(ws + WS_H); }
    __device__ __forceinline__ bf16_t* PROJ_() const { return (bf16_t*)(ws + WS_PROJ); }
    __device__ __forceinline__ bf16_t* RWR_() const { return (bf16_t*)(ws + WS_RW); }
    __device__ __forceinline__ bf16_t* RWK_() const { return (bf16_t*)(ws + WS_RW) + (size_t)T * DMIX; }
    __device__ __forceinline__ bf16_t* RWV_() const { return (bf16_t*)(ws + WS_RW) + (size_t)2 * T * DMIX; }
    __device__ __forceinline__ bf16_t* RWKK_() const { return (bf16_t*)(ws + WS_RW) + (size_t)3 * T * DMIX; }
    __device__ __forceinline__ bf16_t* LOWA_() const { return (bf16_t*)(ws + WS_LOWA); }
    __device__ __forceinline__ bf16_t* SMALL_() const { return (bf16_t*)(ws + WS_SMALL); }
    __device__ __forceinline__ bf16_t* OUTS_() const { return (bf16_t*)(ws + WS_OUT); }
    __device__ __forceinline__ bf16_t* XBC_() const { return (bf16_t*)(ws + WS_XBC); }
    __device__ __forceinline__ float* DT_() const { return (float*)(ws + WS_DT); }
};

__device__ __forceinline__ float bf2f(bf16_t v) { return __uint_as_float((unsigned)v << 16); }
__device__ __forceinline__ float bflo(unsigned v) { return __uint_as_float(v << 16); }
__device__ __forceinline__ float bfhi(unsigned v) { return __uint_as_float(v & 0xffff0000u); }
__device__ __forceinline__ bf16_t f2bf(float f) { return (bf16_t)(cvt_pk_bf16(f, 0.f) & 0xffffu); }
__device__ __forceinline__ float sigmoidf_(float x) { return __builtin_amdgcn_rcpf(1.0f + __expf(-x)); }
__device__ __forceinline__ float siluf_(float x) { return x * __builtin_amdgcn_rcpf(1.0f + __expf(-x)); }
__device__ __forceinline__ float softplusf_(float x) { return fmaxf(x, 0.f) + __logf(1.0f + __expf(-fabsf(x))); }
__device__ __forceinline__ void unpack8(const u32x4 w, float* f) { f[0] = bflo(w.x); f[1] = bfhi(w.x); f[2] = bflo(w.y); f[3] = bfhi(w.y); f[4] = bflo(w.z); f[5] = bfhi(w.z); f[6] = bflo(w.w); f[7] = bfhi(w.w); }
__device__ __forceinline__ u32x4 pack8(const float* f) { u32x4 w; w.x = cvt_pk_bf16(f[0], f[1]); w.y = cvt_pk_bf16(f[2], f[3]); w.z = cvt_pk_bf16(f[4], f[5]); w.w = cvt_pk_bf16(f[6], f[7]); return w; }
__device__ __forceinline__ float shx(float x, int lane, int m) { return __int_as_float(__builtin_amdgcn_ds_bpermute((lane ^ m) << 2, __float_as_int(x))); }
__device__ __forceinline__ float wave_sum(float x, int lane) { x += shx(x, lane, 32); x += shx(x, lane, 16); x += shx(x, lane, 8); x += shx(x, lane, 4); x += shx(x, lane, 2); x += shx(x, lane, 1); return x; }
__device__ __forceinline__ float red8(float x, int lane) { x += shx(x, lane, 1); x += shx(x, lane, 2); x += shx(x, lane, 4); return x; }
template <int CTRL> __device__ __forceinline__ float dppf(float x) { return __int_as_float(__builtin_amdgcn_update_dpp(0, __float_as_int(x), CTRL, 0xF, 0xF, true)); }
__device__ __forceinline__ float dred8(float x) { x += dppf<0xB1>(x); x += dppf<0x4E>(x); x += dppf<0x141>(x); return x; }
__device__ __forceinline__ int cond_of_row(int r) { return r < 4096 ? 0 : 1 + ((r - 4096) >> 10); }

template <class F>
__device__ __forceinline__ int conv_tiles(const Ctx& c, F colptr, int ld, bf16_t* dst, int K, int N, int base) {
    LAS float* tile = (LAS float*)c.lds;
    const int nkt = K / 64, ntl = (N / 256) * nkt;
    int first = (c.bid - (base % c.G) + c.G) % c.G;
    for (int tl = first; tl < ntl; tl += c.G) {
        const int n0 = (tl / nkt) * 256, k0 = (tl % nkt) * 64;
        const int n4 = c.lane * 4;
        const float* p = colptr(n0 + n4);
        f32x4 v[8];
#pragma unroll
        for (int j = 0; j < 8; ++j) { const int k = c.wid + 8 * j; v[j] = p ? __builtin_nontemporal_load((const f32x4*)(p + (size_t)(k0 + k) * ld)) : (f32x4){0.f, 0.f, 0.f, 0.f}; }
#pragma unroll
        for (int j = 0; j < 8; ++j) { const int k = c.wid + 8 * j; LAS float* t = tile + k * 257 + n4; t[0] = v[j][0]; t[1] = v[j][1]; t[2] = v[j][2]; t[3] = v[j][3]; }
        __syncthreads();
        const int kc = c.tid & 7, nn0 = c.tid >> 3;
#pragma unroll
        for (int j = 0; j < 4; ++j) { const int n = nn0 + 64 * j; float f[8];
#pragma unroll
            for (int i = 0; i < 8; ++i) f[i] = tile[(kc * 8 + i) * 257 + n];
            *(u32x4*)(dst + (size_t)(n0 + n) * K + k0 + kc * 8) = pack8(f); }
        __syncthreads();
    }
    return base + ntl;
}
struct ColGU { const float* g; const float* u; __device__ const float* operator()(int n) const { const int pn = n >> 8, bj = (n >> 7) & 1, i = n & 127; return g + (u - g) * (long)bj + pn * 128 + i; } };
struct ColPlain { const float* w; int nvalid; __device__ const float* operator()(int n) const { return n < nvalid ? w + n : nullptr; } };

__device__ __forceinline__ int convert_ffn(const Ctx& c, int l, int f, int base) {
    const size_t o = ((size_t)l * 2 + f) * 1024 * 2816;
    base = conv_tiles(c, ColGU{c.in[10] + o, c.in[11] + o}, DFF, c.WGU_(), 1024, 5632, base);
    return conv_tiles(c, ColPlain{c.in[12] + o, 1024}, 1024, c.WD_(), DFF, 1024, base);
}
__device__ __forceinline__ void convert_mixer(const Ctx& c, int l, int base) {
    base = conv_tiles(c, ColPlain{c.in[13] + (size_t)l * 1024 * NIN, NIN}, NIN, c.WIN_(), 1024, NPROJ, base);
    base = conv_tiles(c, ColPlain{c.in[20] + (size_t)l * 512 * 1024, 1024}, 1024, c.WBO_(), 512, 1024, base);
    base = conv_tiles(c, ColPlain{c.in[24] + (size_t)l * 512 * 1024, 1024}, 1024, c.WBO_() + 1024 * 512, 512, 1024, base);
    base = conv_tiles(c, ColPlain{c.in[36] + (size_t)l * 512 * 1024, 1024}, 1024, c.WBO_() + 2 * 1024 * 512, 512, 1024, base);
    base = conv_tiles(c, ColPlain{c.in[37] + (size_t)l * 1024 * 1024, 1024}, 1024, c.WOUT_(), 1024, 1024, base);
    const float* w2 = c.in[27] + (size_t)l * 2 * 64 * 512; const float* a2 = c.in[29] + (size_t)l * 64 * 512; const float* g2 = c.in[30] + (size_t)l * 128 * 512; const float* gk = c.in[21] + (size_t)l * 2 * 16 * 256;
    for (int i = c.bid * NT + c.tid; i < NSM * KSM; i += c.G * NT) {
        const int n = i / KSM, k = i % KSM; float v = 0.f;
        if (n < 512) { if (k < 64) v = w2[k * 512 + n]; }
        else if (n < 1024) { if (k >= 64 && k < 128) v = w2[64 * 512 + (k - 64) * 512 + (n - 512)]; }
        else if (n < 1536) { if (k >= 128 && k < 192) v = a2[(k - 128) * 512 + (n - 1024)]; }
        else if (n < 2048) { if (k >= 192 && k < 320) v = g2[(k - 192) * 512 + (n - 1536)]; }
        else if (n < 2304) { if (k >= 320 && k < 336) v = gk[(k - 320) * 256 + (n - 2048)]; }
        else { if (k >= 336 && k < 352) v = gk[16 * 256 + (k - 336) * 256 + (n - 2304)]; }
        c.WSM_()[i] = f2bf(v);
    }
}

__device__ void phase_init(const Ctx& c) {
    const float* xp = c.in[0]; const float* xs = c.in[1];
    for (int i = c.bid * NT + c.tid; i < T * D / 4; i += c.G * NT) {
        const int r = i >> 8, c4 = (i & 255) * 4;
        f32x4 v;
        if (r < 4096) v = *(const f32x4*)(xp + (size_t)r * D + c4);
        else {
            v = *(const f32x4*)(xs + (size_t)(r - 4096) * D + c4);
            const int t = (r - 4096) & 1023, gr = t >> 6, gc = t & 63;
#pragma unroll
            for (int j = 0; j < 4; ++j) { const int cc = c4 + j, seg = cc >> 8, ii = cc & 255;
                const float omega = __expf(-(float)ii * (9.210340371976184f / 256.0f)); const float ang = (float)(seg < 2 ? gr : gc) * omega;
                v[j] += (seg & 1) ? __cosf(ang) : __sinf(ang); }
        }
        *(f32x4*)(c.X_() + (size_t)r * D + c4) = v;
    }
    LAS float* sc = (LAS float*)c.lds;
    LAS float* red = sc + 5 * 1024;
    for (int i = c.tid; i < 5 * 1024; i += NT) { const int cd = i >> 10, k = i & 1023; const float x = cd == 0 ? c.in[6][k] : c.in[5][(cd - 1) * 1024 + k]; sc[i] = siluf_(x); }
    __syncthreads();
    for (int it = c.bid; it < 288; it += c.G) {
        const int l = it / 144, n0 = (it % 144) * 64, col = c.tid & 63, kg = c.tid >> 6;
        const float* w = c.in[8] + (size_t)l * 1024 * 9216 + n0 + col;
        float a0 = 0.f, a1 = 0.f, a2 = 0.f, a3 = 0.f, a4 = 0.f;
#pragma unroll 16
        for (int k = kg * 128; k < kg * 128 + 128; ++k) { const float wv = w[(size_t)k * 9216]; a0 += sc[k] * wv; a1 += sc[1024 + k] * wv; a2 += sc[2048 + k] * wv; a3 += sc[3072 + k] * wv; a4 += sc[4096 + k] * wv; }
        red[(kg * 5 + 0) * 64 + col] = a0; red[(kg * 5 + 1) * 64 + col] = a1; red[(kg * 5 + 2) * 64 + col] = a2; red[(kg * 5 + 3) * 64 + col] = a3; red[(kg * 5 + 4) * 64 + col] = a4;
        __syncthreads();
        if (c.tid < 320) { const int cd = c.tid >> 6, cl = c.tid & 63; float s = c.in[9][l * 9216 + n0 + cl];
#pragma unroll
            for (int g = 0; g < 8; ++g) s += red[(g * 5 + cd) * 64 + cl];
            c.ADA_()[(l * 5 + cd) * 9216 + n0 + cl] = s; }
        __syncthreads();
    }
}

__device__ void phase_norm(const Ctx& c, int l, int which, bool addP) {
    const bf16_t* P = c.OUTS_();
    const float* g = c.in[7] + (l * 3 + which) * 1024;
    for (int r = c.gw; r < T; r += c.NW) {
        float* xr = c.X_() + (size_t)r * D; f32x4 v[4]; float ss = 0.f;
#pragma unroll
        for (int j = 0; j < 4; ++j) { v[j] = __builtin_nontemporal_load((const f32x4*)(xr + (c.lane + 64 * j) * 4)); if (addP) { const u32x2 pw = __builtin_nontemporal_load((const u32x2*)(P + (size_t)r * D + (c.lane + 64 * j) * 4)), pv = __builtin_nontemporal_load((const u32x2*)(P + (size_t)T * D + (size_t)r * D + (c.lane + 64 * j) * 4)); v[j] = v[j] + ((f32x4){bflo(pw.x), bfhi(pw.x), bflo(pw.y), bfhi(pw.y)} + (f32x4){bflo(pv.x), bfhi(pv.x), bflo(pv.y), bfhi(pv.y)}); __builtin_nontemporal_store(v[j], (f32x4*)(xr + (c.lane + 64 * j) * 4)); } ss += v[j][0] * v[j][0] + v[j][1] * v[j][1] + v[j][2] * v[j][2] + v[j][3] * v[j][3]; }
        ss = wave_sum(ss, c.lane); const float rs = rsqrtf(ss * (1.0f / 1024.0f) + 1e-6f);
        const float* sh = c.ADA_() + (l * 5 + cond_of_row(r)) * 9216 + (which * 3) * 1024; const float* scl = sh + 1024;
#pragma unroll
        for (int j = 0; j < 4; ++j) { const int cc = (c.lane + 64 * j) * 4; const f32x4 gg = *(const f32x4*)(g + cc), s1 = *(const f32x4*)(scl + cc), s0 = *(const f32x4*)(sh + cc);
            const f32x4 o = v[j] * rs * gg * (s1 + 1.0f) + s0; u32x2 w; w.x = cvt_pk_bf16(o[0], o[1]); w.y = cvt_pk_bf16(o[2], o[3]); *(u32x2*)(c.H_() + (size_t)r * D + cc) = w; }
    }
}
__device__ void phase_final_norm(const Ctx& c) {
    const float* g = c.in[38]; const bf16_t* P = c.OUTS_();
    for (int r = c.gw; r < T; r += c.NW) {
        float* xr = c.X_() + (size_t)r * D; f32x4 v[4]; float ss = 0.f;
#pragma unroll
        for (int j = 0; j < 4; ++j) { const u32x2 pw = *(const u32x2*)(P + (size_t)r * D + (c.lane + 64 * j) * 4), pv = *(const u32x2*)(P + (size_t)T * D + (size_t)r * D + (c.lane + 64 * j) * 4); v[j] = *(const f32x4*)(xr + (c.lane + 64 * j) * 4) + ((f32x4){bflo(pw.x), bfhi(pw.x), bflo(pw.y), bfhi(pw.y)} + (f32x4){bflo(pv.x), bfhi(pv.x), bflo(pv.y), bfhi(pv.y)}); ss += v[j][0] * v[j][0] + v[j][1] * v[j][1] + v[j][2] * v[j][2] + v[j][3] * v[j][3]; }
        ss = wave_sum(ss, c.lane); const float rs = rsqrtf(ss * (1.0f / 1024.0f) + 1e-6f);
#pragma unroll
        for (int j = 0; j < 4; ++j) { const int cc = (c.lane + 64 * j) * 4; *(f32x4*)(xr + cc) = v[j] * rs * *(const f32x4*)(g + cc); }
    }
}

struct EpiGU { static constexpr bool PERM = true, AFTER_DRAIN = false; bf16_t* O;
    __device__ __forceinline__ void operator()(const f32x4 (&acc)[2][2][4][2], const pg8::Unit& u, int wr, int wc, int fr, int fq) const {
        const int row0 = u.pm * 256 + wr * 64 + fr, col0 = u.pn * 128 + wc * 32 + 8 * fq;
#pragma unroll
        for (int ai = 0; ai < 2; ++ai)
#pragma unroll
            for (int m = 0; m < 4; ++m) { float o[8];
#pragma unroll
                for (int n = 0; n < 2; ++n)
#pragma unroll
                    for (int j = 0; j < 4; ++j) o[n * 4 + j] = siluf_(acc[ai][0][m][n][j]) * acc[ai][1][m][n][j];
                *(u32x4*)(O + (size_t)(row0 + ai * 128 + m * 16) * DFF + col0) = pack8(o); }
    } };
struct EpiResid { static constexpr bool PERM = true, AFTER_DRAIN = false; bf16_t* P; const float* gate; float s;
    __device__ __forceinline__ void operator()(const f32x4 (&acc)[2][2][4][2], const pg8::Unit& u, int wr, int wc, int fr, int fq) const {
        const int pn = u.pn & 3, kh = u.pn >> 2;
        const int row0 = u.pm * 256 + wr * 64 + fr, col0 = pn * 256 + wc * 32 + 8 * fq; const int cd = cond_of_row(u.pm * 256);
        f32x4 gv[2][2];
#pragma unroll
        for (int bj = 0; bj < 2; ++bj)
#pragma unroll
            for (int n = 0; n < 2; ++n) gv[bj][n] = *(const f32x4*)(gate + cd * 9216 + col0 + bj * 128 + n * 4) * s;
        bf16_t* base = P + (size_t)kh * T * D;
#pragma unroll
        for (int ai = 0; ai < 2; ++ai)
#pragma unroll
            for (int m = 0; m < 4; ++m) { const size_t off = (size_t)(row0 + ai * 128 + m * 16) * D + col0;
#pragma unroll
                for (int bj = 0; bj < 2; ++bj) { const f32x4 v0 = acc[ai][bj][m][0] * gv[bj][0], v1 = acc[ai][bj][m][1] * gv[bj][1];
                    u32x4 w; w.x = cvt_pk_bf16(v0[0], v0[1]); w.y = cvt_pk_bf16(v0[2], v0[3]); w.z = cvt_pk_bf16(v1[0], v1[1]); w.w = cvt_pk_bf16(v1[2], v1[3]);
                    *(u32x4*)(base + off + bj * 128) = w; } }
    } };
struct EpiProj { static constexpr bool PERM = true, AFTER_DRAIN = false; bf16_t* O; int ldc;
    __device__ __forceinline__ void operator()(const f32x4 (&acc)[2][2][4][2], const pg8::Unit& u, int wr, int wc, int fr, int fq) const {
        const int row0 = u.pm * 256 + wr * 64 + fr, col0 = u.pn * 256 + wc * 32 + 8 * fq;
#pragma unroll
        for (int ai = 0; ai < 2; ++ai)
#pragma unroll
            for (int m = 0; m < 4; ++m) { bf16_t* rowp = O + (size_t)(row0 + ai * 128 + m * 16) * ldc + col0;
#pragma unroll
                for (int bj = 0; bj < 2; ++bj) { const f32x4 v0 = acc[ai][bj][m][0], v1 = acc[ai][bj][m][1]; u32x4 w; w.x = cvt_pk_bf16(v0[0], v0[1]); w.y = cvt_pk_bf16(v0[2], v0[3]); w.z = cvt_pk_bf16(v1[0], v1[1]); w.w = cvt_pk_bf16(v1[2], v1[3]);
                    *(u32x4*)(rowp + bj * 128) = w; } }
    } };
struct EpiSmall { static constexpr bool PERM = true, AFTER_DRAIN = false; bf16_t* O; const float* w0; const float* a0; bf16_t* rwk; const bf16_t* rwkk; const float* ka;
    __device__ __forceinline__ void operator()(const f32x4 (&acc)[2][2][4][2], const pg8::Unit& u, int wr, int wc, int fr, int fq) const {
        const int row0 = u.pm * 256 + wr * 64 + fr, col0 = u.pn * 256 + wc * 32 + 8 * fq;
        const int kind = u.pn < 4 ? 0 : (u.pn < 6 ? 2 : 3);
        const float* bias = kind == 0 ? w0 : (kind == 2 ? a0 - 1024 : w0 - 1536);
        const float bsc = kind == 3 ? 0.f : 1.f;
#pragma unroll
        for (int bj = 0; bj < 2; ++bj) { const int cc = col0 + bj * 128; const f32x4 b0 = *(const f32x4*)(bias + cc) * bsc, b1 = *(const f32x4*)(bias + cc + 4) * bsc;
#pragma unroll
            for (int ai = 0; ai < 2; ++ai)
#pragma unroll
                for (int m = 0; m < 4; ++m) { const size_t row = row0 + ai * 128 + m * 16; const f32x4 x0 = acc[ai][bj][m][0] + b0, x1 = acc[ai][bj][m][1] + b1; float o[8];
#pragma unroll
                    for (int j = 0; j < 8; ++j) { const float x = j < 4 ? x0[j & 3] : x1[j & 3];
                        const float sg = __builtin_amdgcn_rcpf(1.0f + __expf(-x));
                        const float y01 = 1.0f - __expf(-sg * 0.60653066f);
                        o[j] = kind == 0 ? y01 : (kind == 2 ? sg : x); }
                    if (kind == 2) { float kv[8], kkv[8]; bf16_t* kp = rwk + row * 512 + (cc - 1024); unpack8(*(const u32x4*)kp, kv); unpack8(*(const u32x4*)(rwkk + row * 512 + (cc - 1024)), kkv);
                        const f32x4 ka0 = *(const f32x4*)(ka + cc - 1024), ka1 = *(const f32x4*)(ka + cc - 1024 + 4);
#pragma unroll
                        for (int j = 0; j < 8; ++j) { const float av = o[j], kaj = j < 4 ? ka0[j & 3] : ka1[j & 3]; kv[j] = kv[j] * (1.0f + (av - 1.0f) * kaj); o[j] = kkv[j] * av; }
                        *(u32x4*)kp = pack8(kv); }
                    *(u32x4*)(O + row * NSM + cc) = pack8(o); }
            asm volatile("" ::: "memory"); }
    } };
struct EpiBranch { static constexpr bool PERM = true, AFTER_DRAIN = false; bf16_t* M; const bf16_t* gates;
    __device__ __forceinline__ void operator()(const f32x4 (&acc)[2][2][4][2], const pg8::Unit& u, int wr, int wc, int fr, int fq) const {
        int upm = u.pm, upn = u.pn; asm volatile("" : "+s"(upm), "+s"(upn));
        const int b = upn >> 2, pn = upn & 3; const float keep = b ? 1.0f : 0.0f;
        const int row0 = upm * 256 + wr * 64 + fr, col0 = pn * 256 + wc * 32 + 8 * fq; const bf16_t* gb = gates + b * 1024;
#pragma unroll
        for (int ai = 0; ai < 2; ++ai)
#pragma unroll
            for (int m = 0; m < 4; ++m) { const int row = row0 + ai * 128 + m * 16;
#pragma unroll
                for (int bj = 0; bj < 2; ++bj) { const int cc = col0 + bj * 128; float gt[8], o[8];
                    unpack8(*(const u32x4*)(gb + (size_t)row * NPROJ + cc), gt);
                    bf16_t* mp = M + (size_t)row * D + cc;
                    unpack8(*(const u32x4*)mp, o);
#pragma unroll
                    for (int j = 0; j < 8; ++j) o[j] = o[j] * keep + sigmoidf_(gt[j]) * acc[ai][bj][m][j >> 2][j & 3];
                    *(u32x4*)mp = pack8(o); }
                asm volatile("" ::: "memory"); }
    } };

#ifndef GP_ALIGN
#define GP_ALIGN true
#endif
#ifndef GP_SP2
#define GP_SP2 true
#endif
template <class Epi>
__device__ __forceinline__ void run_gemm(const Ctx& c, const bf16_t* A, const bf16_t* Bt, int N, int K, const Epi& E, int ksplit = 1) {
    int Kl = K / ksplit; asm volatile("" : "+s"(Kl));
    pg8::Gemm g{A, Bt, T, N * ksplit, Kl, K, N / 256, (size_t)Kl * 2, (size_t)Kl * 2}; pg8::StaticOrder S; S.init(T, N * ksplit, c.G, c.bid);
    pg8::gemm_phase<Epi, pg8::StaticOrder, GP_ALIGN, GP_SP2>(c.lds, g, S, E);
}

struct BranchOrder { int c;
    __device__ bool next(int i, pg8::Unit& u) const { if (c >= 128 || i >= 3) return false; u.pm = c >> 2; u.pn = (c & 3) + 4 * i; return true; }
    __device__ __forceinline__ void a_ready(const pg8::Unit&) const {}
    __device__ __forceinline__ void done(const pg8::Unit&) const {}
};
__device__ __forceinline__ void ldf8(const float* p, float* f) { const f32x4 a = *(const f32x4*)p, b = *(const f32x4*)(p + 4); f[0] = a[0]; f[1] = a[1]; f[2] = a[2]; f[3] = a[3]; f[4] = b[0]; f[5] = b[1]; f[6] = b[2]; f[7] = b[3]; }
__device__ void phase_prepass(const Ctx& c, int l) {
    const float* cw = c.in[14] + l * 3 * 768; const float* cb = c.in[15] + l * 768; const float* dtb = c.in[16] + l * 16;
    const float* mu = c.in[25] + l * 1856; const float* rkk = c.in[31] + l * 512; const float* gkw = c.in[21] + l * 2 * 16 * 256; const float* gkb = c.in[22] + l * 512;
    const int lane = c.lane;
    for (int r = c.gw; r < T; r += c.NW) {
        int t, L; if (r < 4096) { t = r & 255; L = 256; } else { t = (r - 4096) & 1023; L = 1024; }
        const bool hp = t > 0, hn = t < L - 1;
        const bf16_t* p0 = c.PROJ_() + (size_t)r * NPROJ; const bf16_t* pm = hp ? p0 - NPROJ : p0; const bf16_t* pn = hn ? p0 + NPROJ : p0;
        const float fp = hp ? 1.f : 0.f, fn = hn ? 1.f : 0.f;
#pragma unroll
        for (int it = 0; it < 2; ++it) { const int g = lane + 64 * it; if (g < 96) { const int cc = g * 8; float x0[8], xm[8], xn[8], w0[8], w1[8], w2[8], bb[8], o[8];
            unpack8(*(const u32x4*)(p0 + 512 + cc), x0); unpack8(*(const u32x4*)(pm + 512 + cc), xm); unpack8(*(const u32x4*)(pn + 512 + cc), xn);
            ldf8(cw + cc, w0); ldf8(cw + 768 + cc, w1); ldf8(cw + 1536 + cc, w2); ldf8(cb + cc, bb);
#pragma unroll
            for (int j = 0; j < 8; ++j) o[j] = siluf_(bb[j] + w0[j] * xm[j] * fp + w1[j] * x0[j] + w2[j] * xn[j] * fn);
            *(u32x4*)(c.XBC_() + (size_t)r * 768 + cc) = pack8(o); } }
        if (lane < 16) c.DT_()[r * 16 + lane] = softplusf_(bf2f(p0[1280 + lane]) + dtb[lane]);
#pragma unroll
        for (int it = 0; it < 4; ++it) { const int g = lane + 64 * it; if (g < 232) { const int cc = g * 8; float x0[8], xm[8], xn[8], m8[8], o[8];
            unpack8(*(const u32x4*)(p0 + C_RW + cc), x0); unpack8(*(const u32x4*)(pm + C_RW + cc), xm); unpack8(*(const u32x4*)(pn + C_RW + cc), xn); ldf8(mu + cc, m8);
#pragma unroll
            for (int j = 0; j < 8; ++j) o[j] = x0[j] + (0.5f * (xm[j] * fp + xn[j] * fn) - x0[j]) * m8[j];
            if (it == 0) *(u32x4*)(c.RWR_() + (size_t)r * 512 + cc) = pack8(o);
            else if (it == 1) { const int ck = cc - 512; *(u32x4*)(c.RWK_() + (size_t)r * 512 + ck) = pack8(o); float kw[8], kq[8]; ldf8(rkk + ck, kw); float ss = 0.f;
#pragma unroll
                for (int j = 0; j < 8; ++j) { kq[j] = o[j] * kw[j]; ss += kq[j] * kq[j]; }
                ss = dred8(ss); const float inv = 1.0f / fmaxf(sqrtf(ss), 1e-12f);
#pragma unroll
                for (int j = 0; j < 8; ++j) kq[j] *= inv;
                *(u32x4*)(c.RWKK_() + (size_t)r * 512 + ck) = pack8(kq); }
            else if (it == 2) *(u32x4*)(c.RWV_() + (size_t)r * 512 + (cc - 1024)) = pack8(o);
            else { const int cl = cc - 1536;
#pragma unroll
                for (int j = 0; j < 8; ++j) { const float e2 = __expf(2.0f * o[j]); const float th = 1.0f - 2.0f / (1.0f + e2); const float sg = sigmoidf_(o[j]); o[j] = cl < 128 ? th : (cl < 192 ? o[j] : sg); }
                *(u32x4*)(c.LOWA_() + (size_t)r * KSM + cl) = pack8(o); } } }
        if (lane < 8) { unsigned z = 0u; asm volatile("" : "+v"(z)); *(u32x4*)(c.LOWA_() + (size_t)r * KSM + 320 + lane * 8) = (u32x4){z, z, z, z}; }
        {
            const int d = lane >> 5, cg = lane & 31; const float* gwp = gkw + d * 16 * 256 + cg * 8; float lr[16], acc[8];
            unpack8(*(const u32x4*)(p0 + C_GLA + 1536 + d * 16), lr); unpack8(*(const u32x4*)(p0 + C_GLA + 1536 + d * 16 + 8), lr + 8); ldf8(gkb + d * 256 + cg * 8, acc);
#pragma unroll
            for (int i = 0; i < 16; ++i) { float w[8]; ldf8(gwp + i * 256, w);
#pragma unroll
                for (int j = 0; j < 8; ++j) acc[j] += lr[i] * w[j]; }
#pragma unroll
            for (int j = 0; j < 8; ++j) acc[j] = 1.0f - __expf(softplusf_(-acc[j]) * (-1.0f / 16.0f));
            *(u32x4*)(c.SMALL_() + (size_t)r * NSM + 2048 + d * 256 + cg * 8) = pack8(acc); }
    }
}

struct SeqInfo { int L, row0, b, ctx; };
__device__ __forceinline__ SeqInfo seq_info(int s) { SeqInfo q; if (s < 16) { q.L = 256; q.row0 = s * 256; q.b = s; q.ctx = 1; } else { q.L = 1024; q.row0 = 4096 + (s - 16) * 1024; q.b = s - 16; q.ctx = 0; } return q; }

#ifndef PF_SSD
#define PF_SSD 8
#endif
#ifndef PF_GLA
#define PF_GLA 4
#endif
#ifndef PF_RW
#define PF_RW 2
#endif
__device__ __forceinline__ u32x4 ldu16(const bf16_t* ub, unsigned lo) { return *(const u32x4*)((const char*)ub + lo); }
__device__ __forceinline__ bf16_t ldu2(const bf16_t* ub, unsigned lo) { return *(const bf16_t*)((const char*)ub + lo); }
__device__ __forceinline__ float sel8(const float (&y)[8], int k) { float v = y[0]; v = k == 1 ? y[1] : v; v = k == 2 ? y[2] : v; v = k == 3 ? y[3] : v; v = k == 4 ? y[4] : v; v = k == 5 ? y[5] : v; v = k == 6 ? y[6] : v; v = k == 7 ? y[7] : v; return v; }

constexpr int REC = 336;
__device__ __forceinline__ void st8(LAS float* p, const u32x4 w) { float f[8]; unpack8(w, f); *(LAS f32x4*)p = (f32x4){f[0], f[1], f[2], f[3]}; *(LAS f32x4*)(p + 4) = (f32x4){f[4], f[5], f[6], f[7]}; }
__device__ __forceinline__ void ld8(const LAS float* p, float* f) { const f32x4 a = *(const LAS f32x4*)p, b = *(const LAS f32x4*)(p + 4); f[0] = a[0]; f[1] = a[1]; f[2] = a[2]; f[3] = a[3]; f[4] = b[0]; f[5] = b[1]; f[6] = b[2]; f[7] = b[3]; }

__device__ void scan_ssd(const Ctx& c, int l, int s, int dir, int hp) {
    const SeqInfo q = seq_info(s); const int h = hp * 2 + (c.wid >> 2), w4 = c.wid & 3, lane = c.lane, r = lane >> 3, p0 = w4 * 16 + r, np = lane & 7, g = h >> 2;
    float S[2][8];
#pragma unroll
    for (int e = 0; e < 2; ++e) {
        if (!q.ctx) { const float* st = c.in[2] + ((((size_t)q.b * 2 + l) * 2 + dir) * 8 + h) * 4096 + (p0 + 8 * e) * 64 + np * 8; const f32x4 a = *(const f32x4*)st, b = *(const f32x4*)(st + 4);
            S[e][0] = a[0]; S[e][1] = a[1]; S[e][2] = a[2]; S[e][3] = a[3]; S[e][4] = b[0]; S[e][5] = b[1]; S[e][6] = b[2]; S[e][7] = b[3]; }
        else {
#pragma unroll
            for (int j = 0; j < 8; ++j) S[e][j] = 0.f; } }
    const float adh = -__expf(c.in[17][l * 16 + dir * 8 + h]) * 1.44269504f;
    const long sgn = dir ? -1 : 1; const size_t rbase = (size_t)q.row0 + (dir ? q.L - 1 : 0);
    LAS float* lb = (LAS float*)c.lds + c.wid * (8 * REC); LAS float* wr = lb + r * REC + np * 8; const LAS float* rd = lb + np * 8;
    const char* gX = (const char*)(c.XBC_() + (rbase + sgn * r) * 768); const float* gD = c.DT_() + (rbase + sgn * r) * 16 + dir * 8 + h; const long cX = sgn * 8 * 768 * 2, cD = sgn * 8 * 16;
    const unsigned loB = (512 + g * 64 + np * 8) * 2, loX = (h * 64 + w4 * 16 + np) * 2;
    bf16_t* O = c.OUTS_() + (size_t)(0 * 2 + dir) * T * DMIX + (rbase + sgn * np) * DMIX + h * 64 + p0;
    u32x4 nB, nC; bf16_t nx0, nx1; float ndt;
#define SSD_LOAD() { nB = *(const u32x4*)(gX + loB); nC = *(const u32x4*)(gX + loB + 256); nx0 = *(const bf16_t*)(gX + loX); nx1 = *(const bf16_t*)(gX + loX + 16); ndt = *gD; gX += cX; gD += cD; }
#define SSD_STORE() { st8(wr, nB); st8(wr + 64, nC); lb[r * REC + 128 + np] = bf2f(nx0); lb[r * REC + 136 + np] = bf2f(nx1); lb[r * REC + 144] = ndt; }
    SSD_LOAD(); SSD_STORE();
    for (int i0 = 0; i0 < q.L; i0 += 8) {
        SSD_LOAD();
        float out0 = 0.f, out1 = 0.f;
#pragma unroll
        for (int j = 0; j < 8; ++j) {
            float B[8], C[8]; ld8(rd + j * REC, B); ld8(rd + j * REC + 64, C); const float x0 = lb[j * REC + 128 + r], x1 = lb[j * REC + 136 + r], dtv = lb[j * REC + 144];
            const float da = __builtin_amdgcn_exp2f(dtv * adh), xd0 = x0 * dtv, xd1 = x1 * dtv; float ya = 0.f, yb = 0.f, za = 0.f, zb = 0.f;
#pragma unroll
            for (int k = 0; k < 8; k += 2) {
                S[0][k] = da * S[0][k] + xd0 * B[k]; S[0][k + 1] = da * S[0][k + 1] + xd0 * B[k + 1]; ya += S[0][k] * C[k]; yb += S[0][k + 1] * C[k + 1];
                S[1][k] = da * S[1][k] + xd1 * B[k]; S[1][k + 1] = da * S[1][k + 1] + xd1 * B[k + 1]; za += S[1][k] * C[k]; zb += S[1][k + 1] * C[k + 1]; }
            { const float yv = dred8(ya + yb), zv = dred8(za + zb); out0 = (np == j) ? yv : out0; out1 = (np == j) ? zv : out1; }
        }
        O[0] = f2bf(out0); O[8] = f2bf(out1); O += sgn * 8 * DMIX;
        SSD_STORE();
    }
    if (q.ctx) {
#pragma unroll
        for (int e = 0; e < 2; ++e) { int ln = lane; asm volatile("" : "+v"(ln)); float* o = c.out + OUT_SSD + ((((size_t)q.b * 2 + l) * 2 + dir) * 8 + h) * 4096 + (w4 * 16 + (ln >> 3) + 8 * e) * 64 + (ln & 7) * 8; *(f32x4*)o = (f32x4){S[e][0], S[e][1], S[e][2], S[e][3]}; *(f32x4*)(o + 4) = (f32x4){S[e][4], S[e][5], S[e][6], S[e][7]}; } }
}

__device__ void scan_gla(const Ctx& c, int l, int s, int dir, int h) {
    const SeqInfo q = seq_info(s); const int lane = c.lane, r = lane >> 3, v0 = c.wid * 16 + r, kp = lane & 7;
    float S[2][8];
#pragma unroll
    for (int e = 0; e < 2; ++e) {
        if (!q.ctx) { const float* st = c.in[3] + (((((size_t)q.b * 2 + l) * 2 + dir) * 4 + h) * 64 + kp * 8) * 128 + v0 + 8 * e;
#pragma unroll
            for (int j = 0; j < 8; ++j) S[e][j] = st[j * 128]; }
        else {
#pragma unroll
            for (int j = 0; j < 8; ++j) S[e][j] = 0.f; } }
    const long sgn = dir ? -1 : 1; const size_t rbase = (size_t)q.row0 + (dir ? q.L - 1 : 0);
    LAS float* lb = (LAS float*)c.lds + c.wid * (8 * REC); LAS float* wr = lb + r * REC + kp * 8; const LAS float* rd = lb + kp * 8;
    const char* gP = (const char*)(c.PROJ_() + (rbase + sgn * r) * NPROJ); const char* gS = (const char*)(c.SMALL_() + (rbase + sgn * r) * NSM); const long cP = sgn * 8 * NPROJ * 2, cS = sgn * 8 * NSM * 2;
    const unsigned loQ = (C_GLA + h * 64 + kp * 8) * 2, loV = (C_GLA + 512 + h * 128 + c.wid * 16 + kp) * 2, loG = (2048 + dir * 256 + h * 64 + kp * 8) * 2;
    bf16_t* O = c.OUTS_() + (size_t)(1 * 2 + dir) * T * DMIX + (rbase + sgn * kp) * DMIX + h * 128 + v0;
    u32x4 nQ, nK, nG; bf16_t nv0, nv1;
#define GLA_LOAD() { nQ = *(const u32x4*)(gP + loQ); nK = *(const u32x4*)(gP + loQ + 512); nG = *(const u32x4*)(gS + loG); nv0 = *(const bf16_t*)(gP + loV); nv1 = *(const bf16_t*)(gP + loV + 16); gP += cP; gS += cS; }
#define GLA_STORE() { st8(wr, nQ); st8(wr + 64, nK); st8(wr + 128, nG); lb[r * REC + 192 + kp] = bf2f(nv0); lb[r * REC + 200 + kp] = bf2f(nv1); }
    GLA_LOAD(); GLA_STORE();
    for (int i0 = 0; i0 < q.L; i0 += 8) {
        GLA_LOAD();
        float out0 = 0.f, out1 = 0.f;
#pragma unroll 4
        for (int j = 0; j < 8; ++j) {
            float Q[8], K[8], G[8]; ld8(rd + j * REC, Q); ld8(rd + j * REC + 64, K); ld8(rd + j * REC + 128, G); const float va = lb[j * REC + 192 + r], vb = lb[j * REC + 200 + r];
            float oa = 0.f, ob = 0.f, pa = 0.f, pb = 0.f;
#pragma unroll
            for (int k = 0; k < 8; k += 2) {
                S[0][k] = (S[0][k] - S[0][k] * G[k]) + K[k] * va; S[0][k + 1] = (S[0][k + 1] - S[0][k + 1] * G[k + 1]) + K[k + 1] * va; oa += Q[k] * S[0][k]; ob += Q[k + 1] * S[0][k + 1];
                S[1][k] = (S[1][k] - S[1][k] * G[k]) + K[k] * vb; S[1][k + 1] = (S[1][k + 1] - S[1][k + 1] * G[k + 1]) + K[k + 1] * vb; pa += Q[k] * S[1][k]; pb += Q[k + 1] * S[1][k + 1]; }
            { const float yv = dred8(oa + ob), zv = dred8(pa + pb); out0 = (kp == j) ? yv : out0; out1 = (kp == j) ? zv : out1; }
        }
        O[0] = f2bf(out0 * 0.125f); O[8] = f2bf(out1 * 0.125f); O += sgn * 8 * DMIX;
        GLA_STORE();
    }
    if (q.ctx) {
#pragma unroll
        for (int e = 0; e < 2; ++e) { int ln = lane; asm volatile("" : "+v"(ln)); float* o = c.out + OUT_GLA + (((((size_t)q.b * 2 + l) * 2 + dir) * 4 + h) * 64 + (ln & 7) * 8) * 128 + c.wid * 16 + (ln >> 3) + 8 * e;
#pragma unroll
            for (int j = 0; j < 8; ++j) o[j * 128] = S[e][j]; } }
}

__device__ void scan_rwkv(const Ctx& c, int l, int s, int dir, int hs) {
    const SeqInfo q = seq_info(s); const int h = hs >> 3, rg = hs & 7, lane = c.lane, r = lane >> 3, vr = rg * 8 + r, kp = lane & 7;
    float S[8];
    if (!q.ctx) { const float* st = c.in[4] + ((((size_t)q.b * 2 + l) * 2 + dir) * 8 + h) * 4096 + vr * 64 + kp * 8; const f32x4 a = *(const f32x4*)st, b = *(const f32x4*)(st + 4);
        S[0] = a[0]; S[1] = a[1]; S[2] = a[2]; S[3] = a[3]; S[4] = b[0]; S[5] = b[1]; S[6] = b[2]; S[7] = b[3]; }
    else {
#pragma unroll
        for (int j = 0; j < 8; ++j) S[j] = 0.f; }
    const long sgn = dir ? -1 : 1; const size_t rbase = (size_t)q.row0 + (dir ? q.L - 1 : 0);
    constexpr size_t AS2 = (size_t)T * DMIX * 2;
    LAS float* lb = (LAS float*)c.lds + c.wid * (8 * REC); LAS float* wr = lb + r * REC + kp * 8; const LAS float* rd = lb + kp * 8;
    const char* gR = (const char*)(c.RWR_() + (rbase + sgn * r) * 512 + h * 64 + kp * 8); const char* gS = (const char*)(c.SMALL_() + (rbase + sgn * r) * NSM + h * 64 + kp * 8);
    const char* gV = (const char*)(c.RWV_() + (rbase + sgn * r) * 512 + h * 64 + rg * 8 + kp); const long cR = sgn * 8 * 512 * 2, cS = sgn * 8 * NSM * 2;
    const unsigned loW = dir * 1024;
    bf16_t* O = c.OUTS_() + (size_t)(2 * 2 + dir) * T * DMIX + (rbase + sgn * kp) * DMIX + h * 64 + vr;
    u32x4 nR, nK, nKK, nA, nW; bf16_t nv;
#define RW_LOAD() { nR = *(const u32x4*)gR; nK = *(const u32x4*)(gR + AS2); nKK = *(const u32x4*)(gR + 3 * AS2); nA = *(const u32x4*)(gS + 2048); nW = *(const u32x4*)(gS + loW); nv = *(const bf16_t*)gV; gR += cR; gS += cS; gV += cR; }
#define RW_STORE() { st8(wr, nR); st8(wr + 64, nK); st8(wr + 128, nKK); st8(wr + 192, nA); st8(wr + 256, nW); lb[r * REC + 320 + kp] = bf2f(nv); }
    RW_LOAD(); RW_STORE();
    for (int i0 = 0; i0 < q.L; i0 += 8) {
        RW_LOAD();
        float outv = 0.f;
#pragma unroll 4
        for (int j = 0; j < 8; ++j) {
            float R[8], K[8], KK[8], A[8], W[8]; ld8(rd + j * REC, R); ld8(rd + j * REC + 64, K); ld8(rd + j * REC + 128, KK); ld8(rd + j * REC + 192, A); ld8(rd + j * REC + 256, W); const float vv = lb[j * REC + 320 + r];
            float s0 = 0.f, s1 = 0.f;
#pragma unroll
            for (int k = 0; k < 8; k += 2) { s0 += S[k] * KK[k]; s1 += S[k + 1] * KK[k + 1]; }
            const float skk = dred8(s0 + s1); float o0 = 0.f, o1 = 0.f;
#pragma unroll
            for (int k = 0; k < 8; k += 2) {
                S[k] = (S[k] - S[k] * W[k]) - skk * A[k] + vv * K[k]; S[k + 1] = (S[k + 1] - S[k + 1] * W[k + 1]) - skk * A[k + 1] + vv * K[k + 1];
                o0 += S[k] * R[k]; o1 += S[k + 1] * R[k + 1]; }
            { const float yv = dred8(o0 + o1); outv = (kp == j) ? yv : outv; }
        }
        *O = f2bf(outv); O += sgn * 8 * DMIX;
        RW_STORE();
    }
    if (q.ctx) { float* o = c.out + OUT_RWK + ((((size_t)q.b * 2 + l) * 2 + dir) * 8 + h) * 4096 + vr * 64 + kp * 8; *(f32x4*)o = (f32x4){S[0], S[1], S[2], S[3]}; *(f32x4*)(o + 4) = (f32x4){S[4], S[5], S[6], S[7]}; }
}

__device__ __forceinline__ void scan_item(const Ctx& c, int l, int id) {
    if (id < 320) { int n = id, s; if (n < 64) s = 16 + (n >> 4); else { n -= 64; s = n >> 4; }
        const int sub = n & 15; scan_rwkv(c, l, s, sub >> 3, (sub & 7) * 8 + c.wid); }
    else { const bool gla = id < 480; int m = gla ? id - 320 : id - 480, s; if (m < 32) s = 16 + (m >> 3); else { m -= 32; s = m >> 3; }
        const int sub = m & 7; if (gla) scan_gla(c, l, s, sub >> 2, sub & 3); else scan_ssd(c, l, s, sub >> 2, sub & 3); }
}
#define RW_L(n) (n)
#define RW_S(n) (64 + (n))
#define GLA_L(m) (320 + (m))
#define GLA_S(m) (320 + 32 + (m))
#define SSD_L(m) (480 + (m))
#define SSD_S(m) (480 + 32 + (m))
__device__ void phase_scan(const Ctx& c, int l) {
    const bool bal = c.G == 256; const int n = bal ? ((c.bid & 7) < 4 ? 1 : 4) : (640 - c.bid + c.G - 1) / c.G;
    for (int k = 0; k < n; ++k) {
        int bl = c.bid; asm volatile("" : "+s"(bl));
        const int cl = bl & 7, ix = bl >> 3, j = (cl - 4) * 32 + ix;
        const int id = !bal ? bl + k * c.G : (cl < 2 ? RW_L(ix * 2 + cl) : (cl == 2 ? GLA_L(ix) : (cl == 3 ? SSD_L(ix) : (k == 0 ? RW_S(2 * j) : (k == 1 ? RW_S(2 * j + 1) : (k == 2 ? GLA_S(j) : SSD_S(j)))))));
        scan_item(c, l, id);
    }
}

#ifndef PPT
#define PPT 1
#endif
__device__ void phase_postpass(const Ctx& c, int l) {
    const int lane = c.lane, c0 = lane * 8;
    const float* Dp = c.in[18] + l * 16; const float* snorm = c.in[19] + l * 512; const float* gnorm = c.in[23] + l * 128;
    const float* rk = c.in[33] + l * 512; const float* lnw = c.in[34] + l * 512; const float* lnb = c.in[35] + l * 512;
    constexpr size_t SL = (size_t)T * DMIX;
    for (int r0 = c.gw; r0 < T; r0 += PPT * c.NW) {
        u32x4 q[PPT][13];
#pragma unroll
        for (int e = 0; e < PPT; ++e) { const int r = min(r0 + e * c.NW, T - 1); const bf16_t* p0 = c.PROJ_() + (size_t)r * NPROJ; const bf16_t* of = c.OUTS_() + (size_t)r * DMIX + c0;
            q[e][0] = *(const u32x4*)of; q[e][1] = __builtin_nontemporal_load((const u32x4*)(of + SL)); q[e][2] = __builtin_nontemporal_load((const u32x4*)(c.XBC_() + (size_t)r * 768 + c0)); q[e][3] = __builtin_nontemporal_load((const u32x4*)(p0 + c0));
            q[e][4] = __builtin_nontemporal_load((const u32x4*)(of + 2 * SL)); q[e][5] = __builtin_nontemporal_load((const u32x4*)(of + 3 * SL)); q[e][6] = __builtin_nontemporal_load((const u32x4*)(p0 + C_GLA + 1024 + c0));
            q[e][7] = __builtin_nontemporal_load((const u32x4*)(of + 4 * SL)); q[e][8] = __builtin_nontemporal_load((const u32x4*)(of + 5 * SL)); q[e][9] = __builtin_nontemporal_load((const u32x4*)(c.RWR_() + (size_t)r * 512 + c0)); q[e][10] = __builtin_nontemporal_load((const u32x4*)(c.RWK_() + (size_t)r * 512 + c0));
            q[e][11] = __builtin_nontemporal_load((const u32x4*)(c.RWV_() + (size_t)r * 512 + c0)); q[e][12] = __builtin_nontemporal_load((const u32x4*)(c.SMALL_() + (size_t)r * NSM + 1536 + c0)); }
#pragma unroll
        for (int e = 0; e < PPT; ++e) { const int r = r0 + e * c.NW; if (r >= T) break;
            bf16_t* of = c.OUTS_() + (size_t)r * DMIX + c0;
            {
                float a[8], b[8], x[8], z[8], y[8]; unpack8(q[e][0], a); unpack8(q[e][1], b); unpack8(q[e][2], x); unpack8(q[e][3], z);
                const int h = lane >> 3; const float dsum = Dp[h] + Dp[8 + h]; float ss = 0.f;
#pragma unroll
                for (int j = 0; j < 8; ++j) { y[j] = (x[j] * dsum + a[j] + b[j]) * siluf_(z[j]); ss += y[j] * y[j]; }
                ss = wave_sum(ss, c.lane); const float rs = rsqrtf(ss * (1.0f / 512.0f) + 1e-6f);
#pragma unroll
                for (int j = 0; j < 8; ++j) y[j] = y[j] * rs * snorm[c0 + j];
                *(u32x4*)of = pack8(y);
            }
            {
                float a[8], b[8], g[8], y[8]; unpack8(q[e][4], a); unpack8(q[e][5], b); unpack8(q[e][6], g);
                float ss = 0.f;
#pragma unroll
                for (int j = 0; j < 8; ++j) { y[j] = a[j] + b[j]; ss += y[j] * y[j]; }
                ss = dred8(ss); ss += shx(ss, c.lane, 8);
                const float rs = rsqrtf(ss * (1.0f / 128.0f) + 1e-6f);
#pragma unroll
                for (int j = 0; j < 8; ++j) y[j] = y[j] * rs * gnorm[(c0 + j) & 127] * siluf_(g[j]);
                *(u32x4*)(of + 2 * SL) = pack8(y);
            }
            {
                float a[8], b[8], rr[8], kk[8], vv[8], gg[8], y[8];
                unpack8(q[e][7], a); unpack8(q[e][8], b); unpack8(q[e][9], rr); unpack8(q[e][10], kk); unpack8(q[e][11], vv); unpack8(q[e][12], gg);
                float sm = 0.f, bon = 0.f;
#pragma unroll
                for (int j = 0; j < 8; ++j) { y[j] = a[j] + b[j]; sm += y[j]; bon += rr[j] * kk[j] * rk[c0 + j]; }
                sm = dred8(sm); bon = dred8(bon); const float mean = sm * (1.0f / 64.0f); float vs = 0.f;
#pragma unroll
                for (int j = 0; j < 8; ++j) { y[j] -= mean; vs += y[j] * y[j]; }
                vs = dred8(vs); const float rs = rsqrtf(vs * (1.0f / 64.0f) + 64e-5f);
#pragma unroll
                for (int j = 0; j < 8; ++j) y[j] = (y[j] * rs * lnw[c0 + j] + lnb[c0 + j] + bon * vv[j]) * gg[j];
                *(u32x4*)(of + 4 * SL) = pack8(y);
            }
        }
    }
}

#ifndef RMASK
#define RMASK 0
#endif
#ifndef RMASK3
#define RMASK3 0
#endif
constexpr int N_PHASES = 2 + 2 * (14 + __builtin_popcount(RMASK) + 2 * __builtin_popcount(RMASK3));
__global__ void __launch_bounds__(NT, 2) fwd_kernel(Args a) {
    extern __shared__ __attribute__((aligned(16))) unsigned char lds_raw[];
    Ctx c; c.in = a.in; c.out = a.out; c.ws = a.ws; c.lds = (LAS unsigned char*)lds_raw;
    cg::grid_group grid = cg::this_grid();
    volatile LAS unsigned* st = (volatile LAS unsigned*)(c.lds + LDS_STAGE);
    if (threadIdx.x < 4) st[threadIdx.x] = 0u;
    __syncthreads();
    const XcdBarrier bar = xcd_barrier_post((unsigned*)(a.ws + WS_BAR), st);
    if (a.ph_hi < 0) grid.sync();
    for (int ph = a.ph_lo; ph < a.ph_hi; ++ph) {
#ifndef EXTRA_SYNC
#define EXTRA_SYNC 0
#endif
        if (ph > a.ph_lo) { xcd_barrier(bar); for (int e = 0; e < EXTRA_SYNC; ++e) xcd_barrier(bar); }
        { int tl = threadIdx.x, bl = blockIdx.x, gl = gridDim.x; asm volatile("" : "+v"(tl), "+s"(bl), "+s"(gl)); c.G = gl; c.NW = gl * 8;
          c.tid = tl; c.lane = tl & 63; c.wid = __builtin_amdgcn_readfirstlane(tl >> 6); c.bid = bl; c.gw = bl * 8 + c.wid; }
        if (ph == 0) { phase_init(c); __syncthreads(); const int base = convert_ffn(c, 0, 0, 0); convert_mixer(c, 0, base); continue; }
        if (ph == N_PHASES - 1) { phase_final_norm(c); continue; }
#ifndef RMASK
#define RMASK 0
#endif
        constexpr int LAYER_LEN = 14 + __builtin_popcount(RMASK) + 2 * __builtin_popcount(RMASK3);
        const int l = (ph - 1) / LAYER_LEN; int sp = 0; float sgn = 1.0f;
        if (RMASK | RMASK3) { int k = (ph - 1) % LAYER_LEN; for (sp = 0; sp < 14; ++sp) { const int reps = 1 + ((RMASK >> sp) & 1) + 2 * ((RMASK3 >> sp) & 1); if (k < reps) break; k -= reps; } sgn = (k & 1) ? -1.0f : 1.0f; }
        else sp = (ph - 1) % 14;
        const float* ada_l = c.ADA_() + l * 5 * 9216;
#ifndef PMASK
#define PMASK 0xFFFF
#endif
#define PON(k) ((PMASK >> (k)) & 1)
        switch (sp) {
            case 0: if (PON(0)) { phase_norm(c, l, 0, l > 0); if (l > 0) { __syncthreads(); int base = convert_ffn(c, l, 0, 0); convert_mixer(c, l, base); } } break;
            case 1: case 12: if (PON(1)) run_gemm(c, c.H_(), c.WGU_(), 5632, 1024, EpiGU{c.PROJ_()}); break;
            case 2: if (PON(2)) run_gemm(c, c.PROJ_(), c.WD_(), 1024, DFF, EpiResid{c.OUTS_(), ada_l + 2 * 1024, 0.5f * sgn}, 2); break;
            case 13: if (PON(2)) run_gemm(c, c.PROJ_(), c.WD_(), 1024, DFF, EpiResid{c.OUTS_(), ada_l + 8 * 1024, 0.5f * sgn}, 2); break;
            case 3: if (PON(3)) phase_norm(c, l, 1, true); break;
            case 4: if (PON(4)) run_gemm(c, c.H_(), c.WIN_(), NPROJ, 1024, EpiProj{c.PROJ_(), NPROJ}); break;
            case 5: if (PON(5)) phase_prepass(c, l); break;
            case 6: if (PON(6)) run_gemm(c, c.LOWA_(), c.WSM_(), 2048, KSM, EpiSmall{c.SMALL_(), c.in[26] + l * 1024, c.in[28] + l * 512, c.RWK_(), c.RWKK_(), c.in[32] + l * 512}); break;
            case 7: if (PON(7)) phase_scan(c, l); break;
            case 8: if (PON(8)) phase_postpass(c, l); break;
            case 9: if (PON(9)) { int Kl = 512; asm volatile("" : "+s"(Kl));
                pg8::Gemm g{c.OUTS_(), c.WBO_(), T, 3072, Kl, 512, 4, (size_t)2 * T * DMIX * 2, (size_t)1024 * 512 * 2}; BranchOrder S{c.bid};
                pg8::gemm_phase<EpiBranch, BranchOrder, GP_ALIGN, GP_SP2>(c.lds, g, S, EpiBranch{c.H_(), c.PROJ_() + C_GATE});
                if (c.G > 128 && c.bid >= 128) { Ctx c2 = c; c2.bid = c.bid - 128; c2.G = c.G - 128; (void)convert_ffn(c2, l, 1, 0); } } break;
            case 10: if (PON(10)) run_gemm(c, c.H_(), c.WOUT_(), 1024, 1024, EpiResid{c.OUTS_(), ada_l + 5 * 1024, 1.0f * sgn}, 2); break;
            case 11: if (PON(11)) { phase_norm(c, l, 2, true); if (c.G <= 128) { __syncthreads(); (void)convert_ffn(c, l, 1, 0); } } break;
        }
    }
}

#ifndef N_LAUNCH_MODE
#define N_LAUNCH_MODE 1
#endif
extern "C" void kernel_launch(void* const* d_in, const int* in_sizes, int n_in, void* d_out, int out_size, void* d_ws, size_t ws_size, hipStream_t stream) {
    static int grid = 0;
    if (grid == 0) {
        if (n_in != 39 || ws_size < WS_END) { fprintf(stderr, "kernel_launch: need 39 inputs and %zu bytes of workspace; got %d, %zu\n", (size_t)WS_END, n_in, ws_size); grid = -1; return; }
        if (hipFuncSetAttribute((const void*)fwd_kernel, hipFuncAttributeMaxDynamicSharedMemorySize, LDS_BYTES) != hipSuccess) { fprintf(stderr, "kernel_launch: hipFuncSetAttribute failed\n"); grid = -1; return; }
        int dev = 0, cus = 0, per_cu = 0;
        hipGetDevice(&dev); hipDeviceGetAttribute(&cus, hipDeviceAttributeMultiprocessorCount, dev);
        hipOccupancyMaxActiveBlocksPerMultiprocessor(&per_cu, (const void*)fwd_kernel, NT, LDS_BYTES);
        if (per_cu < 1) { fprintf(stderr, "kernel_launch: occupancy query says %d blocks per CU\n", per_cu); per_cu = 1; }
        (void)hipGetLastError();
        grid = cus;
    }
    if (grid < 0) return;
    Args a{};
    for (int i = 0; i < 39; ++i) a.in[i] = (const float*)d_in[i];
    a.out = (float*)d_out; a.ws = (unsigned char*)d_ws;
#if N_LAUNCH_MODE == 0
    for (int ph = 0; ph < N_PHASES; ++ph) { a.ph_lo = ph; a.ph_hi = ph + 1; hipLaunchKernelGGL(fwd_kernel, dim3(grid), dim3(NT), LDS_BYTES, stream, a); }
#else
    if (hipMemsetAsync((unsigned char*)d_ws + WS_BAR, 0, XCD_BAR_WORDS * 4, stream) != hipSuccess) { fprintf(stderr, "kernel_launch: memset of the barrier words failed\n"); return; }
    a.ph_lo = 0; a.ph_hi = N_PHASES;
    void* args[] = {&a};
    hipError_t e = hipLaunchCooperativeKernel((const void*)fwd_kernel, dim3(grid), dim3(NT), args, LDS_BYTES, stream);
    if (e != hipSuccess) fprintf(stderr, "cooperative launch failed: %s (grid %d)\n", hipGetErrorString(e), grid);
#endif
}
```
